# Optimizing an MI355X kernel written in HIP

```python
import math
import jax, jax.numpy as jnp
from jax import lax
import numpy as np

D_MODEL = 1024
BATCH = 8
SEQ = 4096
DEPTH = 1

NSA_HEADS = 8
NSA_KV_GROUPS = 2
HEAD_DIM = 64
Q_PER_KV = NSA_HEADS // NSA_KV_GROUPS
NSA_WIDTH = NSA_HEADS * HEAD_DIM
KV_WIDTH = NSA_KV_GROUPS * HEAD_DIM
CMP_BLOCK = 32
CMP_STRIDE = 16
CMP_HIDDEN = 256
SLC_BLOCK = 64
SLC_TOPK = 16
SLC_QBLOCK = 64
WINDOW = 512
WIN_BLOCK = 128
FORCE_BONUS = 1000.0
SSM_GROUP = 16
SSM_GROUPS = 32
SSM_STATE = 64
SSM_WIDTH = SSM_GROUPS * SSM_GROUP
D_FF = 2816
RMS_EPS = 1e-6
IN_WIDTH = NSA_WIDTH + 6 * KV_WIDTH + 3 * NSA_HEADS + SSM_WIDTH + 2 * D_MODEL

kernel_name = "nsa_s5_gated_macaron_layer"


def _rmsnorm(x, g):
    xf = x.astype(jnp.float32)
    return xf * lax.rsqrt(jnp.mean(xf * xf, axis=-1, keepdims=True) + RMS_EPS) * g.astype(jnp.float32)


def _swiglu(x, g, w_gate, w_up, w_down):
    h = _rmsnorm(x, g)
    return (jax.nn.silu(h @ w_gate) * (h @ w_up)) @ w_down


def _masked_softmax(s, mask):
    s = jnp.where(mask, s.astype(jnp.float32), -1e30)
    m = jnp.max(s, axis=-1, keepdims=True)
    e = jnp.where(mask, jnp.exp(s - m), 0.0)
    den = jnp.sum(e, axis=-1, keepdims=True)
    return e / jnp.where(den > 0, den, 1.0)


def _compress(kv, pos, w1, w2):
    b, s, g, d = kv.shape
    chunks = kv.reshape(b, s // CMP_STRIDE, CMP_STRIDE, g, d)
    blocks = jnp.concatenate([chunks[:, :-1], chunks[:, 1:]], axis=2) + pos[:, None, :]
    flat = blocks.transpose(0, 1, 3, 2, 4).reshape(b, s // CMP_STRIDE - 1, g, CMP_BLOCK * d)
    return jax.nn.gelu(flat @ w1) @ w2


def _selected_attention(q, k, v, sel, scale):
    b, s, g, r, d = q.shape
    n = sel.shape[-1]
    ns = s // SLC_BLOCK
    nq = s // SLC_QBLOCK
    kb = k.reshape(b, ns, SLC_BLOCK, g, d).transpose(0, 3, 1, 2, 4)
    vb = v.reshape(b, ns, SLC_BLOCK, g, d).transpose(0, 3, 1, 2, 4)
    qc = q.reshape(b, nq, SLC_QBLOCK, g, r, d).transpose(1, 0, 2, 3, 4, 5)
    ic = sel.reshape(b, g, nq, SLC_QBLOCK, n).transpose(2, 0, 1, 3, 4)
    tc = jnp.arange(s).reshape(nq, SLC_QBLOCK)
    bi = jnp.arange(b)[:, None, None, None]
    gi = jnp.arange(g)[None, :, None, None]
    offs = jnp.arange(SLC_BLOCK)

    def step(args):
        qb, ib, tb = args
        kg = kb[bi, gi, ib]
        vg = vb[bi, gi, ib]
        sc = jnp.einsum('bqgrd,bgqnkd->bgrqnk', qb, kg) * scale
        kpos = ib[..., None] * SLC_BLOCK + offs
        mask = (kpos <= tb[:, None, None])[:, :, None]
        p = _masked_softmax(sc.reshape(b, g, r, SLC_QBLOCK, n * SLC_BLOCK),
                            mask.reshape(b, g, 1, SLC_QBLOCK, n * SLC_BLOCK))
        return jnp.einsum('bgrqk,bgqkd->bqgrd', p,
                          vg.reshape(b, g, SLC_QBLOCK, n * SLC_BLOCK, d).astype(jnp.float32))

    o = lax.map(step, (qc, ic, tc))
    return o.transpose(1, 0, 2, 3, 4, 5).reshape(b, s, g, r, d)


def _window_attention(q, k, v, scale):
    b, s, g, r, d = q.shape
    nb = s // WIN_BLOCK
    nprev = WINDOW // WIN_BLOCK
    pad = ((0, 0), (WINDOW, 0), (0, 0), (0, 0))
    kp = jnp.pad(k, pad).reshape(b, nb + nprev, WIN_BLOCK, g, d)
    vp = jnp.pad(v, pad).reshape(b, nb + nprev, WIN_BLOCK, g, d)
    band_k = jnp.concatenate([kp[:, i:i + nb] for i in range(nprev + 1)], axis=2)
    band_v = jnp.concatenate([vp[:, i:i + nb] for i in range(nprev + 1)], axis=2)
    qw = q.reshape(b, nb, WIN_BLOCK, g, r, d)
    sc = jnp.einsum('bnqgrd,bnkgd->bgrnqk', qw, band_k) * scale
    blk = jnp.arange(nb)[:, None] * WIN_BLOCK
    qpos = blk + jnp.arange(WIN_BLOCK)[None, :]
    kpos = blk - WINDOW + jnp.arange((nprev + 1) * WIN_BLOCK)[None, :]
    diff = qpos[:, :, None] - kpos[:, None, :]
    mask = (diff >= 0) & (diff < WINDOW) & (kpos[:, None, :] >= 0)
    p = _masked_softmax(sc, mask)
    o = jnp.einsum('bgrnqk,bnkgd->bnqgrd', p, band_v.astype(jnp.float32))
    return o.reshape(b, s, g, r, d)


def _nsa(q, k_cmp, v_cmp, k_slc, v_slc, k_win, v_win, gate_logits, q_norm,
         k_norm_cmp, k_norm_slc, k_norm_win, cmp_pos_k, cmp_pos_v,
         cmp_k_w1, cmp_k_w2, cmp_v_w1, cmp_v_w2):
    b, s, g, r, d = q.shape
    scale = HEAD_DIM ** -0.5
    t = jnp.arange(s)
    q = _rmsnorm(q, q_norm)
    kc = _rmsnorm(_compress(k_cmp, cmp_pos_k, cmp_k_w1, cmp_k_w2), k_norm_cmp)
    vc = _compress(v_cmp, cmp_pos_v, cmp_v_w1, cmp_v_w2).astype(jnp.float32)
    nc = kc.shape[1]
    ci = jnp.arange(nc)
    sc = jnp.einsum('bsgrd,bcgd->bgrsc', q, kc) * scale
    cmp_mask = (ci * CMP_STRIDE + CMP_BLOCK - 1)[None, :] <= t[:, None]
    p_cmp = _masked_softmax(sc, cmp_mask)
    o_cmp = jnp.einsum('bgrsc,bcgd->bsgrd', p_cmp, vc)
    ns = s // SLC_BLOCK
    j = jnp.arange(ns)
    overlap = ((ci[:, None] * CMP_STRIDE < (j[None, :] + 1) * SLC_BLOCK) &
               (ci[:, None] * CMP_STRIDE + CMP_BLOCK > j[None, :] * SLC_BLOCK)).astype(jnp.float32)
    imp = jnp.einsum('bgrsc,cj->bgsj', p_cmp, overlap)
    qblk = t // SLC_BLOCK
    force = (j[None, :] == 0) | (j[None, :] == qblk[:, None]) | (j[None, :] == qblk[:, None] - 1)
    score = jnp.where(j[None, :] <= qblk[:, None], imp + FORCE_BONUS * force.astype(jnp.float32), -1e30)
    _, sel = lax.top_k(score, min(SLC_TOPK, ns))
    o_slc = _selected_attention(q, _rmsnorm(k_slc, k_norm_slc), v_slc, sel, scale)
    o_win = _window_attention(q, _rmsnorm(k_win, k_norm_win), v_win, scale)
    gates = jax.nn.sigmoid(gate_logits.astype(jnp.float32)).reshape(b, s, 3, g, r, 1)
    o = gates[:, :, 0] * o_cmp + gates[:, :, 1] * o_slc + gates[:, :, 2] * o_win
    return o.reshape(b, s, NSA_WIDTH)


def _complex_affine_combine(e1, e2):
    a1r, a1i, b1r, b1i = e1
    a2r, a2i, b2r, b2i = e2
    return (a2r * a1r - a2i * a1i,
            a2r * a1i + a2i * a1r,
            a2r * b1r - a2i * b1i + b2r,
            a2r * b1i + a2i * b1r + b2i)


def _s5_glu(u, lambda_re, lambda_im, log_step, b_re, b_im, c_re, c_im, d_skip, glu_w):
    b, s, _ = u.shape
    u = u.astype(jnp.float32).reshape(b, s, SSM_GROUPS, SSM_GROUP)
    lr = lambda_re.astype(jnp.float32)
    li = lambda_im.astype(jnp.float32)
    step = jnp.exp(log_step.astype(jnp.float32))[:, None]
    mag = jnp.exp(lr * step)
    ar = mag * jnp.cos(li * step)
    ai = mag * jnp.sin(li * step)
    den = lr * lr + li * li
    cr = ((ar - 1.0) * lr + ai * li) / den
    cim = (ai * lr - (ar - 1.0) * li) / den
    br = b_re.astype(jnp.float32)
    bim = b_im.astype(jnp.float32)
    bbr = cr[..., None] * br - cim[..., None] * bim
    bbi = cr[..., None] * bim + cim[..., None] * br
    ur = jnp.einsum('bsgc,gpc->bsgp', u, bbr)
    ui = jnp.einsum('bsgc,gpc->bsgp', u, bbi)
    a_r = jnp.broadcast_to(ar[None, None], (1, s, SSM_GROUPS, SSM_STATE))
    a_i = jnp.broadcast_to(ai[None, None], (1, s, SSM_GROUPS, SSM_STATE))
    _, _, xr, xi = lax.associative_scan(_complex_affine_combine, (a_r, a_i, ur, ui), axis=1)
    y = (jnp.einsum('bsgp,gcp->bsgc', xr, c_re.astype(jnp.float32))
         - jnp.einsum('bsgp,gcp->bsgc', xi, c_im.astype(jnp.float32))
         + d_skip.astype(jnp.float32) * u)
    hg = jax.nn.gelu(y.reshape(b, s, SSM_WIDTH)) @ glu_w
    val, gate = jnp.split(hg, 2, axis=-1)
    return val * jax.nn.sigmoid(gate)


def _mixing(x, mix_norm, w_in, q_norm, k_norm_cmp, k_norm_slc, k_norm_win, cmp_pos_k, cmp_pos_v,
            cmp_k_w1, cmp_k_w2, cmp_v_w1, cmp_v_w2, w_nsa_proj, ssm_lambda_re, ssm_lambda_im,
            ssm_log_step, ssm_b_re, ssm_b_im, ssm_c_re, ssm_c_im, ssm_d, ssm_glu_w, w_out):
    b, s, _ = x.shape
    h = _rmsnorm(x, mix_norm)
    proj = h @ w_in
    sizes = [NSA_WIDTH] + [KV_WIDTH] * 6 + [3 * NSA_HEADS, SSM_WIDTH, D_MODEL, D_MODEL]
    cuts = [sum(sizes[:i + 1]) for i in range(len(sizes) - 1)]
    q, kc, vc, ks, vs, kw, vw, nsa_gate, ssm_u, gate_nsa, gate_ssm = jnp.split(proj, cuts, axis=-1)
    kvr = lambda z: z.reshape(b, s, NSA_KV_GROUPS, HEAD_DIM)
    o_nsa = _nsa(q.reshape(b, s, NSA_KV_GROUPS, Q_PER_KV, HEAD_DIM), kvr(kc), kvr(vc), kvr(ks), kvr(vs),
                 kvr(kw), kvr(vw), nsa_gate, q_norm, k_norm_cmp, k_norm_slc, k_norm_win,
                 cmp_pos_k, cmp_pos_v, cmp_k_w1, cmp_k_w2, cmp_v_w1, cmp_v_w2)
    y_nsa = o_nsa @ w_nsa_proj
    y_ssm = _s5_glu(ssm_u, ssm_lambda_re, ssm_lambda_im, ssm_log_step, ssm_b_re, ssm_b_im,
                    ssm_c_re, ssm_c_im, ssm_d, ssm_glu_w)
    merged = jax.nn.sigmoid(gate_nsa) * y_nsa + jax.nn.sigmoid(gate_ssm) * y_ssm
    return merged @ w_out


def setup_inputs(seed: int = 0) -> dict:
    key = jax.random.key(seed)
    ks = jax.random.split(key, 32)
    L = DEPTH
    nrm = lambda k, shape, sc: jax.random.normal(k, shape, jnp.float32) * sc
    gain = lambda k, n: 1.0 + 0.01 * jax.random.normal(k, (L, n), jnp.float32)
    lam_n = jnp.arange(SSM_STATE, dtype=jnp.float32)
    return {
        'x': nrm(ks[0], (BATCH, SEQ, D_MODEL), 1.0),
        'ffn1_norm': gain(ks[1], D_MODEL),
        'ffn1_w_gate': nrm(ks[2], (L, D_MODEL, D_FF), D_MODEL ** -0.5),
        'ffn1_w_up': nrm(ks[3], (L, D_MODEL, D_FF), D_MODEL ** -0.5),
        'ffn1_w_down': nrm(ks[4], (L, D_FF, D_MODEL), D_FF ** -0.5),
        'mix_norm': gain(ks[5], D_MODEL),
        'w_in': nrm(ks[6], (L, D_MODEL, IN_WIDTH), D_MODEL ** -0.5),
        'q_norm': gain(ks[7], HEAD_DIM),
        'k_norm_cmp': gain(ks[8], HEAD_DIM),
        'k_norm_slc': gain(ks[9], HEAD_DIM),
        'k_norm_win': gain(ks[10], HEAD_DIM),
        'cmp_pos_k': nrm(ks[11], (L, CMP_BLOCK, HEAD_DIM), 0.1),
        'cmp_pos_v': nrm(ks[12], (L, CMP_BLOCK, HEAD_DIM), 0.1),
        'cmp_k_w1': nrm(ks[13], (L, CMP_BLOCK * HEAD_DIM, CMP_HIDDEN), (CMP_BLOCK * HEAD_DIM) ** -0.5),
        'cmp_k_w2': nrm(ks[14], (L, CMP_HIDDEN, HEAD_DIM), CMP_HIDDEN ** -0.5),
        'cmp_v_w1': nrm(ks[15], (L, CMP_BLOCK * HEAD_DIM, CMP_HIDDEN), (CMP_BLOCK * HEAD_DIM) ** -0.5),
        'cmp_v_w2': nrm(ks[16], (L, CMP_HIDDEN, HEAD_DIM), CMP_HIDDEN ** -0.5),
        'w_nsa_proj': nrm(ks[17], (L, NSA_WIDTH, D_MODEL), NSA_WIDTH ** -0.5),
        'ssm_lambda_re': -0.5 + nrm(ks[18], (L, SSM_GROUPS, SSM_STATE), 0.01),
        'ssm_lambda_im': math.pi * lam_n + nrm(ks[19], (L, SSM_GROUPS, SSM_STATE), 0.01),
        'ssm_log_step': jax.random.uniform(ks[20], (L, SSM_GROUPS), jnp.float32,
                                           minval=math.log(1e-3), maxval=math.log(1e-1)),
        'ssm_b_re': nrm(ks[21], (L, SSM_GROUPS, SSM_STATE, SSM_GROUP), (2 * SSM_GROUP) ** -0.5),
        'ssm_b_im': nrm(ks[22], (L, SSM_GROUPS, SSM_STATE, SSM_GROUP), (2 * SSM_GROUP) ** -0.5),
        'ssm_c_re': nrm(ks[23], (L, SSM_GROUPS, SSM_GROUP, SSM_STATE), (2 * SSM_STATE) ** -0.5),
        'ssm_c_im': nrm(ks[24], (L, SSM_GROUPS, SSM_GROUP, SSM_STATE), (2 * SSM_STATE) ** -0.5),
        'ssm_d': nrm(ks[25], (L, SSM_GROUPS, SSM_GROUP), 1.0),
        'ssm_glu_w': nrm(ks[26], (L, SSM_WIDTH, 2 * D_MODEL), SSM_WIDTH ** -0.5),
        'w_out': nrm(ks[27], (L, D_MODEL, D_MODEL), D_MODEL ** -0.5),
        'ffn2_norm': gain(ks[28], D_MODEL),
        'ffn2_w_gate': nrm(ks[29], (L, D_MODEL, D_FF), D_MODEL ** -0.5),
        'ffn2_w_up': nrm(ks[30], (L, D_MODEL, D_FF), D_MODEL ** -0.5),
        'ffn2_w_down': nrm(ks[31], (L, D_FF, D_MODEL), D_FF ** -0.5),
    }


def reference(x, ffn1_norm, ffn1_w_gate, ffn1_w_up, ffn1_w_down, mix_norm, w_in, q_norm,
              k_norm_cmp, k_norm_slc, k_norm_win, cmp_pos_k, cmp_pos_v, cmp_k_w1, cmp_k_w2,
              cmp_v_w1, cmp_v_w2, w_nsa_proj, ssm_lambda_re, ssm_lambda_im, ssm_log_step,
              ssm_b_re, ssm_b_im, ssm_c_re, ssm_c_im, ssm_d, ssm_glu_w, w_out,
              ffn2_norm, ffn2_w_gate, ffn2_w_up, ffn2_w_down):
    in_dtype = x.dtype
    h = x.astype(jnp.float32)
    for l in range(DEPTH):
        h = h + 0.5 * _swiglu(h, ffn1_norm[l], ffn1_w_gate[l], ffn1_w_up[l], ffn1_w_down[l])
        h = h + _mixing(h, mix_norm[l], w_in[l], q_norm[l], k_norm_cmp[l], k_norm_slc[l],
                        k_norm_win[l], cmp_pos_k[l], cmp_pos_v[l], cmp_k_w1[l], cmp_k_w2[l],
                        cmp_v_w1[l], cmp_v_w2[l], w_nsa_proj[l], ssm_lambda_re[l],
                        ssm_lambda_im[l], ssm_log_step[l], ssm_b_re[l], ssm_b_im[l],
                        ssm_c_re[l], ssm_c_im[l], ssm_d[l], ssm_glu_w[l], w_out[l])
        h = h + 0.5 * _swiglu(h, ffn2_norm[l], ffn2_w_gate[l], ffn2_w_up[l], ffn2_w_down[l])
    return h.astype(in_dtype)
```

```cpp
#include <hip/hip_runtime.h>
#include <cstdint>
#include <cstdio>

typedef unsigned short bf16_t;
constexpr int BATCH = 8, SEQ = 4096, DM = 1024, T = BATCH * SEQ;
constexpr int FF = 2816, NH = 8, NG = 2, HD = 64;
constexpr int INW = 3864, NCMP = 255;
constexpr int SSM_G = 32, SSM_C = 16, SSM_P = 64;
constexpr float RMS_EPS = 1e-6f;
constexpr float C2 = 0.125f * 1.4426950408889634f;

__device__ __forceinline__ float bf2f(bf16_t v) { return __uint_as_float(((unsigned)v) << 16); }
__device__ __forceinline__ bf16_t f2bf(float f) { unsigned u = __float_as_uint(f); return (bf16_t)((u + 0x7fffu + ((u >> 16) & 1u)) >> 16); }
__device__ __forceinline__ unsigned pk2(float lo, float hi) { return (unsigned)f2bf(lo) | ((unsigned)f2bf(hi) << 16); }
__device__ __forceinline__ float sigmoidf_(float x) { return 1.f / (1.f + __expf(-x)); }
__device__ __forceinline__ float gelu_tanh(float x) { const float u = 0.7978845608028654f * (x + 0.044715f * x * x * x); return 0.5f * x * (1.f + tanhf(u)); }
__device__ __forceinline__ float fsigmoid(float x) { return __builtin_amdgcn_rcpf(1.f + __builtin_amdgcn_exp2f(-1.4426950408889634f * x)); }
__device__ __forceinline__ float fgelu_tanh(float x) { const float u = 0.7978845608028654f * (x + 0.044715f * x * x * x); return x * fsigmoid(2.f * u); }
__device__ __forceinline__ float wave_sum(float v) {
#pragma unroll
    for (int o = 1; o < 64; o <<= 1) v += __shfl_xor(v, o);
    return v;
}
__device__ __forceinline__ float wave_max(float v) {
#pragma unroll
    for (int o = 1; o < 64; o <<= 1) v = fmaxf(v, __shfl_xor(v, o));
    return v;
}

constexpr size_t MiB = 1u << 20;
constexpr size_t WS_CTL = 0, CTL_ZERO_BYTES = 32 * 1024;
constexpr size_t WS_W1GU = 1 * MiB;
constexpr size_t WS_W1D = 12 * MiB;
constexpr size_t WS_WIN = 18 * MiB;
constexpr size_t WS_WC1K = 26 * MiB;
constexpr size_t WS_WC1V = 27 * MiB;
constexpr size_t WS_MISC = 28 * MiB;
constexpr size_t WS_WNSA = 29 * MiB;
constexpr size_t WS_WGLU = 30 * MiB;
constexpr size_t WS_WOUT = 32 * MiB;
constexpr size_t WS_W2GU = 34 * MiB;
constexpr size_t WS_W2D = 45 * MiB;
constexpr size_t WS_W1S = 51 * MiB;
constexpr size_t WS_WTOEP = 60 * MiB;
constexpr size_t WS_KTAB = 132 * MiB;
constexpr size_t WS_SSQ = 134 * MiB;
constexpr size_t WS_G3 = 136 * MiB;
constexpr size_t WS_HID = 139 * MiB;
constexpr size_t WS_KCMP = 143 * MiB;
constexpr size_t WS_VCMP = 143 * MiB + 512 * 1024;
constexpr size_t WS_SSMP = 144 * MiB;
constexpr size_t WS_SST = 145 * MiB;
constexpr size_t WS_XN = 161 * MiB;
constexpr size_t WS_BIG = 225 * MiB;
constexpr size_t WS_ACT = WS_BIG;
constexpr size_t WS_SGN = WS_BIG;
constexpr size_t WS_SGS = WS_BIG + 64 * MiB;
constexpr size_t WS_Q = WS_BIG + 128 * MiB;
constexpr size_t WS_KS = WS_BIG + 160 * MiB;
constexpr size_t WS_VS = WS_BIG + 168 * MiB;
constexpr size_t WS_KW = WS_BIG + 176 * MiB;
constexpr size_t WS_VW = WS_BIG + 184 * MiB;
constexpr size_t WS_KCR = WS_BIG + 192 * MiB;
constexpr size_t WS_VCR = WS_BIG + 201 * MiB;
constexpr size_t WS_ACAT = WS_BIG + 210 * MiB;
constexpr size_t WS_OWIN = WS_BIG + 246 * MiB;
constexpr size_t WS_M1 = WS_BIG + 128 * MiB;
constexpr size_t WS_MERGED = WS_BIG + 192 * MiB;
constexpr size_t WS_ONSA = WS_XN;
constexpr size_t WS_GELUY = WS_XN + 32 * MiB;
constexpr size_t WS_END = 512 * MiB;
constexpr int ACAT_LD = 1152;

namespace pg8 {
#define PG8_LAS __attribute__((address_space(3)))
typedef short bf16x8 __attribute__((ext_vector_type(8)));
typedef float f32x4 __attribute__((ext_vector_type(4)));
typedef float f32x2 __attribute__((ext_vector_type(2)));
typedef unsigned u32x4 __attribute__((ext_vector_type(4)));
typedef unsigned u32x2 __attribute__((ext_vector_type(2)));
constexpr int BM = 256, BK = 64, HALF = 128, HTB = HALF * BK * 2  , STAGE_BYTES = 8 * HTB, NXCD = 8, WGM = 8;

__host__ __device__ __forceinline__ int lds_byte(int r, int c) { const int st = (r >> 4) * 2 + (c >> 5), rr = r & 15, cc = c & 31, ob = rr * 64 + cc * 2; return st * 1024 + (ob ^ (((ob >> 9) & 1) << 5)); }
__host__ __device__ __forceinline__ void stage_rc(int b, int& R, int& C) { const int st = b / 1024, sb = b % 1024, swz = sb ^ (((sb >> 9) & 1) << 5); R = (st >> 1) * 16 + swz / 64; C = (st & 1) * 32 + (swz % 64) / 2; }
__host__ __device__ __forceinline__ int perm32(int rho) { const int n = rho >> 4, i = rho & 15; return 8 * (i >> 2) + 4 * n + (i & 3); }

struct Unit { int pm, pn, pg; };
struct Gemm { const bf16_t* A; const bf16_t* Bt; int lda, ldb, K; size_t gsA, gsB; };

struct StaticOrder {
    int nM, nN, nwg, G, c;
    __host__ __device__ __forceinline__ void init(int M, int N, int G_, int c_) { nM = M / BM; nN = N / BM; nwg = nM * nN; G = G_; c = c_; }
    __host__ __device__ __forceinline__ bool next(int i, Unit& u) const {
        const long L = (long)i * G + c; if (L >= nwg) return false;
        int wgid = (int)L; { const int q = nwg / NXCD, r = nwg % NXCD, xcd = wgid % NXCD, off = wgid / NXCD; wgid = (xcd < r ? xcd * (q + 1) : r * (q + 1) + (xcd - r) * q) + off; }
        const int nig = WGM * nN, gid = wgid / nig, fm = gid * WGM, gsz = (nM - fm) < WGM ? (nM - fm) : WGM;
        u.pm = fm + ((wgid % nig) % gsz); u.pn = (wgid % nig) / gsz; u.pg = 0; return true;
    }
};
struct GroupOrder {
    int nM, nN, ng, G, c;
    __host__ __device__ __forceinline__ void init(int nM_, int nN_, int ng_, int G_, int c_) { nM = nM_; nN = nN_; ng = ng_; G = G_; c = c_; }
    __host__ __device__ __forceinline__ bool next(int i, Unit& u) const {
        if (c < 0) return false;
        const long L = (long)i * G + c; if (L >= (long)ng * nM * nN) return false;
        const int per = nM * nN, r = (int)(L % per); u.pg = (int)(L / per); u.pm = r % nM; u.pn = r / nM; return true;
    }
};

struct SplitOrder {
    StaticOrder S;
    __host__ __device__ __forceinline__ bool next(int i, Unit& u) const { Unit t; if (!S.next(i >> 1, t)) return false; u.pm = t.pm; u.pn = 2 * t.pn + (i & 1); u.pg = 0; return true; }
};
typedef __bf16 bf16x2_t __attribute__((ext_vector_type(2)));
__device__ __forceinline__ unsigned cvt_pk_bf16(float lo, float hi) { f32x2 v = {lo, hi}; bf16x2_t b = __builtin_convertvector(v, bf16x2_t); return __builtin_bit_cast(unsigned, b); }

template <class Epi, class Sched, bool ALIGN_EPI = false, bool SP2 = false>
__device__ __forceinline__ void gemm_phase(PG8_LAS unsigned char* lds, const Gemm g, const Sched& S, const Epi& E) {
    const int tid = threadIdx.x, wid = __builtin_amdgcn_readfirstlane(tid >> 6), lane = tid & 63, wr = wid >> 2, wc = wid & 3, fr = lane & 15, fq = lane >> 4;
    const int K = g.K, nt = K / BK;
    unsigned voffA[2], voffB[2];
#pragma unroll
    for (int i = 0; i < 2; ++i) { int R, C; stage_rc(tid * 16 + i * 8192, R, C); const int Rb = Epi::PERM ? ((R & ~31) + perm32(R & 31)) : R;
        voffA[i] = (unsigned)(R * g.lda + C) * 2u; voffB[i] = (unsigned)(Rb * g.ldb + C) * 2u; }
    const size_t kstep = (size_t)(BK * 2);
    const size_t hstepA = (size_t)HALF * g.lda * 2, hstepB = (size_t)HALF * g.ldb * 2;
    const size_t tstepA = 2 * hstepA, tstepB = 2 * hstepB;
    const unsigned ldsw = (unsigned)wid * 1024u;
    const int aoff = lds_byte(wr * 64 + fr, fq * 8), boff = lds_byte(wc * 32 + fr, fq * 8);
#define PG8_SA(b, h) (((b) * 2 + (h)) * HTB)
#define PG8_SB(b, h) ((4 + (b) * 2 + (h)) * HTB)
#define PG8_STAGE(bufoff, gbase, voff) do { _Pragma("unroll") for (int _i = 0; _i < 2; ++_i) \
        __builtin_amdgcn_global_load_lds((const unsigned*)((const char*)(gbase) + (voff)[_i]), (PG8_LAS unsigned*)(lds + (bufoff) + ldsw + _i * 8192), 16, 0, 0); } while (0)
#define PG8_LDA(dst, b, h) do { _Pragma("unroll") for (int m = 0; m < 4; ++m) _Pragma("unroll") for (int k = 0; k < 2; ++k) dst[m][k] = *(const PG8_LAS bf16x8*)(lds + PG8_SA(b, h) + aoff + m * 2048 + k * 1024); } while (0)
#define PG8_LDB(dst, b, h) do { _Pragma("unroll") for (int n = 0; n < 2; ++n) _Pragma("unroll") for (int k = 0; k < 2; ++k) dst[n][k] = *(const PG8_LAS bf16x8*)(lds + PG8_SB(b, h) + boff + n * 2048 + k * 1024); } while (0)
#define PG8_MMA(ai, bj, At, Bt) do { __builtin_amdgcn_s_setprio(1); _Pragma("unroll") for (int m = 0; m < 4; ++m) _Pragma("unroll") for (int n = 0; n < 2; ++n) _Pragma("unroll") for (int k = 0; k < 2; ++k) \
        acc[ai][bj][m][n] = __builtin_amdgcn_mfma_f32_16x16x32_bf16(Bt[n][k], At[m][k], acc[ai][bj][m][n], 0, 0, 0); __builtin_amdgcn_s_setprio(0); } while (0)
#define PG8_WAIT_V(n) asm volatile("s_waitcnt vmcnt(" #n ")" ::: "memory")
#define PG8_WAIT_L(n) asm volatile("s_waitcnt lgkmcnt(" #n ")" ::: "memory")
#define PG8_BAR __builtin_amdgcn_s_barrier()
#define PG8_SCHED __builtin_amdgcn_sched_barrier(0)
    Unit cur, nxt; int ui = 0;
    if (!S.next(0, cur)) return;
    f32x4 acc[2][2][4][2];
    if constexpr (Epi::HAS_INIT) E.init(acc, cur, wr, wc, fr, fq);
    else {
#pragma unroll
    for (int a = 0; a < 2; ++a)
#pragma unroll
        for (int b = 0; b < 2; ++b)
#pragma unroll
            for (int m = 0; m < 4; ++m)
#pragma unroll
                for (int n = 0; n < 2; ++n) acc[a][b][m][n] = (f32x4){0.f, 0.f, 0.f, 0.f};
    }
    bf16x8 At[4][2], B0[2][2], B1[2][2];
    const char* cA = (const char*)g.A + (size_t)cur.pg * g.gsA + (size_t)cur.pm * tstepA; const char* cB = (const char*)g.Bt + (size_t)cur.pg * g.gsB + (size_t)cur.pn * tstepB;
    if constexpr (SP2) {
        PG8_STAGE(PG8_SB(0, 0), cB, voffB); PG8_STAGE(PG8_SB(0, 1), cB + hstepB, voffB); PG8_STAGE(PG8_SA(0, 0), cA, voffA); PG8_STAGE(PG8_SA(0, 1), cA + hstepA, voffA);
        if (wr == 1) PG8_BAR;
        PG8_WAIT_V(2); PG8_BAR;
        PG8_STAGE(PG8_SB(1, 0), cB + kstep, voffB); PG8_STAGE(PG8_SA(1, 0), cA + kstep, voffA); PG8_STAGE(PG8_SB(1, 1), cB + hstepB + kstep, voffB);
        PG8_WAIT_V(6); PG8_BAR;
    } else {
        PG8_STAGE(PG8_SB(0, 0), cB, voffB); PG8_STAGE(PG8_SA(0, 0), cA, voffA); PG8_STAGE(PG8_SB(0, 1), cB + hstepB, voffB); PG8_STAGE(PG8_SA(0, 1), cA + hstepA, voffA);
        if (wr == 1) PG8_BAR;
        PG8_WAIT_V(4); PG8_BAR;
        PG8_STAGE(PG8_SB(1, 0), cB + kstep, voffB); PG8_STAGE(PG8_SA(1, 0), cA + kstep, voffA); PG8_STAGE(PG8_SB(1, 1), cB + hstepB + kstep, voffB);
        PG8_WAIT_V(6); PG8_BAR;
    }
    for (;;) {
        const bool has_next = S.next(ui + 1, nxt);
        const char* nA = has_next ? (const char*)g.A + (size_t)nxt.pg * g.gsA + (size_t)nxt.pm * tstepA : cA; const char* nB = has_next ? (const char*)g.Bt + (size_t)nxt.pg * g.gsB + (size_t)nxt.pn * tstepB : cB;
        for (int t = 0; t < nt; t += 2) {
            const bool last = (t == nt - 2);
            const char* a1 = cA + (size_t)(t + 1) * kstep;
            const char* a2 = last ? nA : cA + (size_t)(t + 2) * kstep; const char* b2 = last ? nB : cB + (size_t)(t + 2) * kstep;
            const char* a3 = a2 + kstep; const char* b3 = b2 + kstep;
            if constexpr (SP2) {
            PG8_LDB(B0, 0, 0); PG8_LDB(B1, 0, 1); PG8_SCHED; PG8_LDA(At, 0, 0); PG8_STAGE(PG8_SA(1, 1), a1 + hstepA, voffA);
            PG8_WAIT_V(8); PG8_WAIT_L(0); PG8_BAR; PG8_MMA(0, 0, At, B0); PG8_MMA(0, 1, At, B1); PG8_BAR; PG8_SCHED;
            PG8_LDA(At, 0, 1); PG8_STAGE(PG8_SB(0, 0), b2, voffB); PG8_STAGE(PG8_SB(0, 1), b2 + hstepB, voffB); PG8_STAGE(PG8_SA(0, 0), a2, voffA);
            PG8_WAIT_V(8); PG8_WAIT_L(0); PG8_BAR; PG8_MMA(1, 0, At, B0); PG8_MMA(1, 1, At, B1); PG8_BAR; PG8_SCHED;
            PG8_LDB(B0, 1, 0); PG8_LDB(B1, 1, 1); PG8_SCHED; PG8_LDA(At, 1, 0); PG8_STAGE(PG8_SA(0, 1), a2 + hstepA, voffA);
            PG8_WAIT_V(8); PG8_WAIT_L(0); PG8_BAR; PG8_MMA(0, 0, At, B0); PG8_MMA(0, 1, At, B1); PG8_BAR; PG8_SCHED;
            PG8_LDA(At, 1, 1); PG8_STAGE(PG8_SB(1, 0), b3, voffB); PG8_STAGE(PG8_SB(1, 1), b3 + hstepB, voffB); PG8_STAGE(PG8_SA(1, 0), a3, voffA);
            PG8_WAIT_V(8); PG8_WAIT_L(0); PG8_BAR; PG8_MMA(1, 0, At, B0); PG8_MMA(1, 1, At, B1); PG8_BAR; PG8_SCHED;
            } else {
            PG8_LDB(B0, 0, 0); PG8_SCHED; PG8_LDA(At, 0, 0); PG8_STAGE(PG8_SA(1, 1), a1 + hstepA, voffA);
            PG8_WAIT_L(8); PG8_BAR; PG8_WAIT_L(0); PG8_MMA(0, 0, At, B0); PG8_BAR; PG8_SCHED;
            PG8_LDB(B1, 0, 1); PG8_STAGE(PG8_SB(0, 0), b2, voffB);
            PG8_BAR; PG8_WAIT_L(0); PG8_MMA(0, 1, At, B1); PG8_BAR;
            PG8_LDA(At, 0, 1); PG8_STAGE(PG8_SA(0, 0), a2, voffA);
            PG8_BAR; PG8_WAIT_L(0); PG8_MMA(1, 0, At, B0); PG8_BAR; PG8_SCHED;
            PG8_STAGE(PG8_SB(0, 1), b2 + hstepB, voffB);
            PG8_WAIT_V(6); PG8_BAR; PG8_MMA(1, 1, At, B1); PG8_BAR;
            PG8_LDB(B0, 1, 0); PG8_SCHED; PG8_LDA(At, 1, 0); PG8_STAGE(PG8_SA(0, 1), a2 + hstepA, voffA);
            PG8_WAIT_L(8); PG8_BAR; PG8_WAIT_L(0); PG8_MMA(0, 0, At, B0); PG8_BAR; PG8_SCHED;
            PG8_LDB(B1, 1, 1); PG8_STAGE(PG8_SB(1, 0), b3, voffB);
            PG8_BAR; PG8_WAIT_L(0); PG8_MMA(0, 1, At, B1); PG8_BAR;
            PG8_LDA(At, 1, 1); PG8_STAGE(PG8_SA(1, 0), a3, voffA);
            PG8_BAR; PG8_WAIT_L(0); PG8_MMA(1, 0, At, B0); PG8_BAR; PG8_SCHED;
            PG8_STAGE(PG8_SB(1, 1), b3 + hstepB, voffB);
            PG8_WAIT_V(6); PG8_BAR; PG8_MMA(1, 1, At, B1); PG8_BAR;
            }
        }
        if constexpr (ALIGN_EPI) { if (wr == 0) PG8_BAR; }
        if constexpr (!Epi::AFTER_DRAIN) { E(acc, cur, wr, wc, fr, fq); }
        if (!has_next) break;
        if constexpr (Epi::HAS_INIT) E.init(acc, nxt, wr, wc, fr, fq);
        else {
#pragma unroll
        for (int a = 0; a < 2; ++a)
#pragma unroll
            for (int b = 0; b < 2; ++b)
#pragma unroll
                for (int m = 0; m < 4; ++m)
#pragma unroll
                    for (int n = 0; n < 2; ++n) acc[a][b][m][n] = (f32x4){0.f, 0.f, 0.f, 0.f};
        }
        cur = nxt; cA = nA; cB = nB; ++ui;
        if constexpr (ALIGN_EPI) { if (wr == 1) PG8_BAR; }
    }
    PG8_WAIT_V(0);
    if constexpr (!ALIGN_EPI) { if (wr == 0) PG8_BAR; }
    PG8_BAR;
    if constexpr (Epi::AFTER_DRAIN) { E.fused(acc, cur, wr, wc, fr, fq, lds, wid, lane); }
#undef PG8_SA
#undef PG8_SB
#undef PG8_STAGE
#undef PG8_LDA
#undef PG8_LDB
#undef PG8_MMA
#undef PG8_WAIT_V
#undef PG8_WAIT_L
#undef PG8_BAR
#undef PG8_SCHED
}
}
#define PG8_SP2 true
#define PG8_ALIGN true

namespace epi {
using pg8::f32x4; using pg8::u32x4; using pg8::u32x2; using pg8::Unit; using pg8::cvt_pk_bf16;
constexpr int HALF = 128, BM = 256;

__device__ __forceinline__ float rstd_row(const float* ssq, int row, int fq) {
    const f32x4 p = *(const f32x4*)(ssq + (size_t)row * 16 + 4 * fq);
    float s = (p[0] + p[1]) + (p[2] + p[3]);
    s += __shfl_xor(s, 16); s += __shfl_xor(s, 32);
    return rsqrtf(s * (1.f / DM) + RMS_EPS);
}
__device__ __forceinline__ void rstd8(const float* ssq, int row0, int fq, float (&rs)[8]) {
    f32x4 p[8];
#pragma unroll
    for (int i = 0; i < 8; ++i) p[i] = *(const f32x4*)(ssq + (size_t)(row0 + (i >> 2) * HALF + (i & 3) * 16) * 16 + 4 * fq);
#pragma unroll
    for (int i = 0; i < 8; ++i) { float s = (p[i][0] + p[i][1]) + (p[i][2] + p[i][3]); s += __shfl_xor(s, 16); s += __shfl_xor(s, 32); rs[i] = rsqrtf(s * (1.f / DM) + RMS_EPS); }
}
__device__ __forceinline__ u32x4 pack8(const f32x4& a, const f32x4& b) { u32x4 w; w.x = cvt_pk_bf16(a[0], a[1]); w.y = cvt_pk_bf16(a[2], a[3]); w.z = cvt_pk_bf16(b[0], b[1]); w.w = cvt_pk_bf16(b[2], b[3]); return w; }

struct EpiSwiGLU {
    static constexpr bool PERM = true, AFTER_DRAIN = false, HAS_INIT = false;
    bf16_t* act; const float* ssq;
    __device__ __forceinline__ void operator()(const f32x4 (&acc)[2][2][4][2], const Unit& u, int wr, int wc, int fr, int fq) const {
        const int row0 = u.pm * BM + wr * 64 + fr, col0 = u.pn * HALF + wc * 32 + 8 * fq;
        float rs8[8]; rstd8(ssq, row0, fq, rs8);
#pragma unroll
        for (int ai = 0; ai < 2; ++ai)
#pragma unroll
            for (int m = 0; m < 4; ++m) { const int row = row0 + ai * HALF + m * 16; const float rs = rs8[ai * 4 + m];
                f32x4 o[2];
#pragma unroll
                for (int n = 0; n < 2; ++n)
#pragma unroll
                    for (int j = 0; j < 4; ++j) { const float gv = acc[ai][0][m][n][j] * rs, uv = acc[ai][1][m][n][j] * rs; o[n][j] = gv * fsigmoid(gv) * uv; }
                *(u32x4*)(act + (size_t)row * FF + col0) = pack8(o[0], o[1]); }
    }
};

__device__ __forceinline__ void unpack8(const u32x4& w, f32x4& a, f32x4& b) {
    a[0] = __uint_as_float(w.x << 16); a[1] = __uint_as_float(w.x & 0xffff0000u); a[2] = __uint_as_float(w.y << 16); a[3] = __uint_as_float(w.y & 0xffff0000u);
    b[0] = __uint_as_float(w.z << 16); b[1] = __uint_as_float(w.z & 0xffff0000u); b[2] = __uint_as_float(w.w << 16); b[3] = __uint_as_float(w.w & 0xffff0000u);
}
template <bool IN_BF16, bool OUT_F32>
struct EpiResid {
    static constexpr bool PERM = true, AFTER_DRAIN = false, HAS_INIT = true;
    const float* xin; const bf16_t* xb_in; float* out; float alpha; bf16_t* xb_out; float* ssq;
    __device__ __forceinline__ void init(f32x4 (&acc)[2][2][4][2], const Unit& u, int wr, int wc, int fr, int fq) const {
        const int row0 = u.pm * BM + wr * 64 + fr, col0 = u.pn * BM + wc * 32 + 8 * fq; const float ia = 1.f / alpha;
        if constexpr (IN_BF16) {
            u32x4 t[2][4][2];
#pragma unroll
            for (int ai = 0; ai < 2; ++ai)
#pragma unroll
                for (int m = 0; m < 4; ++m)
#pragma unroll
                    for (int bj = 0; bj < 2; ++bj) t[ai][m][bj] = *(const u32x4*)(xb_in + (size_t)(row0 + ai * HALF + m * 16) * DM + col0 + bj * HALF);
#pragma unroll
            for (int ai = 0; ai < 2; ++ai)
#pragma unroll
                for (int m = 0; m < 4; ++m)
#pragma unroll
                    for (int bj = 0; bj < 2; ++bj) { f32x4 a, b; unpack8(t[ai][m][bj], a, b); acc[ai][bj][m][0] = a * ia; acc[ai][bj][m][1] = b * ia; }
        } else {
#pragma unroll
            for (int ai = 0; ai < 2; ++ai)
#pragma unroll
                for (int m = 0; m < 4; ++m)
#pragma unroll
                    for (int bj = 0; bj < 2; ++bj) { const size_t ix = (size_t)(row0 + ai * HALF + m * 16) * DM + col0 + bj * HALF;
                        acc[ai][bj][m][0] = *(const f32x4*)(xin + ix); acc[ai][bj][m][1] = *(const f32x4*)(xin + ix + 4); }
#pragma unroll
            for (int ai = 0; ai < 2; ++ai)
#pragma unroll
                for (int m = 0; m < 4; ++m)
#pragma unroll
                    for (int bj = 0; bj < 2; ++bj) { acc[ai][bj][m][0] *= ia; acc[ai][bj][m][1] *= ia; }
        }
    }
    __device__ __forceinline__ void operator()(const f32x4 (&acc)[2][2][4][2], const Unit& u, int wr, int wc, int fr, int fq) const {
        const int row0 = u.pm * BM + wr * 64 + fr, col0 = u.pn * BM + wc * 32 + 8 * fq;
#pragma unroll
        for (int ai = 0; ai < 2; ++ai)
#pragma unroll
            for (int m = 0; m < 4; ++m) { const int row = row0 + ai * HALF + m * 16; float ss = 0.f;
#pragma unroll
                for (int bj = 0; bj < 2; ++bj) { const size_t ix = (size_t)row * DM + col0 + bj * HALF;
                    const f32x4 o0 = acc[ai][bj][m][0] * alpha, o1 = acc[ai][bj][m][1] * alpha;
                    if constexpr (OUT_F32) { *(f32x4*)(out + ix) = o0; *(f32x4*)(out + ix + 4) = o1; }
                    else { *(u32x4*)(xb_out + ix) = pack8(o0, o1);
                        ss += (o0[0] * o0[0] + o0[1] * o0[1]) + (o0[2] * o0[2] + o0[3] * o0[3]) + (o1[0] * o1[0] + o1[1] * o1[1]) + (o1[2] * o1[2] + o1[3] * o1[3]); } }
                if constexpr (!OUT_F32) { ss += __shfl_xor(ss, 16); ss += __shfl_xor(ss, 32); if (fq == 0) ssq[(size_t)row * 16 + u.pn * 4 + wc] = ss; } }
    }
};

__device__ __forceinline__ void unpack8u(const u32x2& w, f32x4& a, f32x4& b) {
    const float k = 1.f / 255.f;
    a[0] = (float)(w.x & 255u) * k; a[1] = (float)((w.x >> 8) & 255u) * k; a[2] = (float)((w.x >> 16) & 255u) * k; a[3] = (float)(w.x >> 24) * k;
    b[0] = (float)(w.y & 255u) * k; b[1] = (float)((w.y >> 8) & 255u) * k; b[2] = (float)((w.y >> 16) & 255u) * k; b[3] = (float)(w.y >> 24) * k;
}
struct EpiWin {
    static constexpr bool PERM = true, AFTER_DRAIN = false, HAS_INIT = false;
    const float* ssq; bf16_t *q, *ks, *vs, *kw, *vw, *kcr, *vcr, *acat, *sgn, *sgs; float* g3; const float *q_norm, *k_norm_slc, *k_norm_win;
    __device__ __forceinline__ void operator()(const f32x4 (&acc)[2][2][4][2], const Unit& u, int wr, int wc, int fr, int fq) const {
        const int row0 = u.pm * BM + wr * 64 + fr, pn = u.pn;
        float rs8[8]; rstd8(ssq, row0, fq, rs8);
        if (pn < 5) {
            const int slot = 4 * pn + wc;
            bf16_t* base; int nh, idx; const float* gain = nullptr; float scale = 1.f;
            if (slot < 8) { base = q; nh = NH; idx = slot; gain = q_norm; scale = C2; }
            else if (slot < 10) { base = kcr; nh = NG; idx = slot - 8; }
            else if (slot < 12) { base = vcr; nh = NG; idx = slot - 10; }
            else if (slot < 14) { base = ks; nh = NG; idx = slot - 12; gain = k_norm_slc; }
            else if (slot < 16) { base = vs; nh = NG; idx = slot - 14; }
            else if (slot < 18) { base = kw; nh = NG; idx = slot - 16; gain = k_norm_win; }
            else { base = vw; nh = NG; idx = slot - 18; }
            f32x4 gv[2][2];
#pragma unroll
            for (int bj = 0; bj < 2; ++bj)
#pragma unroll
                for (int n = 0; n < 2; ++n) gv[bj][n] = gain ? *(const f32x4*)(gain + 32 * bj + 8 * fq + 4 * n) * scale : (f32x4){1.f, 1.f, 1.f, 1.f};
#pragma unroll
            for (int ai = 0; ai < 2; ++ai)
#pragma unroll
                for (int m = 0; m < 4; ++m) { const int row = row0 + ai * HALF + m * 16; const float rs = rs8[ai * 4 + m]; const int b = row / SEQ, s = row % SEQ;
                    f32x4 v[2][2]; float ss = 0.f;
#pragma unroll
                    for (int bj = 0; bj < 2; ++bj)
#pragma unroll
                        for (int n = 0; n < 2; ++n) { v[bj][n] = acc[ai][bj][m][n] * rs; ss += (v[bj][n][0] * v[bj][n][0] + v[bj][n][1] * v[bj][n][1]) + (v[bj][n][2] * v[bj][n][2] + v[bj][n][3] * v[bj][n][3]); }
                    float rn = 1.f;
                    if (gain) { ss += __shfl_xor(ss, 16); ss += __shfl_xor(ss, 32); rn = rsqrtf(ss * (1.f / 64.f) + RMS_EPS); }
                    bf16_t* dst = base + (((size_t)b * nh + idx) * SEQ + s) * 64 + 8 * fq;
#pragma unroll
                    for (int bj = 0; bj < 2; ++bj) *(u32x4*)(dst + 32 * bj) = pack8(v[bj][0] * gv[bj][0] * rn, v[bj][1] * gv[bj][1] * rn); }
        } else if (pn < 7) {
#pragma unroll
            for (int ai = 0; ai < 2; ++ai)
#pragma unroll
                for (int m = 0; m < 4; ++m) { const int row = row0 + ai * HALF + m * 16; const float rs = rs8[ai * 4 + m]; const int b = row / SEQ, s = row % SEQ;
#pragma unroll
                    for (int bj = 0; bj < 2; ++bj) { const int ch0 = 256 * (pn - 5) + 128 * bj + 32 * wc + 8 * fq, g = ch0 >> 4, ci0 = ch0 & 15;
                        *(u32x4*)(acat + ((size_t)g * 512 + b * 64 + (s >> 6)) * ACAT_LD + (s & 63) * 16 + ci0) = pack8(acc[ai][bj][m][0] * rs, acc[ai][bj][m][1] * rs); } }
        } else if (pn < 15) {
            unsigned char* dstb = (unsigned char*)(pn < 11 ? sgn : sgs) + 256 * (pn - (pn < 11 ? 7 : 11)) + 32 * wc + 8 * fq;
#pragma unroll
            for (int ai = 0; ai < 2; ++ai)
#pragma unroll
                for (int m = 0; m < 4; ++m) { const int row = row0 + ai * HALF + m * 16; const float rs = rs8[ai * 4 + m];
#pragma unroll
                    for (int bj = 0; bj < 2; ++bj) { f32x4 a, b2;
#pragma unroll
                        for (int j = 0; j < 4; ++j) { a[j] = fsigmoid(acc[ai][bj][m][0][j] * rs) * 255.f + 0.5f; b2[j] = fsigmoid(acc[ai][bj][m][1][j] * rs) * 255.f + 0.5f; }
                        u32x2 w; w.x = (unsigned)a[0] | ((unsigned)a[1] << 8) | ((unsigned)a[2] << 16) | ((unsigned)a[3] << 24); w.y = (unsigned)b2[0] | ((unsigned)b2[1] << 8) | ((unsigned)b2[2] << 16) | ((unsigned)b2[3] << 24);
                        *(u32x2*)(dstb + (size_t)row * DM + 128 * bj) = w; } }
        } else {
#pragma unroll
            for (int ai = 0; ai < 2; ++ai)
#pragma unroll
                for (int m = 0; m < 4; ++m) { const int row = row0 + ai * HALF + m * 16; const float rs = rs8[ai * 4 + m];
                    if (wc == 0 && fq < 3) {
#pragma unroll
                        for (int n = 0; n < 2; ++n) { f32x4 a;
#pragma unroll
                            for (int j = 0; j < 4; ++j) a[j] = fsigmoid(acc[ai][0][m][n][j] * rs);
                            *(f32x4*)(g3 + (size_t)row * 24 + 8 * fq + 4 * n) = a; } } }
        }
    }
};
struct EpiNsa {
    static constexpr bool PERM = true, AFTER_DRAIN = false, HAS_INIT = false;
    const bf16_t* sgn; bf16_t* m1;
    __device__ __forceinline__ void operator()(const f32x4 (&acc)[2][2][4][2], const Unit& u, int wr, int wc, int fr, int fq) const {
        const int row0 = u.pm * BM + wr * 64 + fr, col0 = u.pn * BM + wc * 32 + 8 * fq;
#pragma unroll
        for (int ai = 0; ai < 2; ++ai) {
            u32x2 g[4][2];
#pragma unroll
            for (int m = 0; m < 4; ++m)
#pragma unroll
                for (int bj = 0; bj < 2; ++bj) g[m][bj] = *(const u32x2*)((const unsigned char*)sgn + (size_t)(row0 + ai * HALF + m * 16) * DM + col0 + bj * HALF);
#pragma unroll
            for (int m = 0; m < 4; ++m)
#pragma unroll
                for (int bj = 0; bj < 2; ++bj) { const size_t ix = (size_t)(row0 + ai * HALF + m * 16) * DM + col0 + bj * HALF; f32x4 ga, gb; unpack8u(g[m][bj], ga, gb);
                    *(u32x4*)(m1 + ix) = pack8(ga * acc[ai][bj][m][0], gb * acc[ai][bj][m][1]); }
        }
    }
};
struct EpiGlu {
    static constexpr bool PERM = true, AFTER_DRAIN = false, HAS_INIT = false;
    const bf16_t* sgs; const bf16_t* m1; bf16_t* merged;
    __device__ __forceinline__ void operator()(const f32x4 (&acc)[2][2][4][2], const Unit& u, int wr, int wc, int fr, int fq) const {
        const int row0 = u.pm * BM + wr * 64 + fr, col0 = u.pn * HALF + wc * 32 + 8 * fq;
#pragma unroll
        for (int ai = 0; ai < 2; ++ai) {
            u32x2 gs[4]; u32x4 mm[4];
#pragma unroll
            for (int m = 0; m < 4; ++m) { const size_t ix = (size_t)(row0 + ai * HALF + m * 16) * DM + col0; gs[m] = *(const u32x2*)((const unsigned char*)sgs + ix); mm[m] = *(const u32x4*)(m1 + ix); }
#pragma unroll
            for (int m = 0; m < 4; ++m) { const size_t ix = (size_t)(row0 + ai * HALF + m * 16) * DM + col0;
                f32x4 ga, gb, ma, mb; unpack8u(gs[m], ga, gb); unpack8(mm[m], ma, mb);
                f32x4 oa, ob;
#pragma unroll
                for (int j = 0; j < 4; ++j) { oa[j] = ma[j] + ga[j] * acc[ai][0][m][0][j] * fsigmoid(acc[ai][1][m][0][j]); ob[j] = mb[j] + gb[j] * acc[ai][0][m][1][j] * fsigmoid(acc[ai][1][m][1][j]); }
                *(u32x4*)(merged + ix) = pack8(oa, ob); }
        }
    }
};
struct EpiCmp1 {
    static constexpr bool PERM = true, AFTER_DRAIN = false, HAS_INIT = false;
    bf16_t* hid; const float* biasp;
    __device__ __forceinline__ void operator()(const f32x4 (&acc)[2][2][4][2], const Unit& u, int wr, int wc, int fr, int fq) const {
        const int row0 = u.pm * BM + wr * 64 + fr, col0 = wc * 32 + 8 * fq;
        f32x4 bv[2][2];
#pragma unroll
        for (int bj = 0; bj < 2; ++bj)
#pragma unroll
            for (int n = 0; n < 2; ++n) { f32x4 s = {0.f, 0.f, 0.f, 0.f};
#pragma unroll
                for (int k = 0; k < 8; ++k) s += *(const f32x4*)(biasp + ((size_t)u.pg * 8 + k) * 256 + col0 + bj * HALF + 4 * n);
                bv[bj][n] = s; }
#pragma unroll
        for (int ai = 0; ai < 2; ++ai)
#pragma unroll
            for (int m = 0; m < 4; ++m) { const int row = row0 + ai * HALF + m * 16;
#pragma unroll
                for (int bj = 0; bj < 2; ++bj) { f32x4 a, b2;
#pragma unroll
                    for (int j = 0; j < 4; ++j) { a[j] = fgelu_tanh(acc[ai][bj][m][0][j] + bv[bj][0][j]); b2[j] = fgelu_tanh(acc[ai][bj][m][1][j] + bv[bj][1][j]); }
                    *(u32x4*)(hid + ((size_t)u.pg * 4096 + row) * 256 + col0 + bj * HALF) = pack8(a, b2); } }
    }
};
struct EpiSst {
    static constexpr bool PERM = false, AFTER_DRAIN = false, HAS_INIT = false;
    float* S;
    __device__ __forceinline__ void operator()(const f32x4 (&acc)[2][2][4][2], const Unit& u, int wr, int wc, int fr, int fq) const {
        const int row0 = u.pm * BM + wr * 64 + fr, col0 = wc * 32 + 4 * fq;
#pragma unroll
        for (int ai = 0; ai < 2; ++ai)
#pragma unroll
            for (int m = 0; m < 4; ++m) { float* rp = S + ((size_t)u.pg * 512 + row0 + ai * HALF + m * 16) * 128 + col0;
#pragma unroll
                for (int n = 0; n < 2; ++n) *(f32x4*)(rp + 16 * n) = acc[ai][0][m][n]; }
    }
};
struct EpiSsmOut {
    static constexpr bool PERM = true, AFTER_DRAIN = false, HAS_INIT = false;
    const bf16_t* acat; const float* dskip; bf16_t* geluy;
    __device__ __forceinline__ void operator()(const f32x4 (&acc)[2][2][4][2], const Unit& u, int wr, int wc, int fr, int fq) const {
        const int g = u.pg, row0 = u.pm * BM + wr * 64 + fr;
        f32x4 dv[2];
#pragma unroll
        for (int bj = 0; bj < 2; ++bj) { }
        const int co0 = 8 * (fq & 1);
        dv[0] = *(const f32x4*)(dskip + g * 16 + co0); dv[1] = *(const f32x4*)(dskip + g * 16 + co0 + 4);
#pragma unroll
        for (int ai = 0; ai < 2; ++ai) {
            u32x4 uu[4][2];
#pragma unroll
            for (int m = 0; m < 4; ++m)
#pragma unroll
                for (int bj = 0; bj < 2; ++bj) uu[m][bj] = *(const u32x4*)(acat + ((size_t)g * 512 + row0 + ai * HALF + m * 16) * ACAT_LD + u.pn * BM + bj * HALF + wc * 32 + 8 * fq);
#pragma unroll
            for (int m = 0; m < 4; ++m) { const int rr = row0 + ai * HALF + m * 16, b = rr >> 6, c = rr & 63;
#pragma unroll
                for (int bj = 0; bj < 2; ++bj) { const int col = u.pn * BM + bj * HALF + wc * 32 + 8 * fq, i = col >> 4;
                    f32x4 ua, ub; unpack8(uu[m][bj], ua, ub);
                    f32x4 ya = acc[ai][bj][m][0] + dv[0] * ua, yb = acc[ai][bj][m][1] + dv[1] * ub;
#pragma unroll
                    for (int j = 0; j < 4; ++j) { ya[j] = fgelu_tanh(ya[j]); yb[j] = fgelu_tanh(yb[j]); }
                    *(u32x4*)(geluy + ((size_t)b * SEQ + 64 * c + i) * 512 + 16 * g + co0) = pack8(ya, yb); } }
        }
    }
};
}

constexpr int NWAVES = 8;
constexpr int RING_OFF = 0, RING_BYTES = 131072;
constexpr int LDS_BYTES = 163840;
constexpr int LDSCTL_OFF = LDS_BYTES - 512, MISC_OFF = LDSCTL_OFF + 320;
constexpr int CW_TMO = 0, CW_CODE = 1, CW_TOEP = 64, CW_BAR = 4096;

#define GAS __attribute__((address_space(1)))
#define LAS __attribute__((address_space(3)))
typedef unsigned v4u __attribute__((ext_vector_type(4)));
typedef float f32x4 __attribute__((ext_vector_type(4)));
typedef GAS unsigned gu32;
#define RLX_AGENT __ATOMIC_RELAXED, __HIP_MEMORY_SCOPE_AGENT
#define LDS_WAIT() asm volatile("s_waitcnt lgkmcnt(0)" ::: "memory")
#define VM_WAIT() asm volatile("s_waitcnt vmcnt(0)" ::: "memory")

#define XB_TMO      128
#define XB_XCNT(j)  (256  + 64 * (j))
#define XB_XSUB(j)  (1280 + 64 * (j))
#define XB_XGEN(j)  (2304 + 64 * (j))
#define XB_TOP      3328
#define XB_TOPGEN   3392
#define XCD_BAR_WORDS 3456
#define XB_SPIN_CAP (1u << 18)
__device__ __forceinline__ unsigned xb_ld(unsigned* p)              { return __hip_atomic_load(p, __ATOMIC_RELAXED, __HIP_MEMORY_SCOPE_AGENT); }
__device__ __forceinline__ unsigned xb_add(unsigned* p, unsigned v) { return __hip_atomic_fetch_add(p, v, __ATOMIC_RELAXED, __HIP_MEMORY_SCOPE_AGENT); }
__device__ __forceinline__ unsigned xb_xcc_id() { return (unsigned)__builtin_amdgcn_s_getreg((3 << 11) | 20) & 0xFu; }
#define XB_SPIN(cond, bar) do { unsigned _sp = 0; while (cond) { __builtin_amdgcn_s_sleep(1); \
    if ((++_sp & 255u) == 0u) { if (xb_ld(&(bar)[XB_TMO])) break; if (_sp > XB_SPIN_CAP) { atomicAdd(&(bar)[XB_TMO], 1u); break; } } } } while (0)
struct XcdBarrier { unsigned* bar; unsigned x; volatile LAS unsigned* st; };
__device__ __forceinline__ XcdBarrier xcd_barrier_post(unsigned* bar, volatile LAS unsigned* st) {
    XcdBarrier b; b.bar = bar; b.x = xb_xcc_id(); b.st = st;
    if (threadIdx.x == 0) (void)xb_add(&bar[XB_XCNT(b.x)], 1u);
    return b;
}
__device__ __forceinline__ void xcd_barrier_complete(unsigned* bar, unsigned x, unsigned& nloc, unsigned& nx) {
    const unsigned G = gridDim.x * gridDim.y * gridDim.z;
    unsigned sum, cnt, mine, sp = 0u;
    for (;;) {
        sum = 0u; cnt = 0u; mine = 0u;
#pragma unroll
        for (unsigned j = 0; j < 16; ++j) { const unsigned c = xb_ld(&bar[XB_XCNT(j)]); sum += c; cnt += (c > 0u) ? 1u : 0u; mine = (j == x) ? c : mine; }
        if (sum == G) break;
        __builtin_amdgcn_s_sleep(1);
        if ((++sp & 255u) == 0u) { if (xb_ld(&bar[XB_TMO])) break; if (sp > XB_SPIN_CAP) { atomicAdd(&bar[XB_TMO], 1u); break; } }
    }
    nloc = mine > 0u ? mine : 1u; nx = cnt > 0u ? cnt : 1u;
}
__device__ __forceinline__ void xcd_barrier(const XcdBarrier& b) {
    asm volatile("s_waitcnt vmcnt(0)" ::: "memory");
    __syncthreads();
    if (threadIdx.x == 0) {
        unsigned* bar = b.bar;
        __builtin_amdgcn_s_waitcnt(0);
        unsigned nloc = b.st[0], nx = b.st[1];
        if (nloc == 0u) { xcd_barrier_complete(bar, b.x, nloc, nx); b.st[0] = nloc; b.st[1] = nx; }
        const unsigned old = xb_add(&bar[XB_XSUB(b.x)], 1u);
        const unsigned gen = old / nloc;
        if (old + 1u == (gen + 1u) * nloc) {
            __builtin_amdgcn_fence(__ATOMIC_RELEASE, "agent");
            asm volatile("s_waitcnt vmcnt(0)" ::: "memory");
            const unsigned og = xb_add(&bar[XB_TOP], 1u);
            const unsigned tg = og / nx;
            if (og + 1u == (tg + 1u) * nx) xb_add(&bar[XB_TOPGEN], 1u);
            else XB_SPIN(xb_ld(&bar[XB_TOPGEN]) == tg, bar);
            __builtin_amdgcn_fence(__ATOMIC_ACQUIRE, "agent");
            xb_add(&bar[XB_XGEN(b.x)], 1u);
            asm volatile("s_waitcnt vmcnt(0)" ::: "memory");
        } else {
            XB_SPIN(xb_ld(&bar[XB_XGEN(b.x)]) == gen, bar);
            __builtin_amdgcn_fence(__ATOMIC_ACQUIRE, "agent");
            asm volatile("s_waitcnt vmcnt(0)" ::: "memory");
        }
    }
    __syncthreads();
}

struct Args { const float* in[32]; float* out; unsigned char* ws; int ph_lo, ph_hi, fused, pad; };
struct Frame {
    LAS unsigned char* lds; volatile LAS unsigned* MISC; gu32* ctl;
    int tid, lane, wave, vcu, G;
};
enum Phase { PH_PRO = 0, PH_F1GU, PH_F1D, PH_WIN, PH_MIDA, PH_MIDB, PH_NSA, PH_GLU, PH_WOUT, PH_F2GU, PH_F2D, NPH };

template <class MAP>
__device__ __forceinline__ void transpose_item(const float* W, int ldw, bf16_t* WT, int ldt, int k0, int n0, const MAP& srccol, LAS float* scr, int lane, const float* rowscale = nullptr) {
    const int n4 = (lane & 7) * 4, sc = srccol(n0 + n4), kr = lane >> 3;
    f32x4 v[8];
#pragma unroll
    for (int i = 0; i < 8; ++i) v[i] = sc >= 0 ? *(const f32x4*)(W + (size_t)(k0 + kr + 8 * i) * ldw + sc) : (f32x4){0.f, 0.f, 0.f, 0.f};
    if (rowscale) {
#pragma unroll
        for (int i = 0; i < 8; ++i) v[i] = v[i] * rowscale[k0 + kr + 8 * i];
    }
#pragma unroll
    for (int i = 0; i < 8; ++i) { LAS float* d = scr + (kr + 8 * i) * 33 + n4; d[0] = v[i][0]; d[1] = v[i][1]; d[2] = v[i][2]; d[3] = v[i][3]; }
    LDS_WAIT(); asm volatile("" ::: "memory");
    const int c = lane & 7;
#pragma unroll
    for (int j = 0; j < 4; ++j) { const int n = (lane >> 3) + 8 * j; const LAS float* s = scr + (8 * c) * 33 + n;
        v4u o; o.x = pk2(s[0 * 33], s[1 * 33]); o.y = pk2(s[2 * 33], s[3 * 33]); o.z = pk2(s[4 * 33], s[5 * 33]); o.w = pk2(s[6 * 33], s[7 * 33]);
        *(GAS v4u*)(WT + (size_t)(n0 + n) * ldt + k0 + 8 * c) = o; }
    LDS_WAIT(); asm volatile("" ::: "memory");
}
__device__ __forceinline__ void prep_row2(const float* x0, const float* x1, const float* g, bf16_t* o0, bf16_t* o1, float* q0, float* q1, int lane) {
    const GAS f32x4* xa = (const GAS f32x4*)x0 + lane; const GAS f32x4* xb = (const GAS f32x4*)x1 + lane; (void)g;
    f32x4 va[4], vb[4];
#pragma unroll
    for (int j = 0; j < 4; ++j) { va[j] = xa[64 * j]; vb[j] = xb[64 * j]; }
    GAS unsigned long long* oa = (GAS unsigned long long*)o0 + lane; GAS unsigned long long* ob = (GAS unsigned long long*)o1 + lane;
    float sa = 0.f, sb = 0.f;
#pragma unroll
    for (int j = 0; j < 4; ++j) { const f32x4 a = va[j], b = vb[j];
        sa += (a.x * a.x + a.y * a.y) + (a.z * a.z + a.w * a.w); sb += (b.x * b.x + b.y * b.y) + (b.z * b.z + b.w * b.w);
        oa[64 * j] = (unsigned long long)pk2(a.x, a.y) | ((unsigned long long)pk2(a.z, a.w) << 32);
        ob[64 * j] = (unsigned long long)pk2(b.x, b.y) | ((unsigned long long)pk2(b.z, b.w) << 32); }
    sa = wave_sum(sa); sb = wave_sum(sb);
    if (lane < 16) { q0[lane] = (lane == 0) ? sa : 0.f; q1[lane] = (lane == 0) ? sb : 0.f; }
}
__device__ __forceinline__ void prep_row(const float* xrow, const float* g, bf16_t* orow, float* ssqrow, int lane) {
    const GAS f32x4* xr = (const GAS f32x4*)xrow + lane; const GAS f32x4* gr = (const GAS f32x4*)g + lane;
    GAS unsigned long long* o8 = (GAS unsigned long long*)orow + lane;
    float s = 0.f;
#pragma unroll
    for (int j = 0; j < 4; ++j) { const f32x4 v = xr[64 * j], gg = gr[64 * j]; s += (v.x * v.x + v.y * v.y) + (v.z * v.z + v.w * v.w);
        o8[64 * j] = (unsigned long long)pk2(v.x * gg.x, v.y * gg.y) | ((unsigned long long)pk2(v.z * gg.z, v.w * gg.w) << 32); }
    s = wave_sum(s);
    if (lane < 16) ssqrow[lane] = (lane == 0) ? s : 0.f;
}

struct Cplx { double r, i; };
__device__ __forceinline__ Cplx cmul(Cplx a, Cplx b) { return Cplx{a.r * b.r - a.i * b.i, a.r * b.i + a.i * b.r}; }
__device__ __forceinline__ Cplx apow(double lr, double li, double step, double e) { const double m = exp(lr * step * e), ang = li * step * e; return Cplx{m * cos(ang), m * sin(ang)}; }

__device__ __forceinline__ void ssm_weights_task(const Args& a, int g, int i, int lane, LAS float* scr) {
    unsigned char* ws = a.ws;
    const int p = lane;
    const double lr = a.in[18][g * 64 + p], li = a.in[19][g * 64 + p], step = exp((double)a.in[20][g]);
    const Cplx a1 = apow(lr, li, step, 1.0);
    const double den = lr * lr + li * li;
    const Cplx coef{((a1.r - 1.0) * lr + a1.i * li) / den, (a1.i * lr - (a1.r - 1.0) * li) / den};
    const Cplx ab = apow(lr, li, step, (double)(63 - i)), ac = apow(lr, li, step, (double)i), ad = apow(lr, li, step, (double)(i + 1));
    float zr[16], zi[16];
    bf16_t* w1s = (bf16_t*)(ws + WS_W1S) + ((size_t)g * 128) * 1024;
    {
        unsigned pr[8], pi[8];
#pragma unroll
        for (int c = 0; c < 16; ++c) { const Cplx bb = cmul(coef, Cplx{(double)a.in[21][(g * 64 + p) * 16 + c], (double)a.in[22][(g * 64 + p) * 16 + c]});
            const Cplx zb = cmul(ab, bb), zc = cmul(ac, bb); zr[c] = (float)zc.r; zi[c] = (float)zc.i;
            const unsigned br = f2bf((float)zb.r), bi = f2bf((float)zb.i);
            if (c & 1) { pr[c >> 1] |= br << 16; pi[c >> 1] |= bi << 16; } else { pr[c >> 1] = br; pi[c >> 1] = bi; } }
        v4u* dr = (v4u*)(w1s + (size_t)p * 1024 + i * 16); v4u* di = (v4u*)(w1s + (size_t)(64 + p) * 1024 + i * 16);
        dr[0] = (v4u){pr[0], pr[1], pr[2], pr[3]}; dr[1] = (v4u){pr[4], pr[5], pr[6], pr[7]};
        di[0] = (v4u){pi[0], pi[1], pi[2], pi[3]}; di[1] = (v4u){pi[4], pi[5], pi[6], pi[7]};
    }
#pragma unroll
    for (int c = 0; c < 16; ++c) { scr[p * 16 + c] = zr[c]; scr[1024 + p * 16 + c] = zi[c]; }
    LDS_WAIT(); asm volatile("" ::: "memory");
    {
        const int co = lane >> 2, c4 = (lane & 3) * 4;
        f32x4 acc = {0.f, 0.f, 0.f, 0.f};
        for (int pp = 0; pp < 64; ++pp) { const float cr = a.in[23][(g * 16 + co) * 64 + pp], cm = a.in[24][(g * 16 + co) * 64 + pp];
            const f32x4 r4 = *(const LAS f32x4*)(scr + pp * 16 + c4), i4 = *(const LAS f32x4*)(scr + 1024 + pp * 16 + c4);
            acc += r4 * cr - i4 * cm; }
        *(f32x4*)((float*)(ws + WS_KTAB) + (((size_t)g * 64 + i) * 16 + co) * 16 + c4) = acc;
    }
    LDS_WAIT(); asm volatile("" ::: "memory");
    bf16_t* wt = (bf16_t*)(ws + WS_WTOEP) + ((size_t)g * 1024 + i * 16) * ACAT_LD + 1024;
#pragma unroll 4
    for (int co = 0; co < 16; ++co) { const Cplx z = cmul(Cplx{(double)a.in[23][(g * 16 + co) * 64 + p], (double)a.in[24][(g * 16 + co) * 64 + p]}, ad);
        wt[(size_t)co * ACAT_LD + p] = f2bf((float)z.r); wt[(size_t)co * ACAT_LD + 64 + p] = f2bf((float)(-z.i)); }
}
__device__ __forceinline__ void toep_row(unsigned char* ws, int row, int lane) {
    const int g = row >> 10, i = (row >> 4) & 63, co = row & 15, ip = lane;
    bf16_t* dst = (bf16_t*)(ws + WS_WTOEP) + (size_t)row * ACAT_LD + ip * 16;
    v4u o0 = {0u, 0u, 0u, 0u}, o1 = {0u, 0u, 0u, 0u};
    if (ip <= i) { const f32x4* k = (const f32x4*)((const float*)(ws + WS_KTAB) + (((size_t)g * 64 + (i - ip)) * 16 + co) * 16);
        const f32x4 k0 = k[0], k1 = k[1], k2 = k[2], k3 = k[3];
        o0 = (v4u){pk2(k0[0], k0[1]), pk2(k0[2], k0[3]), pk2(k1[0], k1[1]), pk2(k1[2], k1[3])};
        o1 = (v4u){pk2(k2[0], k2[1]), pk2(k2[2], k2[3]), pk2(k3[0], k3[1]), pk2(k3[2], k3[3])}; }
    ((v4u*)dst)[0] = o0; ((v4u*)dst)[1] = o1;
}
__device__ __forceinline__ void ssm_carry_scan(const Args& a, int g, int pm, int tid) {
    if (tid >= 256) return;
    unsigned char* ws = a.ws;
    const int bl = tid >> 6, p = tid & 63, b = 4 * pm + bl;
    const double lr = a.in[18][g * 64 + p], li = a.in[19][g * 64 + p], step = exp((double)a.in[20][g]);
    const Cplx a64 = apow(lr, li, step, 64.0); const float ar = (float)a64.r, ai = (float)a64.i;
    const float* S = (const float*)(ws + WS_SST) + ((size_t)g * 512 + b * 64) * 128;
    bf16_t* X = (bf16_t*)(ws + WS_ACAT) + ((size_t)g * 512 + b * 64) * ACAT_LD + 1024;
    float xr = 0.f, xi = 0.f;
#pragma unroll 8
    for (int c = 0; c < 64; ++c) {
        X[(size_t)c * ACAT_LD + p] = f2bf(xr); X[(size_t)c * ACAT_LD + 64 + p] = f2bf(xi);
        const float sr = S[c * 128 + p], si = S[c * 128 + 64 + p];
        const float nr = ar * xr - ai * xi + sr, ni = ar * xi + ai * xr + si; xr = nr; xi = ni;
    }
}
namespace nsa {
typedef short bf16x8 __attribute__((ext_vector_type(8)));
typedef short s16x4 __attribute__((ext_vector_type(4)));
typedef float f32x16 __attribute__((ext_vector_type(16)));
typedef unsigned u32x4 __attribute__((ext_vector_type(4)));
typedef LAS const char* lds_cptr;
constexpr int SLOTB = 8192;
constexpr int L_K = 0, L_V = 2 * SLOTB, L_WSF = 4 * SLOTB, L_IMP = L_WSF + 8 * 256, L_SEL = L_IMP + 64 * 65 * 4, L_UNI = L_SEL + 64 * 8, L_TL = L_UNI + 64, L_OACC = L_TL + 512, L_QF = L_OACC + 8 * 8192, L_GT = L_QF + 8 * 4096, L_DUMP = L_GT + 8 * 3 * 64 * 4, L_END = L_DUMP + 1024;
static_assert(L_END <= LDSCTL_OFF && L_QF % 16 == 0, "attention LDS map");
__device__ __forceinline__ int crow(int r, int hi) { return (r & 3) + 8 * (r >> 2) + 4 * hi; }
#define NSA_MFMA(a, b, c) __builtin_amdgcn_mfma_f32_32x32x16_bf16(a, b, c, 0, 0, 0)
enum { M_NONE = 0, M_CAUSAL = 1, M_WINLO = 2, M_CMP = 3, M_SEL = 4, M_SELCAUSAL = 5 };

struct Ctx {
    LAS unsigned char* lds; int wid, lane, r32, hi, th, hh;
};
__device__ __forceinline__ void glds16(const void* gsrc, unsigned lds_dst) { unsigned keep;
    asm volatile("s_mov_b32 %0, m0\n\ts_mov_b32 m0, %2\n\ts_nop 0\n\tglobal_load_lds_dwordx4 %1, off\n\ts_mov_b32 m0, %0" : "=&s"(keep) : "v"(gsrc), "s"(lds_dst) : "memory"); }
__device__ __forceinline__ unsigned lds_addr(const Ctx& c, int off) { return (unsigned)__builtin_amdgcn_readfirstlane((int)(unsigned)(uintptr_t)c.lds + off); }
__device__ __forceinline__ int koff(int i) { return i < 2 ? L_K + i * SLOTB : L_IMP; }
__device__ __forceinline__ int voff(int i) { return i < 2 ? L_V + i * SLOTB : L_IMP + SLOTB; }
__device__ __forceinline__ void dma_kv(const Ctx& c, const bf16_t* Kt, const bf16_t* Vt, int s) {
    const int krow_ = c.wid * 8 + (c.lane >> 3);
    const bf16_t* ks = Kt + krow_ * 64 + ((c.lane & 7) ^ ((krow_ >> 1) & 7)) * 8;
    const bf16_t* vs = Vt + (16 * (c.wid & 3) + (c.lane >> 2)) * 64 + (c.wid >> 2) * 32 + (c.lane & 3) * 8;
    glds16(ks, lds_addr(c, koff(s) + c.wid * 1024));
    glds16(vs, lds_addr(c, voff(s) + c.wid * 1024));
}
__device__ __forceinline__ void dma_v(const Ctx& c, const bf16_t* Vt, int s) {
    const bf16_t* vs = Vt + (16 * (c.wid & 3) + (c.lane >> 2)) * 64 + (c.wid >> 2) * 32 + (c.lane & 3) * 8;
    glds16(vs, lds_addr(c, voff(s) + c.wid * 1024));
}
__device__ __forceinline__ void dma_k(const Ctx& c, const bf16_t* Kt, int s) {
    const int krow_ = c.wid * 8 + (c.lane >> 3);
    const bf16_t* ks = Kt + krow_ * 64 + ((c.lane & 7) ^ ((krow_ >> 1) & 7)) * 8;
    glds16(ks, lds_addr(c, koff(s) + c.wid * 1024));
}
__device__ __forceinline__ void prefetch_tile(const Ctx& c, const bf16_t* t) { glds16(t + c.wid * 512 + c.lane * 8, lds_addr(c, L_DUMP)); }
#define NSA_WAITBAR2() asm volatile("s_waitcnt vmcnt(2) lgkmcnt(0)\n\ts_barrier" ::: "memory")
#define NSA_WAITBAR() asm volatile("s_waitcnt vmcnt(0) lgkmcnt(0)\n\ts_barrier" ::: "memory")

__device__ __forceinline__ int kfrag_off(const Ctx& c, int d0) { return c.r32 * 128 + (((2 * d0 + c.hi) ^ ((c.r32 >> 1) & 7)) << 4); }
__device__ __forceinline__ void qkt(f32x16& p0, f32x16& p1, const Ctx& c, int s, const bf16x8 (&qr)[4]) {
    const lds_cptr kb = (lds_cptr)(c.lds + koff(s));
    p0 = f32x16{}; p1 = f32x16{};
#pragma unroll
    for (int d0 = 0; d0 < 4; ++d0) {
        const int ko = kfrag_off(c, d0);
        const bf16x8 b0 = *(const LAS bf16x8*)(kb + ko), b1 = *(const LAS bf16x8*)(kb + ko + 4096);
        p0 = NSA_MFMA(b0, qr[d0], p0); p1 = NSA_MFMA(b1, qr[d0], p1);
    }
}
__device__ __forceinline__ s16x4 vtr(lds_cptr p) { typedef short v4i16_t __attribute__((ext_vector_type(4))); return __builtin_bit_cast(s16x4, __builtin_amdgcn_ds_read_tr16_b64_v4i16((LAS v4i16_t*)p)); }
__device__ __forceinline__ void pv(f32x16 (&o)[2], const Ctx& c, int s, const bf16x8 (&pa)[4]) {
    const lds_cptr vp = (lds_cptr)(c.lds + voff(s)) + ((c.lane >> 4) & 1) * 32 + (c.lane & 3) * 8 + (4 * c.hi + ((c.lane & 15) >> 2)) * 64;
#pragma unroll
    for (int d0 = 0; d0 < 2; ++d0) {
        s16x4 lo[4], hh[4];
#pragma unroll
        for (int ks = 0; ks < 4; ++ks) { lo[ks] = vtr(vp + d0 * 4096 + ks * 1024); hh[ks] = vtr(vp + d0 * 4096 + ks * 1024 + 512); }
        __builtin_amdgcn_sched_barrier(0);
#pragma unroll
        for (int ks = 0; ks < 4; ++ks) { const bf16x8 vf = {lo[ks][0], lo[ks][1], lo[ks][2], lo[ks][3], hh[ks][0], hh[ks][1], hh[ks][2], hh[ks][3]}; o[d0] = NSA_MFMA(pa[ks], vf, o[d0]); }
        __builtin_amdgcn_sched_barrier(0);
    }
}
__device__ __forceinline__ float rowmax32(const f32x16& p0, const f32x16& p1) {
    float a = fmaxf(p0[0], p1[0]);
#pragma unroll
    for (int r = 1; r < 16; ++r) a = fmaxf(a, fmaxf(p0[r], p1[r]));
    return fmaxf(a, __shfl_xor(a, 32));
}
__device__ __forceinline__ unsigned cvtpk(float lo, float hi) { return pg8::cvt_pk_bf16(lo, hi); }
__device__ __forceinline__ void pack_p(bf16x8 (&pa)[4], const f32x16& p0, const f32x16& p1) {
    pa[0] = __builtin_bit_cast(bf16x8, (u32x4){cvtpk(p0[0], p0[1]), cvtpk(p0[2], p0[3]), cvtpk(p0[4], p0[5]), cvtpk(p0[6], p0[7])});
    pa[1] = __builtin_bit_cast(bf16x8, (u32x4){cvtpk(p0[8], p0[9]), cvtpk(p0[10], p0[11]), cvtpk(p0[12], p0[13]), cvtpk(p0[14], p0[15])});
    pa[2] = __builtin_bit_cast(bf16x8, (u32x4){cvtpk(p1[0], p1[1]), cvtpk(p1[2], p1[3]), cvtpk(p1[4], p1[5]), cvtpk(p1[6], p1[7])});
    pa[3] = __builtin_bit_cast(bf16x8, (u32x4){cvtpk(p1[8], p1[9]), cvtpk(p1[10], p1[11]), cvtpk(p1[12], p1[13]), cvtpk(p1[14], p1[15])});
}
template <int MODE>
__device__ __forceinline__ void apply_mask(f32x16& p0, f32x16& p1, int hi, int ql, int lim, bool rowsel) {
    if (MODE == M_NONE) return;
    const float NEG = -INFINITY;
    const int qh = ql - 4 * hi, lh = lim - 4 * hi;
#pragma unroll
    for (int r = 0; r < 16; ++r) {
        const int kc = (r & 3) + 8 * (r >> 2);
        bool v0 = true, v1 = true;
        if (MODE == M_CAUSAL || MODE == M_SELCAUSAL) { v0 = kc <= qh; v1 = kc + 32 <= qh; }
        if (MODE == M_WINLO) { v0 = kc > qh; v1 = kc + 32 > qh; }
        if (MODE == M_CMP) { v0 = kc <= lh; v1 = kc + 32 <= lh; }
        if (MODE == M_SEL || MODE == M_SELCAUSAL) { v0 = v0 && rowsel; v1 = v1 && rowsel; }
        if (!v0) p0[r] = NEG; if (!v1) p1[r] = NEG;
    }
}
struct Sm { float m, l; };
__device__ __forceinline__ float rowmax32_3(const f32x16& p0, const f32x16& p1) {
    float a = __builtin_fmaxf(__builtin_fmaxf(p0[0], p0[1]), p1[0]), b = __builtin_fmaxf(__builtin_fmaxf(p0[2], p0[3]), p1[1]);
    a = __builtin_fmaxf(__builtin_fmaxf(a, p1[2]), p1[3]);
#pragma unroll
    for (int r = 4; r < 16; r += 4) { a = __builtin_fmaxf(__builtin_fmaxf(a, p0[r]), p0[r + 1]); b = __builtin_fmaxf(__builtin_fmaxf(b, p0[r + 2]), p0[r + 3]);
        a = __builtin_fmaxf(__builtin_fmaxf(a, p1[r]), p1[r + 1]); b = __builtin_fmaxf(__builtin_fmaxf(b, p1[r + 2]), p1[r + 3]); }
    a = __builtin_fmaxf(a, b);
    return __builtin_fmaxf(a, __shfl_xor(a, 32));
}
constexpr float RESCALE_THR = 8.0f;
#define SGB(mask, n) __builtin_amdgcn_sched_group_barrier(mask, n, 0)
__device__ __forceinline__ void rescale_rows(Sm& st, f32x16 (&o)[2], f32x16& p0, f32x16& p1, const Ctx& c, float rm, bool first) {
    const float dl = first ? (rm > -INFINITY ? rm : 0.f) : __builtin_fmaxf(rm, 0.f), f = __builtin_amdgcn_exp2f(-dl);
    st.m += dl; st.l *= f;
#pragma unroll
    for (int r = 0; r < 16; ++r) { p0[r] -= dl; p1[r] -= dl; }
    LAS float* wsf = (LAS float*)(c.lds + L_WSF) + c.wid * 64;
    if (c.hi == 0) wsf[c.r32] = f;
    const LAS float* wsh = wsf + 4 * c.hi;
#pragma unroll
    for (int r = 0; r < 16; ++r) { const float fr_ = wsh[(r & 3) + 8 * (r >> 2)]; o[0][r] *= fr_; o[1][r] *= fr_; }
}
template <int DBG = 0>
__device__ __forceinline__ void exp_sum_pack(Sm& st, f32x16& p0, f32x16& p1, bf16x8 (&pa)[4]) {
    float sum = 0.f;
#pragma unroll
    for (int r = 0; r < 16; ++r) { if (!(DBG & 1)) { p0[r] = __builtin_amdgcn_exp2f(p0[r]); p1[r] = __builtin_amdgcn_exp2f(p1[r]); } sum += p0[r] + p1[r]; }
    st.l += sum;
    pack_p(pa, p0, p1);
}
__device__ __forceinline__ void read_kf(bf16x8 (&kf)[8], const Ctx& c, int ks) {
    const lds_cptr kb = (lds_cptr)(c.lds + koff(ks));
#pragma unroll
    for (int d0 = 0; d0 < 4; ++d0) { const int ko = kfrag_off(c, d0); kf[2 * d0] = *(const LAS bf16x8*)(kb + ko); kf[2 * d0 + 1] = *(const LAS bf16x8*)(kb + ko + 4096); }
}
__device__ __forceinline__ void read_vf(s16x4 (&vf)[16], const Ctx& c, int vs) {
    const lds_cptr vp = (lds_cptr)(c.lds + voff(vs)) + ((c.lane >> 4) & 1) * 32 + (c.lane & 3) * 8 + (4 * c.hi + ((c.lane & 15) >> 2)) * 64;
#pragma unroll
    for (int i = 0; i < 8; ++i) { vf[2 * i] = vtr(vp + (i >> 2) * 4096 + (i & 3) * 1024); vf[2 * i + 1] = vtr(vp + (i >> 2) * 4096 + (i & 3) * 1024 + 512); }
}
template <int DBG = 0>
__device__ __forceinline__ void block_b(f32x16& n0, f32x16& n1, const Ctx& c, const bf16x8 (&kf)[8], const bf16x8 (&qr)[4], s16x4 (&vf)[16], int vs, float cinit, Sm& st, f32x16& p0, f32x16& p1, bf16x8 (&pa)[4]) {
    read_vf(vf, c, vs);
    f32x16 cv;
#pragma unroll
    for (int r = 0; r < 16; ++r) cv[r] = cinit;
#pragma unroll
    for (int d0 = 0; d0 < 4; ++d0) { n0 = NSA_MFMA(kf[2 * d0], qr[d0], d0 == 0 ? cv : n0); n1 = NSA_MFMA(kf[2 * d0 + 1], qr[d0], d0 == 0 ? cv : n1); }
    exp_sum_pack<DBG>(st, p0, p1, pa);
}
template <bool HASN, int DBG = 0, bool NORESC = false>
__device__ __forceinline__ float block_c(f32x16 (&o)[2], const Ctx& c, const s16x4 (&vf)[16], const bf16x8 (&pa)[4], const f32x16& n0, const f32x16& n1, bf16x8 (&kf)[8], int ks2) {
    if (HASN) { if (ks2 >= 0) read_kf(kf, c, ks2); }
    float rm = -INFINITY;
#pragma unroll
    for (int i = 0; i < 8; ++i) { const bf16x8 v8 = {vf[2 * i][0], vf[2 * i][1], vf[2 * i][2], vf[2 * i][3], vf[2 * i + 1][0], vf[2 * i + 1][1], vf[2 * i + 1][2], vf[2 * i + 1][3]}; o[i >> 2] = NSA_MFMA(pa[i & 3], v8, o[i >> 2]); }
    if (HASN && !NORESC) rm = rowmax32_3(n0, n1);
    return rm;
}
#undef SGB
__device__ __forceinline__ void qk_first(f32x16& p0, f32x16& p1, const Ctx& c, int s, float cinit, int mode, int ql) {
    const lds_cptr kb = (lds_cptr)(c.lds + koff(s));
    const lds_cptr qb_ = (lds_cptr)(c.lds + L_QF + c.wid * 4096) + c.hi * 512 + c.r32 * 16;
    bf16x8 qr[4];
#pragma unroll
    for (int d0 = 0; d0 < 4; ++d0) qr[d0] = *(const LAS bf16x8*)(qb_ + d0 * 1024);
#pragma unroll
    for (int r = 0; r < 16; ++r) { p0[r] = cinit; p1[r] = cinit; }
#pragma unroll
    for (int d0 = 0; d0 < 4; ++d0) { const int ko = kfrag_off(c, d0); const bf16x8 b0 = *(const LAS bf16x8*)(kb + ko), b1 = *(const LAS bf16x8*)(kb + ko + 4096); p0 = NSA_MFMA(b0, qr[d0], p0); p1 = NSA_MFMA(b1, qr[d0], p1); }
    if (mode == M_CAUSAL) apply_mask<M_CAUSAL>(p0, p1, c.hi, ql, 0, true); else if (mode == M_WINLO) apply_mask<M_WINLO>(p0, p1, c.hi, ql, 0, true);
}
__device__ __forceinline__ void sm_stats(Sm& st, const Ctx& c, int s, const bf16x8 (&qr)[4], int lim) {
    f32x16 p0, p1; qkt(p0, p1, c, s, qr);
    apply_mask<M_CMP>(p0, p1, c.hi, 0, lim, true);
    const float rm = rowmax32(p0, p1), mn = fmaxf(st.m, rm), f = __builtin_amdgcn_exp2f(st.m - mn);
    st.m = mn;
    float sum = 0.f;
#pragma unroll
    for (int r = 0; r < 16; ++r) sum += __builtin_amdgcn_exp2f(p0[r] - mn) + __builtin_amdgcn_exp2f(p1[r] - mn);
    st.l = st.l * f + sum;
}
__device__ __forceinline__ void acc_scaled(const f32x16 (&o)[2], const Ctx& c, float fac_row) {
    LAS float* wsf = (LAS float*)(c.lds + L_WSF) + c.wid * 64;
    LAS float* oacc = (LAS float*)(c.lds + L_OACC) + c.wid * 2048;
    if (c.hi == 0) wsf[c.r32] = fac_row;
    const LAS float* wsh = wsf + 4 * c.hi; LAS float* oah = oacc + 4 * c.hi * 64 + c.r32;
#pragma unroll
    for (int r = 0; r < 16; ++r) { const int kc = (r & 3) + 8 * (r >> 2); const float fr_ = wsh[kc]; oah[kc * 64] += o[0][r] * fr_; oah[kc * 64 + 32] += o[1][r] * fr_; }
}

struct Tensors { const bf16_t *q, *kcmp, *vcmp, *ks, *vs, *kw, *vw; const float* g3; bf16_t* onsa; bf16_t* owin; bool bounded_slc, bounded_win; };
template <int DBG>
__device__ __forceinline__ void unit(const Tensors& T_, LAS unsigned char* lds, int b, int g, int qb, int flags) {
    int tid_ = threadIdx.x; asm volatile("" : "+v"(tid_));
    Ctx c; c.lds = lds; c.wid = __builtin_amdgcn_readfirstlane(tid_ >> 6); c.lane = tid_ & 63; c.r32 = c.lane & 31; c.hi = c.lane >> 5; c.th = c.wid & 1; c.hh = c.wid >> 1;
    const int tid = tid_, h = 4 * g + c.hh, t0 = qb * 64, ql = 32 * c.th + c.r32, tq = t0 + ql;
    const size_t tok = (size_t)b * SEQ + tq;
    const bf16_t* Qw = T_.q + (((size_t)b * NH + h) * SEQ + t0 + 32 * c.th) * 64;
    bf16x8 qr[4];
#pragma unroll
    for (int d0 = 0; d0 < 4; ++d0) qr[d0] = *(const bf16x8*)(Qw + (size_t)c.r32 * 64 + d0 * 16 + c.hi * 8);
    { LAS bf16x8* qf = (LAS bf16x8*)(lds + L_QF + c.wid * 4096 + c.hi * 512 + c.r32 * 16);
#pragma unroll
      for (int d0 = 0; d0 < 4; ++d0) qf[d0 * 64] = qr[d0]; }
    asm volatile("" :: "v"(qr[0]), "v"(qr[1]), "v"(qr[2]), "v"(qr[3]));
    const size_t bg = (size_t)b * NG + g;
    {
        if (flags & 1) { prefetch_tile(c, T_.kcmp + bg * 256 * 64); prefetch_tile(c, T_.vcmp + bg * 256 * 64);
            prefetch_tile(c, T_.ks + (bg * SEQ + (size_t)qb * 64) * 64); prefetch_tile(c, T_.vs + (bg * SEQ + (size_t)qb * 64) * 64); }
        if (flags & 2) { prefetch_tile(c, T_.kw + (bg * SEQ + (size_t)qb * 64) * 64); prefetch_tile(c, T_.vw + (bg * SEQ + (size_t)qb * 64) * 64);
            if (qb >= 8) { prefetch_tile(c, T_.kw + (bg * SEQ + (size_t)(qb - 8) * 64) * 64); prefetch_tile(c, T_.vw + (bg * SEQ + (size_t)(qb - 8) * 64) * 64); } }
        LAS float* gt = (LAS float*)(lds + L_GT) + c.wid * 192 + c.lane;
        gt[0] = T_.g3[tok * 24 + h]; gt[64] = T_.g3[tok * 24 + 8 + h]; gt[128] = T_.g3[tok * 24 + 16 + h];
    }
    { LAS f32x4* z = (LAS f32x4*)(lds + L_OACC) + c.wid * 512 + c.lane;
#pragma unroll
      for (int i = 0; i < 8; ++i) z[64 * i] = (f32x4){0.f, 0.f, 0.f, 0.f}; }

    if (flags & 1) {
        const bf16_t* KC = T_.kcmp + bg * 256 * 64; const bf16_t* VC = T_.vcmp + bg * 256 * 64;
        const int nct = ((t0 + 63 - 31) >> 4) / 64 + 1;
        const int cmax = (tq >= 31) ? ((tq - 31) >> 4) : -1;
        LAS unsigned* imp = (LAS unsigned*)(lds + L_IMP);
        for (int e = tid; e < 64 * 65; e += 512) imp[e] = 0u;
        Sm st{-1e30f, 0.f};
        dma_k(c, KC, 0);
        for (int n = 0; n < nct; ++n) {
            NSA_WAITBAR();
            if (n + 1 < nct) dma_k(c, KC + (size_t)(n + 1) * 4096, (n + 1) & 1);
            sm_stats(st, c, n & 1, qr, cmax - 64 * n);
        }
        const float lt = st.l + __shfl_xor(st.l, 32), inv = lt > 0.f ? 1.f / lt : 0.f;
        __syncthreads();
        f32x16 o[2]; o[0] = f32x16{}; o[1] = f32x16{};
        dma_kv(c, KC, VC, 0);
        for (int n = 0; n < nct; ++n) {
            NSA_WAITBAR();
            if (n + 1 < nct) dma_kv(c, KC + (size_t)(n + 1) * 4096, VC + (size_t)(n + 1) * 4096, (n + 1) & 1);
            f32x16 p0, p1; qkt(p0, p1, c, n & 1, qr);
            apply_mask<M_CMP>(p0, p1, c.hi, 0, cmax - 64 * n, true);
#pragma unroll
            for (int r = 0; r < 16; ++r) { p0[r] = __builtin_amdgcn_exp2f(p0[r] - st.m) * inv; p1[r] = __builtin_amdgcn_exp2f(p1[r] - st.m) * inv; }
#pragma unroll
            for (int rq = 0; rq < 4; ++rq) {
                const float s0 = (p0[4 * rq] + p0[4 * rq + 1]) + (p0[4 * rq + 2] + p0[4 * rq + 3]), s1 = (p1[4 * rq] + p1[4 * rq + 1]) + (p1[4 * rq + 2] + p1[4 * rq + 3]);
                const int j0 = 16 * n + 2 * rq + c.hi, j1 = j0 + 8;
                LAS unsigned* impr = imp + ql * 65 + 16 * n + c.hi;
                __hip_atomic_fetch_add(&impr[2 * rq], (unsigned)(s0 * 16777216.f + 0.5f), __ATOMIC_RELAXED, __HIP_MEMORY_SCOPE_WORKGROUP);
                __hip_atomic_fetch_add(&impr[2 * rq + 8], (unsigned)(s1 * 16777216.f + 0.5f), __ATOMIC_RELAXED, __HIP_MEMORY_SCOPE_WORKGROUP);
                if (j0 + 1 < 64) __hip_atomic_fetch_add(&impr[2 * rq + 1], (unsigned)(p0[4 * rq + 3] * 16777216.f + 0.5f), __ATOMIC_RELAXED, __HIP_MEMORY_SCOPE_WORKGROUP);
                if (j1 + 1 < 64) __hip_atomic_fetch_add(&impr[2 * rq + 9], (unsigned)(p1[4 * rq + 3] * 16777216.f + 0.5f), __ATOMIC_RELAXED, __HIP_MEMORY_SCOPE_WORKGROUP);
            }
            bf16x8 pa[4]; pack_p(pa, p0, p1);
            pv(o, c, n & 1, pa);
        }
        acc_scaled(o, c, ((LAS float*)(lds + L_GT))[c.wid * 192 + c.lane]);
        __syncthreads();
        {
            int t2_ = tid; asm volatile("" : "+v"(t2_));
            const int tk = t2_ >> 3, jb = (t2_ & 7) * 8;
            unsigned sown[8]; int rank[8];
#pragma unroll
            for (int k = 0; k < 8; ++k) { const int j = jb + k; sown[k] = imp[tk * 65 + j] + ((j == 0 || j == qb || j == qb - 1) ? 0x40000000u : 0u); rank[k] = 0; }
            for (int jp = 0; jp <= qb; ++jp) { const unsigned sp = imp[tk * 65 + jp] + ((jp == 0 || jp == qb || jp == qb - 1) ? 0x40000000u : 0u);
#pragma unroll
                for (int k = 0; k < 8; ++k) rank[k] += (sp > sown[k] || (sp == sown[k] && jp < jb + k)) ? 1 : 0; }
            unsigned bits = 0u;
#pragma unroll
            for (int k = 0; k < 8; ++k) if (jb + k <= qb && rank[k] < 16) bits |= 1u << k;
            ((LAS unsigned char*)(lds + L_SEL))[tk * 8 + (t2_ & 7)] = (unsigned char)bits;
        }
        __syncthreads();
        if (tid < 64) {
            const unsigned long long mine = ((LAS unsigned long long*)(lds + L_SEL))[tid];
            unsigned lo = (unsigned)mine, hi2 = (unsigned)(mine >> 32);
#pragma unroll
            for (int o_ = 1; o_ < 64; o_ <<= 1) { lo |= __shfl_xor(lo, o_); hi2 |= __shfl_xor(hi2, o_); }
            if (tid == 0) { ((LAS unsigned*)(lds + L_UNI))[0] = lo; ((LAS unsigned*)(lds + L_UNI))[1] = hi2; }
        }
        __syncthreads();
    }
    for (int sidx = (flags & 1) ? 0 : 1; sidx < ((flags & 2) ? 2 : 1); ++sidx) {
        unsigned long long tm;
        if (sidx == 0) { const unsigned ul = (unsigned)__builtin_amdgcn_readfirstlane((int)((LAS unsigned*)(lds + L_UNI))[0]), uh = (unsigned)__builtin_amdgcn_readfirstlane((int)((LAS unsigned*)(lds + L_UNI))[1]);
            tm = ((((unsigned long long)uh << 32) | ul) & ((2ull << qb) - 1ull)) | (1ull << qb); }
        else { const int jlo = qb - 7 < 0 ? 0 : qb - 7; tm = ((2ull << qb) - 1ull) & ~((1ull << jlo) - 1ull); }
        if (DBG & 32) tm = 1ull << qb;
        const int NT = __builtin_popcountll(tm);
        unsigned long long selm = ~0ull;
        if (sidx == 0) selm = ((LAS unsigned long long*)(lds + L_SEL))[ql];
        const bool bounded = sidx ? T_.bounded_win : T_.bounded_slc;
        const bf16_t* KB = (sidx ? T_.kw : T_.ks) + bg * SEQ * 64; const bf16_t* VB = (sidx ? T_.vw : T_.vs) + bg * SEQ * 64;
#define TM_TOP(m) (63 - __builtin_clzll(m))
#define TL_RS(j) ((bool)((selm >> (j)) & 1ull))
        Sm st{0.f, 0.f}; f32x16 o[2]; o[0] = f32x16{}; o[1] = f32x16{};
        f32x16 sA0, sA1, sB0, sB1;
        bool first = true;
        if (sidx == 1 && qb >= 8 && !(DBG & 64)) {
            dma_kv(c, KB + (size_t)(qb - 8) * 4096, VB + (size_t)(qb - 8) * 4096, 0);
            NSA_WAITBAR();
            qk_first(sA0, sA1, c, 0, 0.f, M_WINLO, ql);
            const float rm = rowmax32_3(sA0, sA1);
            if (!bounded && __builtin_expect(__any(rm > RESCALE_THR || (rm < -RESCALE_THR && rm > -INFINITY)), 0)) rescale_rows(st, o, sA0, sA1, c, rm, true);
            bf16x8 pa_[4]; exp_sum_pack(st, sA0, sA1, pa_);
            { s16x4 vf0[16]; bf16x8 kfd[8]; read_vf(vf0, c, 0); (void)block_c<false>(o, c, vf0, pa_, sA0, sA1, kfd, -1); }
            first = false;
            asm volatile("s_waitcnt lgkmcnt(0)\n\ts_barrier" ::: "memory");
        }
        unsigned long long tw = tm;
        int jc0 = TM_TOP(tw); tw &= ~(1ull << jc0);
        int jc1 = tw ? TM_TOP(tw) : -1; if (jc1 >= 0) tw &= ~(1ull << jc1);
        int jc2 = tw ? TM_TOP(tw) : -1; if (jc2 >= 0) tw &= ~(1ull << jc2);
        int jc3 = tw ? TM_TOP(tw) : -1; if (jc3 >= 0) tw &= ~(1ull << jc3);
        int jc4 = tw ? TM_TOP(tw) : -1; if (jc4 >= 0) tw &= ~(1ull << jc4);
        dma_k(c, KB + (size_t)jc0 * 4096, 0);
        if (jc1 >= 0) dma_k(c, KB + (size_t)jc1 * 4096, 1);
        dma_v(c, VB + (size_t)jc0 * 4096, 0);
        if (jc2 >= 0) dma_k(c, KB + (size_t)jc2 * 4096, 2);
        NSA_WAITBAR();
        qk_first(sA0, sA1, c, 0, TL_RS(jc0) ? -st.m : -INFINITY, M_CAUSAL, ql);
        float rmc = rowmax32_3(sA0, sA1);
        bf16x8 kf[8];
        if (jc1 >= 0) read_kf(kf, c, 1);
        asm volatile("s_waitcnt lgkmcnt(0)\n\ts_barrier" ::: "memory");
        if (jc3 >= 0) dma_k(c, KB + (size_t)jc3 * 4096, 0);
        if (jc1 >= 0) dma_v(c, VB + (size_t)jc1 * 4096, 1);
        bf16x8 qs[4];
        { const lds_cptr qb_ = (lds_cptr)(lds + L_QF + c.wid * 4096) + c.hi * 512 + c.r32 * 16;
#pragma unroll
          for (int d0 = 0; d0 < 4; ++d0) qs[d0] = *(const LAS bf16x8*)(qb_ + d0 * 1024); }
        int r0 = 0, r1 = 1, r2 = 2;
        s16x4 vf[16];
#define NSA_STEP(n, C0, C1, N0, N1, NR) do { \
            if (jc3 >= 0 && (n) > 0) NSA_WAITBAR2(); else NSA_WAITBAR(); \
            if (jc4 >= 0) dma_k(c, KB + (size_t)jc4 * 4096, r1); \
            if (jc2 >= 0) dma_v(c, VB + (size_t)jc2 * 4096, r2); \
            if (!(NR)) { if (__builtin_expect(__any(rmc > RESCALE_THR || (first && rmc < -RESCALE_THR && rmc > -INFINITY)), 0)) rescale_rows(st, o, C0, C1, c, rmc, first); } \
            first = false; \
            bf16x8 pa_[4]; \
            block_b<DBG>(N0, N1, c, kf, qs, vf, r0, TL_RS(jc1) ? -st.m : -INFINITY, st, C0, C1, pa_); \
            rmc = block_c<true, DBG, NR>(o, c, vf, pa_, N0, N1, kf, jc2 >= 0 ? r2 : -1); \
            { const int t_ = r0; r0 = r1; r1 = r2; r2 = t_; } \
            jc0 = jc1; jc1 = jc2; jc2 = jc3; jc3 = jc4; jc4 = tw ? TM_TOP(tw) : -1; if (jc4 >= 0) tw &= ~(1ull << jc4); \
        } while (0)
        int n = 0;
        bool inA = true;
        if (bounded) {
            rmc = 0.f;
            while (jc1 >= 0) {
                NSA_STEP(n, sA0, sA1, sB0, sB1, true); ++n; inA = false;
                if (jc1 >= 0) { NSA_STEP(n, sB0, sB1, sA0, sA1, true); ++n; inA = true; }
            }
        } else {
            while (jc1 >= 0) {
                NSA_STEP(n, sA0, sA1, sB0, sB1, false); ++n; inA = false;
                if (jc1 >= 0) { NSA_STEP(n, sB0, sB1, sA0, sA1, false); ++n; inA = true; }
            }
        }
        if (!inA) { sA0 = sB0; sA1 = sB1; }
        {
            NSA_WAITBAR();
            if (__builtin_expect(__any(rmc > RESCALE_THR || (first && rmc < -RESCALE_THR && rmc > -INFINITY)), 0)) rescale_rows(st, o, sA0, sA1, c, rmc, first);
            bf16x8 pa_[4]; exp_sum_pack(st, sA0, sA1, pa_);
            read_vf(vf, c, r0);
            (void)block_c<false>(o, c, vf, pa_, sA0, sA1, kf, -1);
            const float lt = st.l + __shfl_xor(st.l, 32);
            acc_scaled(o, c, lt > 0.f ? ((LAS float*)(lds + L_GT))[c.wid * 192 + (sidx ? 128 : 64) + c.lane] / lt : 0.f);
        }
#undef NSA_STEP
#undef TM_TOP
#undef TL_RS
        asm volatile("s_waitcnt lgkmcnt(0)\n\ts_barrier" ::: "memory");
    }
    {
        const LAS float* oacc = (const LAS float*)(lds + L_OACC) + c.wid * 2048;
        const bool to_owin = !(flags & 1);
        bf16_t* dstb = (to_owin ? T_.owin : T_.onsa) + ((size_t)b * SEQ + t0 + 32 * c.th) * 512 + h * 64;
        asm volatile("s_waitcnt lgkmcnt(0)" ::: "memory");
#pragma unroll
        for (int i = 0; i < 4; ++i) { const int row = i * 8 + (c.lane >> 3), ch = c.lane & 7;
            f32x4 a = *(const LAS f32x4*)(oacc + row * 64 + ch * 8), b2 = *(const LAS f32x4*)(oacc + row * 64 + ch * 8 + 4);
            if (!(flags & 2)) { f32x4 wa, wb; epi::unpack8(*(const u32x4*)(T_.owin + ((size_t)b * SEQ + t0 + 32 * c.th + row) * 512 + h * 64 + ch * 8), wa, wb); a += wa; b2 += wb; }
            *(u32x4*)(dstb + (size_t)row * 512 + ch * 8) = epi::pack8(a, b2); }
    }
    __syncthreads();
}
#undef NSA_MFMA
#undef NSA_WAITBAR
}

enum { MAP_ID = 0, MAP_GU = 1, MAP_WIN = 2, MAP_GLU = 3 };
__device__ __forceinline__ int map_col(int mapid, int n) {
    if (mapid == MAP_ID) return n;
    if (mapid == MAP_GU) return ((n >> 8) << 7) + (n & 127);
    if (mapid == MAP_GLU) return (((n >> 7) & 1) << 10) + ((n >> 8) << 7) + (n & 127);
    const int pn = n >> 8, r = n & 255;
    if (pn < 5) { const int bj = r >> 7, wc = (r >> 5) & 3, i = r & 31; return 64 * (4 * pn + wc) + 32 * bj + i; }
    if (pn < 7) return 1304 + 256 * (pn - 5) + r;
    if (pn < 11) return 1816 + 256 * (pn - 7) + r;
    if (pn < 15) return 2840 + 256 * (pn - 11) + r;
    return r < 24 ? 1280 + r : -1;
}
struct TDesc { const float* W; const float* W2; int K, ldw, Nt, mapid; size_t off; const float* gain; };
__device__ __forceinline__ TDesc tdesc(const Args& a, int id) {
    switch (id) {
    case 0: return TDesc{a.in[2], a.in[3], DM, FF, 2 * FF, MAP_GU, WS_W1GU, a.in[1]};
    case 1: return TDesc{a.in[29], a.in[30], DM, FF, 2 * FF, MAP_GU, WS_W2GU, a.in[28]};
    case 2: return TDesc{a.in[4], nullptr, FF, DM, DM, MAP_ID, WS_W1D, nullptr};
    case 3: return TDesc{a.in[31], nullptr, FF, DM, DM, MAP_ID, WS_W2D, nullptr};
    case 4: return TDesc{a.in[6], nullptr, DM, INW, 4096, MAP_WIN, WS_WIN, a.in[5]};
    case 5: return TDesc{a.in[17], nullptr, 512, DM, DM, MAP_ID, WS_WNSA, nullptr};
    case 6: return TDesc{a.in[26], nullptr, 512, 2048, 2048, MAP_GLU, WS_WGLU, nullptr};
    case 7: return TDesc{a.in[27], nullptr, DM, DM, DM, MAP_ID, WS_WOUT, nullptr};
    case 8: return TDesc{a.in[13], nullptr, 2048, 256, 256, MAP_ID, WS_WC1K, nullptr};
    default: return TDesc{a.in[15], nullptr, 2048, 256, 256, MAP_ID, WS_WC1V, nullptr};
    }
}
constexpr int N_TMAT = 10;
__device__ __forceinline__ bool tmat_early(int id) { return id == 0 || id == 2 || id == 4 || id == 8 || id == 9; }
__device__ __forceinline__ int tmat_items(const TDesc& d) { return (d.K / 64) * (d.Nt / 32); }
__device__ __forceinline__ void tmat_item(const Args& a, const TDesc& d, int r, LAS float* scr, int lane) {
    const int nblk = d.Nt / 32, kb = r / nblk, nb = r % nblk, n0 = 32 * nb;
    const float* W = (d.mapid == MAP_GU && ((n0 >> 7) & 1)) ? d.W2 : d.W;
    const int mapid = d.mapid;
    transpose_item(W, d.ldw, (bf16_t*)(a.ws + d.off), d.K, 64 * kb, n0, [mapid](int n) { return map_col(mapid, n); }, scr, lane, d.gain);
}
constexpr int LATE_ITEMS = (DM / 64) * (2 * FF / 32) + (FF / 64) * (DM / 32) + (512 / 64) * (DM / 32) + (512 / 64) * (2048 / 32) + (DM / 64) * (DM / 32);
__device__ __forceinline__ void late_item(const Args& a, int v, LAS float* scr, int lane) {
    const int ids[5] = {1, 3, 5, 6, 7};
    int base = 0;
#pragma unroll
    for (int q = 0; q < 5; ++q) { const TDesc d = tdesc(a, ids[q]); const int n = tmat_items(d); if (v < base + n) { tmat_item(a, d, v - base, scr, lane); return; } base += n; }
}
__device__ __forceinline__ void p0_prologue(Frame& F, const Args& a) {
    LAS float* scr = (LAS float*)(F.lds + RING_OFF + F.wave * 16384);
    const int gw = F.vcu * NWAVES + F.wave, NGW = F.G * NWAVES;
    unsigned char* ws = a.ws;
    { bf16_t* xn = (bf16_t*)(ws + WS_XN); float* ssq = (float*)(ws + WS_SSQ);
      const int per_x = F.G / 8, xcd = F.vcu / per_x, wl = (F.vcu % per_x) * NWAVES + F.wave, nwl = per_x * NWAVES, rows_x = T / 8;
      for (int r = wl; r < rows_x / 2; r += nwl) { const int m = xcd * rows_x + r, m1 = m + rows_x / 2;
          prep_row2(a.in[0] + (size_t)m * DM, a.in[0] + (size_t)m1 * DM, a.in[1], xn + (size_t)m * DM, xn + (size_t)m1 * DM, ssq + (size_t)m * 16, ssq + (size_t)m1 * 16, F.lane); } }
    int base = 0;
    for (int id = 0; id < N_TMAT; ++id) {
        if (!tmat_early(id)) continue;
        const TDesc d = tdesc(a, id);
        const int nitems = tmat_items(d);
        int first = gw - (base % NGW); if (first < 0) first += NGW;
        for (int r = first; r < nitems; r += NGW) tmat_item(a, d, r, scr, F.lane);
        base += nitems;
    }
    for (int wt = gw; wt < SSM_G * 64; wt += NGW) ssm_weights_task(a, wt >> 6, wt & 63, F.lane, scr);
    for (int wt = gw; wt < 64; wt += NGW) { const int kv = wt >> 5, kc = (wt >> 2) & 7, n = (wt & 3) * 64 + F.lane;
        const float* pos = a.in[kv ? 12 : 11]; const float* w1 = a.in[kv ? 15 : 13]; float acc = 0.f;
        for (int k = kc * 256; k < kc * 256 + 256; ++k) acc += pos[k] * w1[(size_t)k * 256 + n];
        ((float*)(ws + WS_MISC))[(kv * 8 + kc) * 256 + n] = acc; }
}

typedef short bf16x8_t __attribute__((ext_vector_type(8)));
typedef float f32x16_t __attribute__((ext_vector_type(16)));
__device__ __forceinline__ void cmp_l2_wave(const bf16_t* hidrows, const float* w2, const float* knorm, bf16_t* outrows, int mrow0, int lane) {
    const int r32 = lane & 31, hi = lane >> 5;
    f32x16_t acc0 = {}, acc1 = {};
    for (int k4 = 0; k4 < 16; k4 += 4) {
        bf16x8_t af[4]; float wv[4][16];
#pragma unroll
        for (int q = 0; q < 4; ++q) { const int ks = k4 + q; af[q] = *(const bf16x8_t*)(hidrows + (size_t)r32 * 256 + 16 * ks + 8 * hi);
#pragma unroll
            for (int j = 0; j < 4; ++j) { const float* wp = w2 + (size_t)(16 * ks + 8 * hi + 2 * j) * 64 + r32; wv[q][4 * j] = wp[0]; wv[q][4 * j + 1] = wp[64]; wv[q][4 * j + 2] = wp[32]; wv[q][4 * j + 3] = wp[64 + 32]; } }
#pragma unroll
        for (int q = 0; q < 4; ++q) {
            const bf16x8_t bf0 = __builtin_bit_cast(bf16x8_t, (v4u){pk2(wv[q][0], wv[q][1]), pk2(wv[q][4], wv[q][5]), pk2(wv[q][8], wv[q][9]), pk2(wv[q][12], wv[q][13])});
            const bf16x8_t bf1 = __builtin_bit_cast(bf16x8_t, (v4u){pk2(wv[q][2], wv[q][3]), pk2(wv[q][6], wv[q][7]), pk2(wv[q][10], wv[q][11]), pk2(wv[q][14], wv[q][15])});
            acc0 = __builtin_amdgcn_mfma_f32_32x32x16_bf16(af[q], bf0, acc0, 0, 0, 0);
            acc1 = __builtin_amdgcn_mfma_f32_32x32x16_bf16(af[q], bf1, acc1, 0, 0, 0);
        }
    }
    const float g0 = knorm ? knorm[r32] : 1.f, g1 = knorm ? knorm[32 + r32] : 1.f;
#pragma unroll
    for (int r = 0; r < 16; ++r) {
        const int row = (r & 3) + 8 * (r >> 2) + 4 * hi;
        float v0 = acc0[r], v1 = acc1[r];
        if (knorm) { float ss = v0 * v0 + v1 * v1;
            ss += __shfl_xor(ss, 1); ss += __shfl_xor(ss, 2); ss += __shfl_xor(ss, 4); ss += __shfl_xor(ss, 8); ss += __shfl_xor(ss, 16);
            const float rn = rsqrtf(ss * (1.f / 64.f) + RMS_EPS); v0 *= rn * g0; v1 *= rn * g1; }
        if (((mrow0 + row) & 255) == 255) { v0 = 0.f; v1 = 0.f; }
        outrows[(size_t)row * 64 + r32] = f2bf(v0); outrows[(size_t)row * 64 + 32 + r32] = f2bf(v1);
    }
}

__global__ void __launch_bounds__(NWAVES * 64, 2) mega(Args args) {
    extern __shared__ __attribute__((aligned(16))) unsigned char lds[];
    Frame F;
    F.lds = (LAS unsigned char*)lds;
    F.MISC = (volatile LAS unsigned*)(F.lds + MISC_OFF);
    F.tid = threadIdx.x; F.lane = F.tid & 63; F.wave = __builtin_amdgcn_readfirstlane(F.tid >> 6);
    F.G = gridDim.x; { const int bx = blockIdx.x; F.vcu = (F.G % 8 == 0) ? (bx % 8) * (F.G / 8) + bx / 8 : bx; }
    unsigned char* ws = args.ws;
    F.ctl = (gu32*)(ws + WS_CTL);
    for (int u = F.tid; u < (LDS_BYTES - LDSCTL_OFF) / 4; u += NWAVES * 64) ((LAS unsigned*)(F.lds + LDSCTL_OFF))[u] = 0u;
    __syncthreads();
    XcdBarrier bar; bar.bar = (unsigned*)(F.ctl + CW_BAR); bar.x = 0; bar.st = nullptr;
    if (args.fused) bar = xcd_barrier_post((unsigned*)(F.ctl + CW_BAR), F.MISC + 8);
    const int lo = args.ph_lo, hi = args.ph_hi;
#define SELF_HANDOFF() do { asm volatile("s_waitcnt vmcnt(0)" ::: "memory"); __syncthreads(); } while (0)
#define IN(k) (lo <= (k) && (k) < hi)
#define SEAM(k) do { if (IN(k) && IN((k) + 1)) xcd_barrier(bar); } while (0)
    float* out = args.out;
    bf16_t* xn = (bf16_t*)(ws + WS_XN); float* ssq = (float*)(ws + WS_SSQ); bf16_t* act = (bf16_t*)(ws + WS_ACT);

    if (IN(PH_PRO)) { p0_prologue(F, args); } SEAM(PH_PRO);

    if (IN(PH_F1GU)) {
        pg8::Gemm g{xn, (const bf16_t*)(ws + WS_W1GU), DM, DM, DM, 0, 0}; pg8::StaticOrder S; S.init(T, 2 * FF, F.G, (int)blockIdx.x);
        epi::EpiSwiGLU E{act, ssq};
        pg8::gemm_phase<epi::EpiSwiGLU, pg8::StaticOrder, PG8_ALIGN, PG8_SP2>(F.lds + RING_OFF, g, S, E);
    } SEAM(PH_F1GU);

    if (IN(PH_F1D)) {
        pg8::Gemm g{act, (const bf16_t*)(ws + WS_W1D), FF, FF, FF, 0, 0}; pg8::StaticOrder S; S.init(T, DM, F.G, (int)blockIdx.x);
        epi::EpiResid<false, false> E{args.in[0], nullptr, nullptr, 0.5f, xn, ssq};
        pg8::gemm_phase<epi::EpiResid<false, false>, pg8::StaticOrder, PG8_ALIGN, PG8_SP2>(F.lds + RING_OFF, g, S, E);
    } SEAM(PH_F1D);

    if (IN(PH_WIN)) {
        pg8::Gemm g{xn, (const bf16_t*)(ws + WS_WIN), DM, DM, DM, 0, 0}; pg8::StaticOrder S; S.init(T, 4096, F.G, (int)blockIdx.x);
        epi::EpiWin E; E.ssq = ssq; E.q = (bf16_t*)(ws + WS_Q); E.ks = (bf16_t*)(ws + WS_KS); E.vs = (bf16_t*)(ws + WS_VS); E.kw = (bf16_t*)(ws + WS_KW); E.vw = (bf16_t*)(ws + WS_VW);
        E.kcr = (bf16_t*)(ws + WS_KCR); E.vcr = (bf16_t*)(ws + WS_VCR); E.acat = (bf16_t*)(ws + WS_ACAT); E.sgn = (bf16_t*)(ws + WS_SGN); E.sgs = (bf16_t*)(ws + WS_SGS); E.g3 = (float*)(ws + WS_G3);
        E.q_norm = args.in[7]; E.k_norm_slc = args.in[9]; E.k_norm_win = args.in[10];
        pg8::gemm_phase<epi::EpiWin, pg8::StaticOrder, PG8_ALIGN, PG8_SP2>(F.lds + RING_OFF, g, S, E);
    } SEAM(PH_WIN);

    if (IN(PH_MIDA)) {
        const int vcu = F.vcu;
        {
            const int cu = (vcu & 7) == 0 ? (vcu >> 3) : -1;
            pg8::Gemm g{(const bf16_t*)(ws + WS_KCR), (const bf16_t*)(ws + WS_WC1K), 1024, 2048, 2048, WS_VCR - WS_KCR, WS_WC1V - WS_WC1K};
            pg8::GroupOrder S; S.init(16, 1, 2, F.G, cu);
            epi::EpiCmp1 E{(bf16_t*)(ws + WS_HID), (const float*)(ws + WS_MISC)};
            pg8::gemm_phase<epi::EpiCmp1, pg8::GroupOrder, false, PG8_SP2>(F.lds + RING_OFF, g, S, E);
            if (cu >= 0) {
                SELF_HANDOFF();
                const int pg = cu >> 4, pm = cu & 15, r0 = pm * 256 + F.wave * 32;
                cmp_l2_wave((const bf16_t*)(ws + WS_HID) + ((size_t)pg * 4096 + r0) * 256, args.in[pg ? 16 : 14], pg ? nullptr : args.in[8],
                            (bf16_t*)(ws + (pg ? WS_VCMP : WS_KCMP)) + (size_t)r0 * 64, r0, F.lane);
            }
        }
        {
            const int cu = (vcu & 3) == 1 ? (vcu >> 2) : -1;
            pg8::Gemm g{(const bf16_t*)(ws + WS_ACAT), (const bf16_t*)(ws + WS_W1S), ACAT_LD, 1024, 1024, (size_t)512 * ACAT_LD * 2, (size_t)128 * 1024 * 2};
            pg8::GroupOrder S; S.init(2, 1, SSM_G, F.G, cu);
            epi::EpiSst E{(float*)(ws + WS_SST)};
            pg8::gemm_phase<epi::EpiSst, pg8::GroupOrder, false, PG8_SP2>(F.lds + RING_OFF, g, S, E);
            if (cu >= 0) {
                SELF_HANDOFF();
                ssm_carry_scan(args, cu >> 1, cu & 1, F.tid);
            }
        }
        {
            unsigned* ctr = (unsigned*)(F.ctl + CW_TOEP);
            LAS float* scr = (LAS float*)(F.lds + RING_OFF + F.wave * 16384);
            for (;;) { int v = 0; if (F.lane == 0) v = (int)__hip_atomic_fetch_add(ctr, 1u, RLX_AGENT); v = __builtin_amdgcn_readfirstlane(v);
                if (v >= LATE_ITEMS + SSM_G * 128) break;
                if (v < LATE_ITEMS) late_item(args, v, scr, F.lane);
                else { const int r0 = (v - LATE_ITEMS) * 8; for (int r = 0; r < 8; ++r) toep_row(ws, r0 + r, F.lane); } }
        }
    } SEAM(PH_MIDA);

    if (IN(PH_MIDB)) {
        if (args.pad & 4) {
            pg8::GroupOrder S; S.init(2, 4, SSM_G, F.G, F.vcu);
            pg8::Unit u0;
            (void)u0;
            pg8::Gemm g{(const bf16_t*)(ws + WS_ACAT), (const bf16_t*)(ws + WS_WTOEP), ACAT_LD, ACAT_LD, ACAT_LD, (size_t)512 * ACAT_LD * 2, (size_t)1024 * ACAT_LD * 2};
            epi::EpiSsmOut E{(const bf16_t*)(ws + WS_ACAT), args.in[25], ((bf16_t*)out + (size_t)T * 512)};
            pg8::gemm_phase<epi::EpiSsmOut, pg8::GroupOrder, false, PG8_SP2>(F.lds + RING_OFF, g, S, E);
        }
        if (args.pad & 3) {
            nsa::Tensors AT{(const bf16_t*)(ws + WS_Q), (const bf16_t*)(ws + WS_KCMP), (const bf16_t*)(ws + WS_VCMP), (const bf16_t*)(ws + WS_KS), (const bf16_t*)(ws + WS_VS),
                            (const bf16_t*)(ws + WS_KW), (const bf16_t*)(ws + WS_VW), (const float*)(ws + WS_G3), ((bf16_t*)out), (bf16_t*)(ws + WS_OWIN), false, false};
            {
                const float gq = wave_max(fabsf(args.in[7][F.lane])), gks = wave_max(fabsf(args.in[9][F.lane])), gkw = wave_max(fabsf(args.in[10][F.lane]));
                AT.bounded_slc = C2 * 64.f * gq * gks < 24.f; AT.bounded_win = C2 * 64.f * gq * gkw < 24.f;
            }
            const int bgi = F.vcu >> 4, sidx = F.vcu & 15;
            for (int i = 0; i < 4; ++i) { const int qb = (i == 0) ? sidx : (i == 1) ? 31 - sidx : (i == 2) ? 32 + sidx : 63 - sidx;

#if defined(PROBE_ATT)
                if (args.pad & 16) nsa::unit<PROBE_ATT>(AT, F.lds + RING_OFF, bgi >> 1, bgi & 1, qb, args.pad & 3); else
#endif
                nsa::unit<0>(AT, F.lds + RING_OFF, bgi >> 1, bgi & 1, qb, args.pad & 3); }
        }
    } SEAM(PH_MIDB);

    if (IN(PH_NSA)) {
        pg8::StaticOrder S; S.init(T, DM, F.G, (int)blockIdx.x);
        { pg8::Gemm g{((const bf16_t*)out), (const bf16_t*)(ws + WS_WNSA), 512, 512, 512, 0, 0};
          epi::EpiNsa E{(const bf16_t*)(ws + WS_SGN), (bf16_t*)(ws + WS_M1)};
          pg8::gemm_phase<epi::EpiNsa, pg8::StaticOrder, PG8_ALIGN, PG8_SP2>(F.lds + RING_OFF, g, S, E); }
        SELF_HANDOFF();
        { pg8::Gemm g{((const bf16_t*)out + (size_t)T * 512), (const bf16_t*)(ws + WS_WGLU), 512, 512, 512, 0, 0}; pg8::SplitOrder L{S};
          epi::EpiGlu E{(const bf16_t*)(ws + WS_SGS), (const bf16_t*)(ws + WS_M1), (bf16_t*)(ws + WS_MERGED)};
          pg8::gemm_phase<epi::EpiGlu, pg8::SplitOrder, PG8_ALIGN, PG8_SP2>(F.lds + RING_OFF, g, L, E); }
    } SEAM(PH_NSA);

    if (IN(PH_WOUT)) {
        pg8::Gemm g{(const bf16_t*)(ws + WS_MERGED), (const bf16_t*)(ws + WS_WOUT), DM, DM, DM, 0, 0}; pg8::StaticOrder S; S.init(T, DM, F.G, (int)blockIdx.x);
        epi::EpiResid<true, false> E{nullptr, xn, nullptr, 1.0f, xn, ssq};
        pg8::gemm_phase<epi::EpiResid<true, false>, pg8::StaticOrder, PG8_ALIGN, PG8_SP2>(F.lds + RING_OFF, g, S, E);
    } SEAM(PH_WOUT);

    if (IN(PH_F2GU)) {
        pg8::Gemm g{xn, (const bf16_t*)(ws + WS_W2GU), DM, DM, DM, 0, 0}; pg8::StaticOrder S; S.init(T, 2 * FF, F.G, (int)blockIdx.x);
        epi::EpiSwiGLU E{act, ssq};
        pg8::gemm_phase<epi::EpiSwiGLU, pg8::StaticOrder, PG8_ALIGN, PG8_SP2>(F.lds + RING_OFF, g, S, E);
    } SEAM(PH_F2GU);

    if (IN(PH_F2D)) {
        pg8::Gemm g{act, (const bf16_t*)(ws + WS_W2D), FF, FF, FF, 0, 0}; pg8::StaticOrder S; S.init(T, DM, F.G, (int)blockIdx.x);
        epi::EpiResid<true, true> E{nullptr, xn, out, 0.5f, nullptr, nullptr};
        pg8::gemm_phase<epi::EpiResid<true, true>, pg8::StaticOrder, PG8_ALIGN, PG8_SP2>(F.lds + RING_OFF, g, S, E);
    }
#undef IN
#undef SEAM
}

template <int NB, class AL, class BL, class EPI>
__device__ __forceinline__ void tgemm(int m0, int n0, int K, const AL& al, const BL& bl, const EPI& epi) {
    __shared__ float As[16][64 + 4];
    __shared__ float Bs[NB][16][64 + 4];
    __shared__ float Cs[NB][64][65];
    const int tid = threadIdx.x, ty = tid >> 4, tx = tid & 15;
    float acc[NB][4][4];
#pragma unroll
    for (int b = 0; b < NB; ++b)
#pragma unroll
        for (int i = 0; i < 4; ++i)
#pragma unroll
            for (int j = 0; j < 4; ++j) acc[b][i][j] = 0.f;
    for (int k0 = 0; k0 < K; k0 += 16) {
        {
            const int m = tid >> 2, kk = (tid & 3) * 4;
#pragma unroll
            for (int i = 0; i < 4; ++i) As[kk + i][m] = al(m0 + m, k0 + kk + i);
        }
        {
            const int kk = tid >> 4, nn = (tid & 15) * 4;
#pragma unroll
            for (int b = 0; b < NB; ++b)
#pragma unroll
                for (int j = 0; j < 4; ++j) Bs[b][kk][nn + j] = bl(b, k0 + kk, n0 + nn + j);
        }
        __syncthreads();
#pragma unroll
        for (int kk = 0; kk < 16; ++kk) {
            float a[4];
#pragma unroll
            for (int i = 0; i < 4; ++i) a[i] = As[kk][ty * 4 + i];
#pragma unroll
            for (int b = 0; b < NB; ++b) {
                float bv[4];
#pragma unroll
                for (int j = 0; j < 4; ++j) bv[j] = Bs[b][kk][tx * 4 + j];
#pragma unroll
                for (int i = 0; i < 4; ++i)
#pragma unroll
                    for (int j = 0; j < 4; ++j) acc[b][i][j] += a[i] * bv[j];
            }
        }
        __syncthreads();
    }
#pragma unroll
    for (int b = 0; b < NB; ++b)
#pragma unroll
        for (int i = 0; i < 4; ++i)
#pragma unroll
            for (int j = 0; j < 4; ++j) Cs[b][ty * 4 + i][tx * 4 + j] = acc[b][i][j];
    __syncthreads();
    epi(Cs, m0, n0);
}

__device__ __forceinline__ float row_rstd(const float* ssq, int t) {
    float s = 0.f;
#pragma unroll
    for (int i = 0; i < 16; ++i) s += ssq[(size_t)t * 16 + i];
    return rsqrtf(s * (1.f / DM) + RMS_EPS);
}

__global__ void __launch_bounds__(256) k_prep_rows(const float* x, const float* g, bf16_t* xn, float* ssq) {
    const int row = blockIdx.x * 4 + (threadIdx.x >> 6), lane = threadIdx.x & 63;
    const float* xr = x + (size_t)row * DM;
    float s = 0.f;
    for (int c = lane; c < DM; c += 64) { const float v = xr[c]; s += v * v; xn[(size_t)row * DM + c] = f2bf(v * g[c]); }
    s = wave_sum(s);
    if (lane < 16) ssq[(size_t)row * 16 + lane] = (lane == 0) ? s : 0.f;
}
__global__ void __launch_bounds__(256) k_row_ssq(const float* x, float* ssq) {
    const int row = blockIdx.x * 4 + (threadIdx.x >> 6), lane = threadIdx.x & 63;
    const float* xr = x + (size_t)row * DM;
    float s = 0.f;
    for (int c = lane; c < DM; c += 64) { const float v = xr[c]; s += v * v; }
    s = wave_sum(s);
    if (lane < 16) ssq[(size_t)row * 16 + lane] = (lane == 0) ? s : 0.f;
}

__global__ void __launch_bounds__(256) k_ffn_gu(const bf16_t* xn, const float* ssq, const float* wg, const float* wu, bf16_t* act) {
    const int m0 = blockIdx.y * 64, n0 = blockIdx.x * 64;
    auto al = [&](int m, int k) { return bf2f(xn[(size_t)m * DM + k]); };
    auto bl = [&](int b, int k, int n) { return (b == 0 ? wg : wu)[(size_t)k * FF + n]; };
    auto epi = [&](float (*Cs)[64][65], int m0_, int n0_) {
        const int tid = threadIdx.x;
        for (int e = tid; e < 64 * 64; e += 256) {
            const int r = e >> 6, c = e & 63, t = m0_ + r;
            const float rs = row_rstd(ssq, t);
            const float gv = Cs[0][r][c] * rs, uv = Cs[1][r][c] * rs;
            act[(size_t)t * FF + n0_ + c] = f2bf(gv * sigmoidf_(gv) * uv);
        }
    };
    tgemm<2>(m0, n0, DM, al, bl, epi);
}
__global__ void __launch_bounds__(256) k_ffn_down(const bf16_t* act, const float* wd, const float* xin, float* out, const float* gnext, bf16_t* xn) {
    const int m0 = blockIdx.y * 64, n0 = blockIdx.x * 64;
    auto al = [&](int m, int k) { return bf2f(act[(size_t)m * FF + k]); };
    auto bl = [&](int b, int k, int n) { return wd[(size_t)k * DM + n]; };
    auto epi = [&](float (*Cs)[64][65], int m0_, int n0_) {
        for (int e = threadIdx.x; e < 64 * 64; e += 256) {
            const int r = e >> 6, c = e & 63, t = m0_ + r, n = n0_ + c;
            const float o = xin[(size_t)t * DM + n] + 0.5f * Cs[0][r][c];
            out[(size_t)t * DM + n] = o;
            if (xn) xn[(size_t)t * DM + n] = f2bf(o * gnext[n]);
        }
    };
    tgemm<1>(m0, n0, FF, al, bl, epi);
}

__device__ __forceinline__ int win_origcol(int v) {
    if (v < 1280) return v;
    if (v < 1792) return 1304 + (v - 1280);
    if (v < 2816) return 1816 + (v - 1792);
    if (v < 3840) return 2840 + (v - 2816);
    if (v < 3864) return 1280 + (v - 3840);
    return -1;
}
struct WinOut {
    bf16_t *q, *ks, *vs, *kw, *vw, *kcr, *vcr, *acat, *sgn, *sgs; float* g3;
    const float *q_norm, *k_norm_slc, *k_norm_win;
};
__global__ void __launch_bounds__(256) k_win_proj(const bf16_t* xn, const float* ssq, const float* win, WinOut o, int skip_lo, int skip_hi) {
    const int m0 = blockIdx.y * 64, nt = blockIdx.x, n0 = nt * 64;
    if (nt > 60) return;
    if (nt >= skip_lo && nt < skip_hi) return;
    auto al = [&](int m, int k) { return bf2f(xn[(size_t)m * DM + k]); };
    auto bl = [&](int b, int k, int n) { const int oc = win_origcol(n); return oc >= 0 ? win[(size_t)k * INW + oc] : 0.f; };
    auto epi = [&](float (*Cs)[64][65], int m0_, int n0_) {
        const int tid = threadIdx.x;
        if (tid >= 64) return;
        const int r = tid, t = m0_ + r, b = t / SEQ, s = t % SEQ;
        const float rs = row_rstd(ssq, t);
        float v[64];
#pragma unroll
        for (int c = 0; c < 64; ++c) v[c] = Cs[0][r][c] * rs;
        if (nt < 8 || nt == 12 || nt == 13 || nt == 16 || nt == 17) {
            float ss = 0.f;
#pragma unroll
            for (int c = 0; c < 64; ++c) ss += v[c] * v[c];
            const float rn = rsqrtf(ss * (1.f / 64.f) + RMS_EPS);
            if (nt < 8) { bf16_t* dst = o.q + (((size_t)b * NH + nt) * SEQ + s) * 64;
#pragma unroll
                for (int c = 0; c < 64; ++c) dst[c] = f2bf(v[c] * rn * o.q_norm[c] * C2); }
            else { const bool isS = nt < 16; const int g = isS ? nt - 12 : nt - 16; bf16_t* dst = (isS ? o.ks : o.kw) + (((size_t)b * NG + g) * SEQ + s) * 64; const float* gn = isS ? o.k_norm_slc : o.k_norm_win;
#pragma unroll
                for (int c = 0; c < 64; ++c) dst[c] = f2bf(v[c] * rn * gn[c]); }
        } else if (nt < 20) {
            bf16_t* base; int g;
            if (nt < 10) { base = o.kcr; g = nt - 8; } else if (nt < 12) { base = o.vcr; g = nt - 10; } else if (nt < 16) { base = o.vs; g = nt - 14; } else { base = o.vw; g = nt - 18; }
            bf16_t* dst = base + (((size_t)b * NG + g) * SEQ + s) * 64;
#pragma unroll
            for (int c = 0; c < 64; ++c) dst[c] = f2bf(v[c]);
        } else if (nt < 28) {
#pragma unroll
            for (int c = 0; c < 64; ++c) { const int ch = 64 * (nt - 20) + c, g = ch >> 4, ci = ch & 15;
                o.acat[((size_t)g * 512 + b * 64 + (s >> 6)) * ACAT_LD + (s & 63) * 16 + ci] = f2bf(v[c]); }
        } else if (nt < 60) {
            const bool isN = nt < 44; bf16_t* dst = (isN ? o.sgn : o.sgs) + (size_t)t * DM + (isN ? nt - 28 : nt - 44) * 64;
#pragma unroll
            for (int c = 0; c < 64; ++c) dst[c] = f2bf(sigmoidf_(v[c]));
        } else {
#pragma unroll
            for (int c = 0; c < 24; ++c) o.g3[(size_t)t * 24 + c] = sigmoidf_(v[c]);
        }
    };
    tgemm<1>(m0, n0, DM, al, bl, epi);
}

__global__ void __launch_bounds__(256) k_cmp_l1(const bf16_t* kcr, const bf16_t* vcr, const float* posk, const float* posv, const float* w1k, const float* w1v, bf16_t* hid) {
    const int kv = blockIdx.z, m0 = blockIdx.y * 64, n0 = blockIdx.x * 64;
    const bf16_t* src = kv ? vcr : kcr; const float* pos = kv ? posv : posk; const float* w1 = kv ? w1v : w1k;
    auto al = [&](int m, int k) { const int bg = m >> 8, c = m & 255, s = k >> 6, d = k & 63, tok = 16 * c + s;
        if (tok >= SEQ) return 0.f; return bf2f(src[((size_t)bg * SEQ + tok) * 64 + d]) + pos[k]; };
    auto bl = [&](int b, int k, int n) { return w1[(size_t)k * 256 + n]; };
    auto epi = [&](float (*Cs)[64][65], int m0_, int n0_) {
        for (int e = threadIdx.x; e < 64 * 64; e += 256) { const int r = e >> 6, c = e & 63;
            hid[((size_t)kv * 4096 + m0_ + r) * 256 + n0_ + c] = f2bf(gelu_tanh(Cs[0][r][c])); }
    };
    tgemm<1>(m0, n0, 2048, al, bl, epi);
}
__global__ void __launch_bounds__(256) k_cmp_l2(const bf16_t* hid, const float* w2k, const float* w2v, const float* knorm, bf16_t* kcmp, bf16_t* vcmp) {
    const int gw = blockIdx.x * 4 + (threadIdx.x >> 6), lane = threadIdx.x & 63;
    const int kv = gw >> 12, m = gw & 4095;
    const float* w2 = kv ? w2v : w2k; const bf16_t* h = hid + ((size_t)kv * 4096 + m) * 256;
    float acc = 0.f;
    for (int k = 0; k < 256; ++k) acc += bf2f(h[k]) * w2[k * 64 + lane];
    if (!kv) { const float ss = wave_sum(acc * acc); acc = acc * rsqrtf(ss * (1.f / 64.f) + RMS_EPS) * knorm[lane]; }
    if ((m & 255) == 255) acc = 0.f;
    (kv ? vcmp : kcmp)[(size_t)m * 64 + lane] = f2bf(acc);
}

constexpr int SSMP_AB = 0, SSMP_BB = SSM_G * SSM_P * 2;
__global__ void k_ssm_params(const float* lre, const float* lim, const float* lstep, const float* bre, const float* bim, float* sp) {
    const int g = blockIdx.x, p = threadIdx.x;
    const double lr = lre[g * 64 + p], li = lim[g * 64 + p], step = exp((double)lstep[g]);
    const double mag = exp(lr * step), ar = mag * cos(li * step), ai = mag * sin(li * step);
    const double den = lr * lr + li * li, cr = ((ar - 1.0) * lr + ai * li) / den, ci = (ai * lr - (ar - 1.0) * li) / den;
    sp[SSMP_AB + (g * 64 + p) * 2 + 0] = (float)ar; sp[SSMP_AB + (g * 64 + p) * 2 + 1] = (float)ai;
    for (int c = 0; c < 16; ++c) { const double br = bre[(g * 64 + p) * 16 + c], bi = bim[(g * 64 + p) * 16 + c];
        sp[SSMP_BB + ((g * 64 + p) * 16 + c) * 2 + 0] = (float)(cr * br - ci * bi); sp[SSMP_BB + ((g * 64 + p) * 16 + c) * 2 + 1] = (float)(cr * bi + ci * br); }
}
__global__ void __launch_bounds__(64) k_ssm_scan(const bf16_t* acat, const float* sp, const float* cre, const float* cim, const float* dsk, bf16_t* geluy) {
    __shared__ float Cre[16][65], Cim[16][65], U[64][16], XR[64], XI[64];
    const int b = blockIdx.x / SSM_G, g = blockIdx.x % SSM_G, p = threadIdx.x;
    for (int e = p; e < 16 * 64; e += 64) { Cre[e >> 6][e & 63] = cre[(g * 16 + (e >> 6)) * 64 + (e & 63)]; Cim[e >> 6][e & 63] = cim[(g * 16 + (e >> 6)) * 64 + (e & 63)]; }
    const float ar = sp[SSMP_AB + (g * 64 + p) * 2], ai = sp[SSMP_AB + (g * 64 + p) * 2 + 1];
    float br[16], bi[16];
#pragma unroll
    for (int c = 0; c < 16; ++c) { br[c] = sp[SSMP_BB + ((g * 64 + p) * 16 + c) * 2]; bi[c] = sp[SSMP_BB + ((g * 64 + p) * 16 + c) * 2 + 1]; }
    const int co = p & 15, qd = p >> 4; const float dv = dsk[g * 16 + co];
    float xr = 0.f, xi = 0.f;
    for (int ch = 0; ch < 64; ++ch) {
        __syncthreads();
        const bf16_t* urow = acat + ((size_t)g * 512 + b * 64 + ch) * ACAT_LD;
        for (int e = p; e < 1024; e += 64) U[e >> 4][e & 15] = bf2f(urow[e]);
        __syncthreads();
        for (int i = 0; i < 64; ++i) {
            float ur = 0.f, ui = 0.f;
#pragma unroll
            for (int c = 0; c < 16; ++c) { ur += br[c] * U[i][c]; ui += bi[c] * U[i][c]; }
            const float nr = ar * xr - ai * xi + ur, ni = ar * xi + ai * xr + ui; xr = nr; xi = ni;
            XR[p] = xr; XI[p] = xi;
            __syncthreads();
            float y = 0.f;
#pragma unroll
            for (int pp = 0; pp < 16; ++pp) { const int P_ = qd * 16 + pp; y += Cre[co][P_] * XR[P_] - Cim[co][P_] * XI[P_]; }
            y += __shfl_xor(y, 16); y += __shfl_xor(y, 32);
            if (qd == 0) { y += dv * U[i][co]; geluy[((size_t)b * SEQ + ch * 64 + i) * 512 + g * 16 + co] = f2bf(gelu_tanh(y)); }
            __syncthreads();
        }
    }
}

__global__ void __launch_bounds__(256) k_win_attn(const bf16_t* q, const bf16_t* kw, const bf16_t* vw, const float* g3, bf16_t* owin) {
    const int gw = blockIdx.x * 4 + (threadIdx.x >> 6), lane = threadIdx.x & 63;
    const int t = gw >> 3, h = gw & 7, b = t / SEQ, s = t % SEQ, g = h >> 2;
    const float qv = bf2f(q[(((size_t)b * NH + h) * SEQ + s) * 64 + lane]);
    const bf16_t* K = kw + ((size_t)b * NG + g) * SEQ * 64; const bf16_t* V = vw + ((size_t)b * NG + g) * SEQ * 64;
    float m = -1e30f, l = 0.f, acc = 0.f;
    const int k0 = s - 511 < 0 ? 0 : s - 511;
    for (int k = k0; k <= s; ++k) {
        const float sc = wave_sum(qv * bf2f(K[(size_t)k * 64 + lane]));
        const float mn = fmaxf(m, sc), f = exp2f(m - mn), p = exp2f(sc - mn);
        l = l * f + p; acc = acc * f + p * bf2f(V[(size_t)k * 64 + lane]); m = mn;
    }
    owin[(size_t)t * 512 + h * 64 + lane] = f2bf(g3[(size_t)t * 24 + 16 + h] * acc / l);
}

__global__ void __launch_bounds__(256) k_cmp_slc_attn(const bf16_t* q, const bf16_t* kcmp, const bf16_t* vcmp, const bf16_t* ks, const bf16_t* vs, const float* g3, const bf16_t* owin, bf16_t* onsa) {
    __shared__ float Ps[4][4][256];
    __shared__ float Sc[4][1024];
    const int w = threadIdx.x >> 6, lane = threadIdx.x & 63;
    const int gw = blockIdx.x * 4 + w, t = gw >> 1, g = gw & 1, b = t / SEQ, s = t % SEQ, qblk = s >> 6;
    const bf16_t* KC = kcmp + ((size_t)b * NG + g) * 256 * 64; const bf16_t* VC = vcmp + ((size_t)b * NG + g) * 256 * 64;
    const bf16_t* KS = ks + ((size_t)b * NG + g) * SEQ * 64; const bf16_t* VS = vs + ((size_t)b * NG + g) * SEQ * 64;
    const int ncv = (s >= 31) ? ((s - 31) >> 4) + 1 : 0;
    __shared__ float Ocmp[4][4][64];
    for (int r = 0; r < 4; ++r) {
        const bf16_t* qp = q + (((size_t)b * NH + g * 4 + r) * SEQ + s) * 64;
        float sc[4]; float mx = -1e30f;
#pragma unroll
        for (int j = 0; j < 4; ++j) { const int c = lane + 64 * j; float a = -1e30f;
            if (c < ncv) { a = 0.f; for (int d = 0; d < 64; ++d) a += bf2f(qp[d]) * bf2f(KC[(size_t)c * 64 + d]); }
            sc[j] = a; mx = fmaxf(mx, a); }
        mx = wave_max(mx); float den = 0.f;
#pragma unroll
        for (int j = 0; j < 4; ++j) { const int c = lane + 64 * j; sc[j] = (c < ncv) ? exp2f(sc[j] - mx) : 0.f; den += sc[j]; }
        den = wave_sum(den); const float inv = den > 0.f ? 1.f / den : 1.f;
#pragma unroll
        for (int j = 0; j < 4; ++j) Ps[w][r][lane + 64 * j] = sc[j] * inv;
        __syncthreads();
        float a = 0.f;
        for (int c = 0; c < ncv; ++c) a += Ps[w][r][c] * bf2f(VC[(size_t)c * 64 + lane]);
        Ocmp[w][r][lane] = a;
    }
    __syncthreads();
    float imp = 0.f;
    for (int r = 0; r < 4; ++r) for (int c = 4 * lane - 1; c <= 4 * lane + 3; ++c) if (c >= 0 && c < NCMP) imp += Ps[w][r][c];
    const bool force = (lane == 0) || (lane == qblk) || (lane == qblk - 1);
    const float score = (lane <= qblk) ? imp + (force ? 1000.f : 0.f) : -1e30f;
    int rank = 0;
    for (int j = 0; j < 64; ++j) { const float o = __shfl(score, j); rank += (o > score || (o == score && j < lane)) ? 1 : 0; }
    const unsigned long long selmask = __ballot(rank < 16 && lane <= qblk);
    for (int r = 0; r < 4; ++r) {
        const bf16_t* qp = q + (((size_t)b * NH + g * 4 + r) * SEQ + s) * 64;
        int nb = 0; float mx = -1e30f;
        for (int j = 0; j < 64; ++j) if ((selmask >> j) & 1ull) {
            const int key = 64 * j + lane; float a = -1e30f;
            if (key <= s) { a = 0.f; for (int d = 0; d < 64; ++d) a += bf2f(qp[d]) * bf2f(KS[(size_t)key * 64 + d]); }
            Sc[w][nb * 64 + lane] = a; mx = fmaxf(mx, a); ++nb;
        }
        mx = wave_max(mx); float den = 0.f;
        for (int i = 0; i < nb; ++i) { const float a = Sc[w][i * 64 + lane]; const float p = (a > -1e29f) ? exp2f(a - mx) : 0.f; Sc[w][i * 64 + lane] = p; den += p; }
        den = wave_sum(den); const float inv = den > 0.f ? 1.f / den : 1.f;
        __syncthreads();
        float a = 0.f; nb = 0;
        for (int j = 0; j < 64; ++j) if ((selmask >> j) & 1ull) {
            for (int kk = 0; kk < 64; ++kk) { const float p = Sc[w][nb * 64 + kk]; if (p != 0.f) a += p * bf2f(VS[(size_t)(64 * j + kk) * 64 + lane]); }
            ++nb;
        }
        const int h = g * 4 + r;
        const float o = g3[(size_t)t * 24 + h] * Ocmp[w][r][lane] + g3[(size_t)t * 24 + 8 + h] * (a * inv) + bf2f(owin[(size_t)t * 512 + h * 64 + lane]);
        onsa[(size_t)t * 512 + h * 64 + lane] = f2bf(o);
        __syncthreads();
    }
}

__global__ void __launch_bounds__(256) k_nsa_proj(const bf16_t* onsa, const float* w, const bf16_t* sgn, bf16_t* m1) {
    const int m0 = blockIdx.y * 64, n0 = blockIdx.x * 64;
    auto al = [&](int m, int k) { return bf2f(onsa[(size_t)m * 512 + k]); };
    auto bl = [&](int b, int k, int n) { return w[(size_t)k * DM + n]; };
    auto epi = [&](float (*Cs)[64][65], int m0_, int n0_) {
        for (int e = threadIdx.x; e < 64 * 64; e += 256) { const int r = e >> 6, c = e & 63; const size_t ix = (size_t)(m0_ + r) * DM + n0_ + c;
            m1[ix] = f2bf(bf2f(sgn[ix]) * Cs[0][r][c]); }
    };
    tgemm<1>(m0, n0, 512, al, bl, epi);
}
__global__ void __launch_bounds__(256) k_glu(const bf16_t* geluy, const float* w, const bf16_t* sgs, const bf16_t* m1, bf16_t* merged) {
    const int m0 = blockIdx.y * 64, n0 = blockIdx.x * 64;
    auto al = [&](int m, int k) { return bf2f(geluy[(size_t)m * 512 + k]); };
    auto bl = [&](int b, int k, int n) { return w[(size_t)k * 2048 + b * 1024 + n]; };
    auto epi = [&](float (*Cs)[64][65], int m0_, int n0_) {
        for (int e = threadIdx.x; e < 64 * 64; e += 256) { const int r = e >> 6, c = e & 63; const size_t ix = (size_t)(m0_ + r) * DM + n0_ + c;
            merged[ix] = f2bf(bf2f(m1[ix]) + bf2f(sgs[ix]) * Cs[0][r][c] * sigmoidf_(Cs[1][r][c])); }
    };
    tgemm<2>(m0, n0, 512, al, bl, epi);
}
__global__ void __launch_bounds__(256) k_wout(const bf16_t* merged, const float* w, float* out, const float* gnext, bf16_t* xn) {
    const int m0 = blockIdx.y * 64, n0 = blockIdx.x * 64;
    auto al = [&](int m, int k) { return bf2f(merged[(size_t)m * DM + k]); };
    auto bl = [&](int b, int k, int n) { return w[(size_t)k * DM + n]; };
    auto epi = [&](float (*Cs)[64][65], int m0_, int n0_) {
        for (int e = threadIdx.x; e < 64 * 64; e += 256) { const int r = e >> 6, c = e & 63; const size_t ix = (size_t)(m0_ + r) * DM + n0_ + c;
            const float o = out[ix] + Cs[0][r][c]; out[ix] = o; xn[ix] = f2bf(o * gnext[n0_ + c]); }
    };
    tgemm<1>(m0, n0, DM, al, bl, epi);
}

static void launch_mega(const Args& a0, int lo, int hi, int fused, int grid, hipStream_t stream, int aflags = 7) {
    Args a = a0; a.ph_lo = lo; a.ph_hi = hi; a.fused = fused; a.pad = aflags;
    hipLaunchKernelGGL(mega, dim3(grid), dim3(NWAVES * 64), LDS_BYTES, stream, a);
}
extern "C" void kernel_launch(void* const* d_in, const int* in_sizes, int n_in, void* d_out, int out_size, void* d_ws, size_t ws_size, hipStream_t stream) {
    static int grid = 0;
    if (grid == 0) {
        if (n_in != 32 || out_size != T * DM || ws_size < WS_END) { fprintf(stderr, "kernel_launch: unexpected shapes n_in %d out %d ws %zu\n", n_in, out_size, ws_size); grid = -1; return; }
        int dev = 0, cus = 0;
        if (hipGetDevice(&dev) != hipSuccess || hipDeviceGetAttribute(&cus, hipDeviceAttributeMultiprocessorCount, dev) != hipSuccess) { grid = -1; return; }
        if (hipFuncSetAttribute((const void*)mega, hipFuncAttributeMaxDynamicSharedMemorySize, LDS_BYTES) != hipSuccess) { fprintf(stderr, "kernel_launch: hipFuncSetAttribute failed\n"); grid = -1; return; }
        if (cus < 256) { fprintf(stderr, "kernel_launch: this kernel's unit maps need 256 co-resident workgroups (one per CU); the device has %d CUs\n", cus); grid = -1; return; }
        grid = 256;
    }
    if (grid < 0) return;
    const float* in[32]; for (int i = 0; i < 32; ++i) in[i] = (const float*)d_in[i];
    unsigned char* ws = (unsigned char*)d_ws; float* out = (float*)d_out;
    (void)hipMemsetAsync(ws + WS_CTL, 0, CTL_ZERO_BYTES, stream);
    Args a{}; for (int i = 0; i < 32; ++i) a.in[i] = in[i]; a.out = out; a.ws = ws;
    float* ssq = (float*)(ws + WS_SSQ); float* g3 = (float*)(ws + WS_G3); bf16_t* hid = (bf16_t*)(ws + WS_HID);
    bf16_t* kcmp = (bf16_t*)(ws + WS_KCMP); bf16_t* vcmp = (bf16_t*)(ws + WS_VCMP); float* ssmp = (float*)(ws + WS_SSMP);
    bf16_t* xn = (bf16_t*)(ws + WS_XN);
    WinOut wo; wo.q = (bf16_t*)(ws + WS_Q); wo.ks = (bf16_t*)(ws + WS_KS); wo.vs = (bf16_t*)(ws + WS_VS); wo.kw = (bf16_t*)(ws + WS_KW); wo.vw = (bf16_t*)(ws + WS_VW);
    wo.kcr = (bf16_t*)(ws + WS_KCR); wo.vcr = (bf16_t*)(ws + WS_VCR); wo.acat = (bf16_t*)(ws + WS_ACAT); wo.sgn = (bf16_t*)(ws + WS_SGN); wo.sgs = (bf16_t*)(ws + WS_SGS); wo.g3 = g3;
    wo.q_norm = in[7]; wo.k_norm_slc = in[9]; wo.k_norm_win = in[10];
    bf16_t* owin = (bf16_t*)(ws + WS_OWIN); bf16_t* onsa = (bf16_t*)(ws + WS_ONSA); bf16_t* geluy = (bf16_t*)(ws + WS_GELUY);
    bf16_t* m1 = (bf16_t*)(ws + WS_M1); bf16_t* merged = (bf16_t*)(ws + WS_MERGED);

#if defined(PROBE_ATT)
    for (int ph = 0; ph < NPH; ++ph) { launch_mega(a, ph, ph + 1, 0, grid, stream); if (ph == PH_MIDB) for (int r_ = 0; r_ < 4; ++r_) launch_mega(a, ph, ph + 1, 0, grid, stream, 2 | 16); }
#elif defined(PROBE_MIDB)
    for (int ph = 0; ph < NPH; ++ph) {
        if (ph == PH_MIDB && PROBE_MIDB == 4) launch_mega(a, ph, ph + 1, 0, grid, stream, 2);
        launch_mega(a, ph, ph + 1, 0, grid, stream);
        if (ph == PH_MIDB) launch_mega(a, ph, ph + 1, 0, grid, stream, PROBE_MIDB == 1 ? 4 : PROBE_MIDB == 2 ? 3 : PROBE_MIDB == 3 ? 2 : PROBE_MIDB == 5 ? 7 : 1);
    }
#elif defined(PROBE_F1D)
    for (int ph = 0; ph < NPH; ++ph) { launch_mega(a, ph, ph + 1, 0, grid, stream); if (ph == PH_F1D) launch_mega(a, ph, ph + 1, 0, grid, stream, 7 | 8); }
#elif defined(REP_PHASE)
    for (int ph = 0; ph < NPH; ++ph) for (int r = 0; r < (ph == REP_PHASE ? 2 : 1); ++r) launch_mega(a, ph, ph + 1, 0, grid, stream);
#elif defined(MK_PER_PHASE)
    for (int ph = 0; ph < NPH; ++ph) launch_mega(a, ph, ph + 1, 0, grid, stream);
#else
    launch_mega(a, 0, NPH, 1, grid, stream);
#endif
}
```

```cpp
#include <hip/hip_runtime.h>
#include <cstdint>
#include <cstdio>

typedef unsigned short bf16_t;
constexpr int BATCH = 8, SEQ = 4096, DM = 1024, T = BATCH * SEQ;
constexpr int FF = 2816, NH = 8, NG = 2, HD = 64;
constexpr int INW = 3864, NCMP = 255;
constexpr int SSM_G = 32, SSM_C = 16, SSM_P = 64;
constexpr float RMS_EPS = 1e-6f;
constexpr float C2 = 0.125f * 1.4426950408889634f;

__device__ __forceinline__ float bf2f(bf16_t v) { return __uint_as_float(((unsigned)v) << 16); }
__device__ __forceinline__ bf16_t f2bf(float f) { unsigned u = __float_as_uint(f); return (bf16_t)((u + 0x7fffu + ((u >> 16) & 1u)) >> 16); }
__device__ __forceinline__ unsigned pk2(float lo, float hi) { return (unsigned)f2bf(lo) | ((unsigned)f2bf(hi) << 16); }
__device__ __forceinline__ float sigmoidf_(float x) { return 1.f / (1.f + __expf(-x)); }
__device__ __forceinline__ float gelu_tanh(float x) { const float u = 0.7978845608028654f * (x + 0.044715f * x * x * x); return 0.5f * x * (1.f + tanhf(u)); }
__device__ __forceinline__ float fsigmoid(float x) { return __builtin_amdgcn_rcpf(1.f + __builtin_amdgcn_exp2f(-1.4426950408889634f * x)); }
__device__ __forceinline__ float fgelu_tanh(float x) { const float u = 0.7978845608028654f * (x + 0.044715f * x * x * x); return x * fsigmoid(2.f * u); }
__device__ __forceinline__ float wave_sum(float v) {
#pragma unroll
    for (int o = 1; o < 64; o <<= 1) v += __shfl_xor(v, o);
    return v;
}
__device__ __forceinline__ float wave_max(float v) {
#pragma unroll
    for (int o = 1; o < 64; o <<= 1) v = fmaxf(v, __shfl_xor(v, o));
    return v;
}

constexpr size_t MiB = 1u << 20;
constexpr size_t WS_CTL = 0, CTL_ZERO_BYTES = 32 * 1024;
constexpr size_t WS_W1GU = 1 * MiB;
constexpr size_t WS_W1D = 12 * MiB;
constexpr size_t WS_WIN = 18 * MiB;
constexpr size_t WS_WC1K = 26 * MiB;
constexpr size_t WS_WC1V = 27 * MiB;
constexpr size_t WS_MISC = 28 * MiB;
constexpr size_t WS_WNSA = 29 * MiB;
constexpr size_t WS_WGLU = 30 * MiB;
constexpr size_t WS_WOUT = 32 * MiB;
constexpr size_t WS_W2GU = 34 * MiB;
constexpr size_t WS_W2D = 45 * MiB;
constexpr size_t WS_W1S = 51 * MiB;
constexpr size_t WS_WTOEP = 60 * MiB;
constexpr size_t WS_KTAB = 132 * MiB;
constexpr size_t WS_SSQ = 134 * MiB;
constexpr size_t WS_G3 = 136 * MiB;
constexpr size_t WS_HID = 139 * MiB;
constexpr size_t WS_KCMP = 143 * MiB;
constexpr size_t WS_VCMP = 143 * MiB + 512 * 1024;
constexpr size_t WS_SSMP = 144 * MiB;
constexpr size_t WS_SST = 145 * MiB;
constexpr size_t WS_XN = 161 * MiB;
constexpr size_t WS_BIG = 225 * MiB;
constexpr size_t WS_ACT = WS_BIG;
constexpr size_t WS_SGN = WS_BIG;
constexpr size_t WS_SGS = WS_BIG + 64 * MiB;
constexpr size_t WS_Q = WS_BIG + 128 * MiB;
constexpr size_t WS_KS = WS_BIG + 160 * MiB;
constexpr size_t WS_VS = WS_BIG + 168 * MiB;
constexpr size_t WS_KW = WS_BIG + 176 * MiB;
constexpr size_t WS_VW = WS_BIG + 184 * MiB;
constexpr size_t WS_KCR = WS_BIG + 192 * MiB;
constexpr size_t WS_VCR = WS_BIG + 201 * MiB;
constexpr size_t WS_ACAT = WS_BIG + 210 * MiB;
constexpr size_t WS_OWIN = WS_BIG + 246 * MiB;
constexpr size_t WS_M1 = WS_BIG + 128 * MiB;
constexpr size_t WS_MERGED = WS_BIG + 192 * MiB;
constexpr size_t WS_ONSA = WS_XN;
constexpr size_t WS_GELUY = WS_XN + 32 * MiB;
constexpr size_t WS_END = 512 * MiB;
constexpr int ACAT_LD = 1152;

namespace pg8 {
#define PG8_LAS __attribute__((address_space(3)))
typedef short bf16x8 __attribute__((ext_vector_type(8)));
typedef float f32x4 __attribute__((ext_vector_type(4)));
typedef float f32x2 __attribute__((ext_vector_type(2)));
typedef unsigned u32x4 __attribute__((ext_vector_type(4)));
typedef unsigned u32x2 __attribute__((ext_vector_type(2)));
constexpr int BM = 256, BK = 64, HALF = 128, HTB = HALF * BK * 2  , STAGE_BYTES = 8 * HTB, NXCD = 8, WGM = 8;

__host__ __device__ __forceinline__ int lds_byte(int r, int c) { const int st = (r >> 4) * 2 + (c >> 5), rr = r & 15, cc = c & 31, ob = rr * 64 + cc * 2; return st * 1024 + (ob ^ (((ob >> 9) & 1) << 5)); }
__host__ __device__ __forceinline__ void stage_rc(int b, int& R, int& C) { const int st = b / 1024, sb = b % 1024, swz = sb ^ (((sb >> 9) & 1) << 5); R = (st >> 1) * 16 + swz / 64; C = (st & 1) * 32 + (swz % 64) / 2; }
__host__ __device__ __forceinline__ int perm32(int rho) { const int n = rho >> 4, i = rho & 15; return 8 * (i >> 2) + 4 * n + (i & 3); }

struct Unit { int pm, pn, pg; };
struct Gemm { const bf16_t* A; const bf16_t* Bt; int lda, ldb, K; size_t gsA, gsB; };

struct StaticOrder {
    int nM, nN, nwg, G, c;
    __host__ __device__ __forceinline__ void init(int M, int N, int G_, int c_) { nM = M / BM; nN = N / BM; nwg = nM * nN; G = G_; c = c_; }
    __host__ __device__ __forceinline__ bool next(int i, Unit& u) const {
        const long L = (long)i * G + c; if (L >= nwg) return false;
        int wgid = (int)L; { const int q = nwg / NXCD, r = nwg % NXCD, xcd = wgid % NXCD, off = wgid / NXCD; wgid = (xcd < r ? xcd * (q + 1) : r * (q + 1) + (xcd - r) * q) + off; }
        const int nig = WGM * nN, gid = wgid / nig, fm = gid * WGM, gsz = (nM - fm) < WGM ? (nM - fm) : WGM;
        u.pm = fm + ((wgid % nig) % gsz); u.pn = (wgid % nig) / gsz; u.pg = 0; return true;
    }
};
struct GroupOrder {
    int nM, nN, ng, G, c;
    __host__ __device__ __forceinline__ void init(int nM_, int nN_, int ng_, int G_, int c_) { nM = nM_; nN = nN_; ng = ng_; G = G_; c = c_; }
    __host__ __device__ __forceinline__ bool next(int i, Unit& u) const {
        if (c < 0) return false;
        const long L = (long)i * G + c; if (L >= (long)ng * nM * nN) return false;
        const int per = nM * nN, r = (int)(L % per); u.pg = (int)(L / per); u.pm = r % nM; u.pn = r / nM; return true;
    }
};

struct SplitOrder {
    StaticOrder S;
    __host__ __device__ __forceinline__ bool next(int i, Unit& u) const { Unit t; if (!S.next(i >> 1, t)) return false; u.pm = t.pm; u.pn = 2 * t.pn + (i & 1); u.pg = 0; return true; }
};
typedef __bf16 bf16x2_t __attribute__((ext_vector_type(2)));
__device__ __forceinline__ unsigned cvt_pk_bf16(float lo, float hi) { f32x2 v = {lo, hi}; bf16x2_t b = __builtin_convertvector(v, bf16x2_t); return __builtin_bit_cast(unsigned, b); }

template <class Epi, class Sched, bool ALIGN_EPI = false, bool SP2 = false>
__device__ __forceinline__ void gemm_phase(PG8_LAS unsigned char* lds, const Gemm g, const Sched& S, const Epi& E) {
    const int tid = threadIdx.x, wid = __builtin_amdgcn_readfirstlane(tid >> 6), lane = tid & 63, wr = wid >> 2, wc = wid & 3, fr = lane & 15, fq = lane >> 4;
    const int K = g.K, nt = K / BK;
    unsigned voffA[2], voffB[2];
#pragma unroll
    for (int i = 0; i < 2; ++i) { int R, C; stage_rc(tid * 16 + i * 8192, R, C); const int Rb = Epi::PERM ? ((R & ~31) + perm32(R & 31)) : R;
        voffA[i] = (unsigned)(R * g.lda + C) * 2u; voffB[i] = (unsigned)(Rb * g.ldb + C) * 2u; }
    const size_t kstep = (size_t)(BK * 2);
    const size_t hstepA = (size_t)HALF * g.lda * 2, hstepB = (size_t)HALF * g.ldb * 2;
    const size_t tstepA = 2 * hstepA, tstepB = 2 * hstepB;
    const unsigned ldsw = (unsigned)wid * 1024u;
    const int aoff = lds_byte(wr * 64 + fr, fq * 8), boff = lds_byte(wc * 32 + fr, fq * 8);
#define PG8_SA(b, h) (((b) * 2 + (h)) * HTB)
#define PG8_SB(b, h) ((4 + (b) * 2 + (h)) * HTB)
#define PG8_STAGE(bufoff, gbase, voff) do { _Pragma("unroll") for (int _i = 0; _i < 2; ++_i) \
        __builtin_amdgcn_global_load_lds((const unsigned*)((const char*)(gbase) + (voff)[_i]), (PG8_LAS unsigned*)(lds + (bufoff) + ldsw + _i * 8192), 16, 0, 0); } while (0)
#define PG8_LDA(dst, b, h) do { _Pragma("unroll") for (int m = 0; m < 4; ++m) _Pragma("unroll") for (int k = 0; k < 2; ++k) dst[m][k] = *(const PG8_LAS bf16x8*)(lds + PG8_SA(b, h) + aoff + m * 2048 + k * 1024); } while (0)
#define PG8_LDB(dst, b, h) do { _Pragma("unroll") for (int n = 0; n < 2; ++n) _Pragma("unroll") for (int k = 0; k < 2; ++k) dst[n][k] = *(const PG8_LAS bf16x8*)(lds + PG8_SB(b, h) + boff + n * 2048 + k * 1024); } while (0)
#define PG8_MMA(ai, bj, At, Bt) do { __builtin_amdgcn_s_setprio(1); _Pragma("unroll") for (int m = 0; m < 4; ++m) _Pragma("unroll") for (int n = 0; n < 2; ++n) _Pragma("unroll") for (int k = 0; k < 2; ++k) \
        acc[ai][bj][m][n] = __builtin_amdgcn_mfma_f32_16x16x32_bf16(Bt[n][k], At[m][k], acc[ai][bj][m][n], 0, 0, 0); __builtin_amdgcn_s_setprio(0); } while (0)
#define PG8_WAIT_V(n) asm volatile("s_waitcnt vmcnt(" #n ")" ::: "memory")
#define PG8_WAIT_L(n) asm volatile("s_waitcnt lgkmcnt(" #n ")" ::: "memory")
#define PG8_BAR __builtin_amdgcn_s_barrier()
#define PG8_SCHED __builtin_amdgcn_sched_barrier(0)
    Unit cur, nxt; int ui = 0;
    if (!S.next(0, cur)) return;
    f32x4 acc[2][2][4][2];
    if constexpr (Epi::HAS_INIT) E.init(acc, cur, wr, wc, fr, fq);
    else {
#pragma unroll
    for (int a = 0; a < 2; ++a)
#pragma unroll
        for (int b = 0; b < 2; ++b)
#pragma unroll
            for (int m = 0; m < 4; ++m)
#pragma unroll
                for (int n = 0; n < 2; ++n) acc[a][b][m][n] = (f32x4){0.f, 0.f, 0.f, 0.f};
    }
    bf16x8 At[4][2], B0[2][2], B1[2][2];
    const char* cA = (const char*)g.A + (size_t)cur.pg * g.gsA + (size_t)cur.pm * tstepA; const char* cB = (const char*)g.Bt + (size_t)cur.pg * g.gsB + (size_t)cur.pn * tstepB;
    if constexpr (SP2) {
        PG8_STAGE(PG8_SB(0, 0), cB, voffB); PG8_STAGE(PG8_SB(0, 1), cB + hstepB, voffB); PG8_STAGE(PG8_SA(0, 0), cA, voffA); PG8_STAGE(PG8_SA(0, 1), cA + hstepA, voffA);
        if (wr == 1) PG8_BAR;
        PG8_WAIT_V(2); PG8_BAR;
        PG8_STAGE(PG8_SB(1, 0), cB + kstep, voffB); PG8_STAGE(PG8_SA(1, 0), cA + kstep, voffA); PG8_STAGE(PG8_SB(1, 1), cB + hstepB + kstep, voffB);
        PG8_WAIT_V(6); PG8_BAR;
    } else {
        PG8_STAGE(PG8_SB(0, 0), cB, voffB); PG8_STAGE(PG8_SA(0, 0), cA, voffA); PG8_STAGE(PG8_SB(0, 1), cB + hstepB, voffB); PG8_STAGE(PG8_SA(0, 1), cA + hstepA, voffA);
        if (wr == 1) PG8_BAR;
        PG8_WAIT_V(4); PG8_BAR;
        PG8_STAGE(PG8_SB(1, 0), cB + kstep, voffB); PG8_STAGE(PG8_SA(1, 0), cA + kstep, voffA); PG8_STAGE(PG8_SB(1, 1), cB + hstepB + kstep, voffB);
        PG8_WAIT_V(6); PG8_BAR;
    }
    for (;;) {
        const bool has_next = S.next(ui + 1, nxt);
        const char* nA = has_next ? (const char*)g.A + (size_t)nxt.pg * g.gsA + (size_t)nxt.pm * tstepA : cA; const char* nB = has_next ? (const char*)g.Bt + (size_t)nxt.pg * g.gsB + (size_t)nxt.pn * tstepB : cB;
        for (int t = 0; t < nt; t += 2) {
            const bool last = (t == nt - 2);
            const char* a1 = cA + (size_t)(t + 1) * kstep;
            const char* a2 = last ? nA : cA + (size_t)(t + 2) * kstep; const char* b2 = last ? nB : cB + (size_t)(t + 2) * kstep;
            const char* a3 = a2 + kstep; const char* b3 = b2 + kstep;
            if constexpr (SP2) {
            PG8_LDB(B0, 0, 0); PG8_LDB(B1, 0, 1); PG8_SCHED; PG8_LDA(At, 0, 0); PG8_STAGE(PG8_SA(1, 1), a1 + hstepA, voffA);
            PG8_WAIT_V(8); PG8_WAIT_L(0); PG8_BAR; PG8_MMA(0, 0, At, B0); PG8_MMA(0, 1, At, B1); PG8_BAR; PG8_SCHED;
            PG8_LDA(At, 0, 1); PG8_STAGE(PG8_SB(0, 0), b2, voffB); PG8_STAGE(PG8_SB(0, 1), b2 + hstepB, voffB); PG8_STAGE(PG8_SA(0, 0), a2, voffA);
            PG8_WAIT_V(8); PG8_WAIT_L(0); PG8_BAR; PG8_MMA(1, 0, At, B0); PG8_MMA(1, 1, At, B1); PG8_BAR; PG8_SCHED;
            PG8_LDB(B0, 1, 0); PG8_LDB(B1, 1, 1); PG8_SCHED; PG8_LDA(At, 1, 0); PG8_STAGE(PG8_SA(0, 1), a2 + hstepA, voffA);
            PG8_WAIT_V(8); PG8_WAIT_L(0); PG8_BAR; PG8_MMA(0, 0, At, B0); PG8_MMA(0, 1, At, B1); PG8_BAR; PG8_SCHED;
            PG8_LDA(At, 1, 1); PG8_STAGE(PG8_SB(1, 0), b3, voffB); PG8_STAGE(PG8_SB(1, 1), b3 + hstepB, voffB); PG8_STAGE(PG8_SA(1, 0), a3, voffA);
            PG8_WAIT_V(8); PG8_WAIT_L(0); PG8_BAR; PG8_MMA(1, 0, At, B0); PG8_MMA(1, 1, At, B1); PG8_BAR; PG8_SCHED;
            } else {
            PG8_LDB(B0, 0, 0); PG8_SCHED; PG8_LDA(At, 0, 0); PG8_STAGE(PG8_SA(1, 1), a1 + hstepA, voffA);
            PG8_WAIT_L(8); PG8_BAR; PG8_WAIT_L(0); PG8_MMA(0, 0, At, B0); PG8_BAR; PG8_SCHED;
            PG8_LDB(B1, 0, 1); PG8_STAGE(PG8_SB(0, 0), b2, voffB);
            PG8_BAR; PG8_WAIT_L(0); PG8_MMA(0, 1, At, B1); PG8_BAR;
            PG8_LDA(At, 0, 1); PG8_STAGE(PG8_SA(0, 0), a2, voffA);
            PG8_BAR; PG8_WAIT_L(0); PG8_MMA(1, 0, At, B0); PG8_BAR; PG8_SCHED;
            PG8_STAGE(PG8_SB(0, 1), b2 + hstepB, voffB);
            PG8_WAIT_V(6); PG8_BAR; PG8_MMA(1, 1, At, B1); PG8_BAR;
            PG8_LDB(B0, 1, 0); PG8_SCHED; PG8_LDA(At, 1, 0); PG8_STAGE(PG8_SA(0, 1), a2 + hstepA, voffA);
            PG8_WAIT_L(8); PG8_BAR; PG8_WAIT_L(0); PG8_MMA(0, 0, At, B0); PG8_BAR; PG8_SCHED;
            PG8_LDB(B1, 1, 1); PG8_STAGE(PG8_SB(1, 0), b3, voffB);
            PG8_BAR; PG8_WAIT_L(0); PG8_MMA(0, 1, At, B1); PG8_BAR;
            PG8_LDA(At, 1, 1); PG8_STAGE(PG8_SA(1, 0), a3, voffA);
            PG8_BAR; PG8_WAIT_L(0); PG8_MMA(1, 0, At, B0); PG8_BAR; PG8_SCHED;
            PG8_STAGE(PG8_SB(1, 1), b3 + hstepB, voffB);
            PG8_WAIT_V(6); PG8_BAR; PG8_MMA(1, 1, At, B1); PG8_BAR;
            }
        }
        if constexpr (ALIGN_EPI) { if (wr == 0) PG8_BAR; }
        if constexpr (!Epi::AFTER_DRAIN) { E(acc, cur, wr, wc, fr, fq); }
        if (!has_next) break;
        if constexpr (Epi::HAS_INIT) E.init(acc, nxt, wr, wc, fr, fq);
        else {
#pragma unroll
        for (int a = 0; a < 2; ++a)
#pragma unroll
            for (int b = 0; b < 2; ++b)
#pragma unroll
                for (int m = 0; m < 4; ++m)
#pragma unroll
                    for (int n = 0; n < 2; ++n) acc[a][b][m][n] = (f32x4){0.f, 0.f, 0.f, 0.f};
        }
        cur = nxt; cA = nA; cB = nB; ++ui;
        if constexpr (ALIGN_EPI) { if (wr == 1) PG8_BAR; }
    }
    PG8_WAIT_V(0);
    if constexpr (!ALIGN_EPI) { if (wr == 0) PG8_BAR; }
    PG8_BAR;
    if constexpr (Epi::AFTER_DRAIN) { E.fused(acc, cur, wr, wc, fr, fq, lds, wid, lane); }
#undef PG8_SA
#undef PG8_SB
#undef PG8_STAGE
#undef PG8_LDA
#undef PG8_LDB
#undef PG8_MMA
#undef PG8_WAIT_V
#undef PG8_WAIT_L
#undef PG8_BAR
#undef PG8_SCHED
}
}
#define PG8_SP2 true
#define PG8_ALIGN true

namespace epi {
using pg8::f32x4; using pg8::u32x4; using pg8::u32x2; using pg8::Unit; using pg8::cvt_pk_bf16;
constexpr int HALF = 128, BM = 256;

__device__ __forceinline__ float rstd_row(const float* ssq, int row, int fq) {
    const f32x4 p = *(const f32x4*)(ssq + (size_t)row * 16 + 4 * fq);
    float s = (p[0] + p[1]) + (p[2] + p[3]);
    s += __shfl_xor(s, 16); s += __shfl_xor(s, 32);
    return rsqrtf(s * (1.f / DM) + RMS_EPS);
}
__device__ __forceinline__ void rstd8(const float* ssq, int row0, int fq, float (&rs)[8]) {
    f32x4 p[8];
#pragma unroll
    for (int i = 0; i < 8; ++i) p[i] = *(const f32x4*)(ssq + (size_t)(row0 + (i >> 2) * HALF + (i & 3) * 16) * 16 + 4 * fq);
#pragma unroll
    for (int i = 0; i < 8; ++i) { float s = (p[i][0] + p[i][1]) + (p[i][2] + p[i][3]); s += __shfl_xor(s, 16); s += __shfl_xor(s, 32); rs[i] = rsqrtf(s * (1.f / DM) + RMS_EPS); }
}
__device__ __forceinline__ u32x4 pack8(const f32x4& a, const f32x4& b) { u32x4 w; w.x = cvt_pk_bf16(a[0], a[1]); w.y = cvt_pk_bf16(a[2], a[3]); w.z = cvt_pk_bf16(b[0], b[1]); w.w = cvt_pk_bf16(b[2], b[3]); return w; }

struct EpiSwiGLU {
    static constexpr bool PERM = true, AFTER_DRAIN = false, HAS_INIT = false;
    bf16_t* act; const float* ssq;
    __device__ __forceinline__ void operator()(const f32x4 (&acc)[2][2][4][2], const Unit& u, int wr, int wc, int fr, int fq) const {
        const int row0 = u.pm * BM + wr * 64 + fr, col0 = u.pn * HALF + wc * 32 + 8 * fq;
        float rs8[8]; rstd8(ssq, row0, fq, rs8);
#pragma unroll
        for (int ai = 0; ai < 2; ++ai)
#pragma unroll
            for (int m = 0; m < 4; ++m) { const int row = row0 + ai * HALF + m * 16; const float rs = rs8[ai * 4 + m];
                f32x4 o[2];
#pragma unroll
                for (int n = 0; n < 2; ++n)
#pragma unroll
                    for (int j = 0; j < 4; ++j) { const float gv = acc[ai][0][m][n][j] * rs, uv = acc[ai][1][m][n][j] * rs; o[n][j] = gv * fsigmoid(gv) * uv; }
                *(u32x4*)(act + (size_t)row * FF + col0) = pack8(o[0], o[1]); }
    }
};

__device__ __forceinline__ void unpack8(const u32x4& w, f32x4& a, f32x4& b) {
    a[0] = __uint_as_float(w.x << 16); a[1] = __uint_as_float(w.x & 0xffff0000u); a[2] = __uint_as_float(w.y << 16); a[3] = __uint_as_float(w.y & 0xffff0000u);
    b[0] = __uint_as_float(w.z << 16); b[1] = __uint_as_float(w.z & 0xffff0000u); b[2] = __uint_as_float(w.w << 16); b[3] = __uint_as_float(w.w & 0xffff0000u);
}
template <bool IN_BF16, bool OUT_F32>
struct EpiResid {
    static constexpr bool PERM = true, AFTER_DRAIN = false, HAS_INIT = true;
    const float* xin; const bf16_t* xb_in; float* out; float alpha; bf16_t* xb_out; float* ssq;
    __device__ __forceinline__ void init(f32x4 (&acc)[2][2][4][2], const Unit& u, int wr, int wc, int fr, int fq) const {
        const int row0 = u.pm * BM + wr * 64 + fr, col0 = u.pn * BM + wc * 32 + 8 * fq; const float ia = 1.f / alpha;
        if constexpr (IN_BF16) {
            u32x4 t[2][4][2];
#pragma unroll
            for (int ai = 0; ai < 2; ++ai)
#pragma unroll
                for (int m = 0; m < 4; ++m)
#pragma unroll
                    for (int bj = 0; bj < 2; ++bj) t[ai][m][bj] = *(const u32x4*)(xb_in + (size_t)(row0 + ai * HALF + m * 16) * DM + col0 + bj * HALF);
#pragma unroll
            for (int ai = 0; ai < 2; ++ai)
#pragma unroll
                for (int m = 0; m < 4; ++m)
#pragma unroll
                    for (int bj = 0; bj < 2; ++bj) { f32x4 a, b; unpack8(t[ai][m][bj], a, b); acc[ai][bj][m][0] = a * ia; acc[ai][bj][m][1] = b * ia; }
        } else {
#pragma unroll
            for (int ai = 0; ai < 2; ++ai)
#pragma unroll
                for (int m = 0; m < 4; ++m)
#pragma unroll
                    for (int bj = 0; bj < 2; ++bj) { const size_t ix = (size_t)(row0 + ai * HALF + m * 16) * DM + col0 + bj * HALF;
                        acc[ai][bj][m][0] = *(const f32x4*)(xin + ix); acc[ai][bj][m][1] = *(const f32x4*)(xin + ix + 4); }
#pragma unroll
            for (int ai = 0; ai < 2; ++ai)
#pragma unroll
                for (int m = 0; m < 4; ++m)
#pragma unroll
                    for (int bj = 0; bj < 2; ++bj) { acc[ai][bj][m][0] *= ia; acc[ai][bj][m][1] *= ia; }
        }
    }
    __device__ __forceinline__ void operator()(const f32x4 (&acc)[2][2][4][2], const Unit& u, int wr, int wc, int fr, int fq) const {
        const int row0 = u.pm * BM + wr * 64 + fr, col0 = u.pn * BM + wc * 32 + 8 * fq;
#pragma unroll
        for (int ai = 0; ai < 2; ++ai)
#pragma unroll
            for (int m = 0; m < 4; ++m) { const int row = row0 + ai * HALF + m * 16; float ss = 0.f;
#pragma unroll
                for (int bj = 0; bj < 2; ++bj) { const size_t ix = (size_t)row * DM + col0 + bj * HALF;
                    const f32x4 o0 = acc[ai][bj][m][0] * alpha, o1 = acc[ai][bj][m][1] * alpha;
                    if constexpr (OUT_F32) { *(f32x4*)(out + ix) = o0; *(f32x4*)(out + ix + 4) = o1; }
                    else { *(u32x4*)(xb_out + ix) = pack8(o0, o1);
                        ss += (o0[0] * o0[0] + o0[1] * o0[1]) + (o0[2] * o0[2] + o0[3] * o0[3]) + (o1[0] * o1[0] + o1[1] * o1[1]) + (o1[2] * o1[2] + o1[3] * o1[3]); } }
                if constexpr (!OUT_F32) { ss += __shfl_xor(ss, 16); ss += __shfl_xor(ss, 32); if (fq == 0) ssq[(size_t)row * 16 + u.pn * 4 + wc] = ss; } }
    }
};

__device__ __forceinline__ void unpack8u(const u32x2& w, f32x4& a, f32x4& b) {
    const float k = 1.f / 255.f;
    a[0] = (float)(w.x & 255u) * k; a[1] = (float)((w.x >> 8) & 255u) * k; a[2] = (float)((w.x >> 16) & 255u) * k; a[3] = (float)(w.x >> 24) * k;
    b[0] = (float)(w.y & 255u) * k; b[1] = (float)((w.y >> 8) & 255u) * k; b[2] = (float)((w.y >> 16) & 255u) * k; b[3] = (float)(w.y >> 24) * k;
}
struct EpiWin {
    static constexpr bool PERM = true, AFTER_DRAIN = false, HAS_INIT = false;
    const float* ssq; bf16_t *q, *ks, *vs, *kw, *vw, *kcr, *vcr, *acat, *sgn, *sgs; float* g3; const float *q_norm, *k_norm_slc, *k_norm_win;
    __device__ __forceinline__ void operator()(const f32x4 (&acc)[2][2][4][2], const Unit& u, int wr, int wc, int fr, int fq) const {
        const int row0 = u.pm * BM + wr * 64 + fr, pn = u.pn;
        float rs8[8]; rstd8(ssq, row0, fq, rs8);
        if (pn < 5) {
            const int slot = 4 * pn + wc;
            bf16_t* base; int nh, idx; const float* gain = nullptr; float scale = 1.f;
            if (slot < 8) { base = q; nh = NH; idx = slot; gain = q_norm; scale = C2; }
            else if (slot < 10) { base = kcr; nh = NG; idx = slot - 8; }
            else if (slot < 12) { base = vcr; nh = NG; idx = slot - 10; }
            else if (slot < 14) { base = ks; nh = NG; idx = slot - 12; gain = k_norm_slc; }
            else if (slot < 16) { base = vs; nh = NG; idx = slot - 14; }
            else if (slot < 18) { base = kw; nh = NG; idx = slot - 16; gain = k_norm_win; }
            else { base = vw; nh = NG; idx = slot - 18; }
            f32x4 gv[2][2];
#pragma unroll
            for (int bj = 0; bj < 2; ++bj)
#pragma unroll
                for (int n = 0; n < 2; ++n) gv[bj][n] = gain ? *(const f32x4*)(gain + 32 * bj + 8 * fq + 4 * n) * scale : (f32x4){1.f, 1.f, 1.f, 1.f};
#pragma unroll
            for (int ai = 0; ai < 2; ++ai)
#pragma unroll
                for (int m = 0; m < 4; ++m) { const int row = row0 + ai * HALF + m * 16; const float rs = rs8[ai * 4 + m]; const int b = row / SEQ, s = row % SEQ;
                    f32x4 v[2][2]; float ss = 0.f;
#pragma unroll
                    for (int bj = 0; bj < 2; ++bj)
#pragma unroll
                        for (int n = 0; n < 2; ++n) { v[bj][n] = acc[ai][bj][m][n] * rs; ss += (v[bj][n][0] * v[bj][n][0] + v[bj][n][1] * v[bj][n][1]) + (v[bj][n][2] * v[bj][n][2] + v[bj][n][3] * v[bj][n][3]); }
                    float rn = 1.f;
                    if (gain) { ss += __shfl_xor(ss, 16); ss += __shfl_xor(ss, 32); rn = rsqrtf(ss * (1.f / 64.f) + RMS_EPS); }
                    bf16_t* dst = base + (((size_t)b * nh + idx) * SEQ + s) * 64 + 8 * fq;
#pragma unroll
                    for (int bj = 0; bj < 2; ++bj) *(u32x4*)(dst + 32 * bj) = pack8(v[bj][0] * gv[bj][0] * rn, v[bj][1] * gv[bj][1] * rn); }
        } else if (pn < 7) {
#pragma unroll
            for (int ai = 0; ai < 2; ++ai)
#pragma unroll
                for (int m = 0; m < 4; ++m) { const int row = row0 + ai * HALF + m * 16; const float rs = rs8[ai * 4 + m]; const int b = row / SEQ, s = row % SEQ;
#pragma unroll
                    for (int bj = 0; bj < 2; ++bj) { const int ch0 = 256 * (pn - 5) + 128 * bj + 32 * wc + 8 * fq, g = ch0 >> 4, ci0 = ch0 & 15;
                        *(u32x4*)(acat + ((size_t)g * 512 + b * 64 + (s >> 6)) * ACAT_LD + (s & 63) * 16 + ci0) = pack8(acc[ai][bj][m][0] * rs, acc[ai][bj][m][1] * rs); } }
        } else if (pn < 15) {
            unsigned char* dstb = (unsigned char*)(pn < 11 ? sgn : sgs) + 256 * (pn - (pn < 11 ? 7 : 11)) + 32 * wc + 8 * fq;
#pragma unroll
            for (int ai = 0; ai < 2; ++ai)
#pragma unroll
                for (int m = 0; m < 4; ++m) { const int row = row0 + ai * HALF + m * 16; const float rs = rs8[ai * 4 + m];
#pragma unroll
                    for (int bj = 0; bj < 2; ++bj) { f32x4 a, b2;
#pragma unroll
                        for (int j = 0; j < 4; ++j) { a[j] = fsigmoid(acc[ai][bj][m][0][j] * rs) * 255.f + 0.5f; b2[j] = fsigmoid(acc[ai][bj][m][1][j] * rs) * 255.f + 0.5f; }
                        u32x2 w; w.x = (unsigned)a[0] | ((unsigned)a[1] << 8) | ((unsigned)a[2] << 16) | ((unsigned)a[3] << 24); w.y = (unsigned)b2[0] | ((unsigned)b2[1] << 8) | ((unsigned)b2[2] << 16) | ((unsigned)b2[3] << 24);
                        *(u32x2*)(dstb + (size_t)row * DM + 128 * bj) = w; } }
        } else {
#pragma unroll
            for (int ai = 0; ai < 2; ++ai)
#pragma unroll
                for (int m = 0; m < 4; ++m) { const int row = row0 + ai * HALF + m * 16; const float rs = rs8[ai * 4 + m];
                    if (wc == 0 && fq < 3) {
#pragma unroll
                        for (int n = 0; n < 2; ++n) { f32x4 a;
#pragma unroll
                            for (int j = 0; j < 4; ++j) a[j] = fsigmoid(acc[ai][0][m][n][j] * rs);
                            *(f32x4*)(g3 + (size_t)row * 24 + 8 * fq + 4 * n) = a; } } }
        }
    }
};
struct EpiNsa {
    static constexpr bool PERM = true, AFTER_DRAIN = false, HAS_INIT = false;
    const bf16_t* sgn; bf16_t* m1;
    __device__ __forceinline__ void operator()(const f32x4 (&acc)[2][2][4][2], const Unit& u, int wr, int wc, int fr, int fq) const {
        const int row0 = u.pm * BM + wr * 64 + fr, col0 = u.pn * BM + wc * 32 + 8 * fq;
#pragma unroll
        for (int ai = 0; ai < 2; ++ai) {
            u32x2 g[4][2];
#pragma unroll
            for (int m = 0; m < 4; ++m)
#pragma unroll
                for (int bj = 0; bj < 2; ++bj) g[m][bj] = *(const u32x2*)((const unsigned char*)sgn + (size_t)(row0 + ai * HALF + m * 16) * DM + col0 + bj * HALF);
#pragma unroll
            for (int m = 0; m < 4; ++m)
#pragma unroll
                for (int bj = 0; bj < 2; ++bj) { const size_t ix = (size_t)(row0 + ai * HALF + m * 16) * DM + col0 + bj * HALF; f32x4 ga, gb; unpack8u(g[m][bj], ga, gb);
                    *(u32x4*)(m1 + ix) = pack8(ga * acc[ai][bj][m][0], gb * acc[ai][bj][m][1]); }
        }
    }
};
struct EpiGlu {
    static constexpr bool PERM = true, AFTER_DRAIN = false, HAS_INIT = false;
    const bf16_t* sgs; const bf16_t* m1; bf16_t* merged;
    __device__ __forceinline__ void operator()(const f32x4 (&acc)[2][2][4][2], const Unit& u, int wr, int wc, int fr, int fq) const {
        const int row0 = u.pm * BM + wr * 64 + fr, col0 = u.pn * HALF + wc * 32 + 8 * fq;
#pragma unroll
        for (int ai = 0; ai < 2; ++ai) {
            u32x2 gs[4]; u32x4 mm[4];
#pragma unroll
            for (int m = 0; m < 4; ++m) { const size_t ix = (size_t)(row0 + ai * HALF + m * 16) * DM + col0; gs[m] = *(const u32x2*)((const unsigned char*)sgs + ix); mm[m] = *(const u32x4*)(m1 + ix); }
#pragma unroll
            for (int m = 0; m < 4; ++m) { const size_t ix = (size_t)(row0 + ai * HALF + m * 16) * DM + col0;
                f32x4 ga, gb, ma, mb; unpack8u(gs[m], ga, gb); unpack8(mm[m], ma, mb);
                f32x4 oa, ob;
#pragma unroll
                for (int j = 0; j < 4; ++j) { oa[j] = ma[j] + ga[j] * acc[ai][0][m][0][j] * fsigmoid(acc[ai][1][m][0][j]); ob[j] = mb[j] + gb[j] * acc[ai][0][m][1][j] * fsigmoid(acc[ai][1][m][1][j]); }
                *(u32x4*)(merged + ix) = pack8(oa, ob); }
        }
    }
};
struct EpiCmp1 {
    static constexpr bool PERM = true, AFTER_DRAIN = false, HAS_INIT = false;
    bf16_t* hid; const float* biasp;
    __device__ __forceinline__ void operator()(const f32x4 (&acc)[2][2][4][2], const Unit& u, int wr, int wc, int fr, int fq) const {
        const int row0 = u.pm * BM + wr * 64 + fr, col0 = wc * 32 + 8 * fq;
        f32x4 bv[2][2];
#pragma unroll
        for (int bj = 0; bj < 2; ++bj)
#pragma unroll
            for (int n = 0; n < 2; ++n) { f32x4 s = {0.f, 0.f, 0.f, 0.f};
#pragma unroll
                for (int k = 0; k < 8; ++k) s += *(const f32x4*)(biasp + ((size_t)u.pg * 8 + k) * 256 + col0 + bj * HALF + 4 * n);
                bv[bj][n] = s; }
#pragma unroll
        for (int ai = 0; ai < 2; ++ai)
#pragma unroll
            for (int m = 0; m < 4; ++m) { const int row = row0 + ai * HALF + m * 16;
#pragma unroll
                for (int bj = 0; bj < 2; ++bj) { f32x4 a, b2;
#pragma unroll
                    for (int j = 0; j < 4; ++j) { a[j] = fgelu_tanh(acc[ai][bj][m][0][j] + bv[bj][0][j]); b2[j] = fgelu_tanh(acc[ai][bj][m][1][j] + bv[bj][1][j]); }
                    *(u32x4*)(hid + ((size_t)u.pg * 4096 + row) * 256 + col0 + bj * HALF) = pack8(a, b2); } }
    }
};
struct EpiSst {
    static constexpr bool PERM = false, AFTER_DRAIN = false, HAS_INIT = false;
    float* S;
    __device__ __forceinline__ void operator()(const f32x4 (&acc)[2][2][4][2], const Unit& u, int wr, int wc, int fr, int fq) const {
        const int row0 = u.pm * BM + wr * 64 + fr, col0 = wc * 32 + 4 * fq;
#pragma unroll
        for (int ai = 0; ai < 2; ++ai)
#pragma unroll
            for (int m = 0; m < 4; ++m) { float* rp = S + ((size_t)u.pg * 512 + row0 + ai * HALF + m * 16) * 128 + col0;
#pragma unroll
                for (int n = 0; n < 2; ++n) *(f32x4*)(rp + 16 * n) = acc[ai][0][m][n]; }
    }
};
struct EpiSsmOut {
    static constexpr bool PERM = true, AFTER_DRAIN = false, HAS_INIT = false;
    const bf16_t* acat; const float* dskip; bf16_t* geluy;
    __device__ __forceinline__ void operator()(const f32x4 (&acc)[2][2][4][2], const Unit& u, int wr, int wc, int fr, int fq) const {
        const int g = u.pg, row0 = u.pm * BM + wr * 64 + fr;
        f32x4 dv[2];
#pragma unroll
        for (int bj = 0; bj < 2; ++bj) { }
        const int co0 = 8 * (fq & 1);
        dv[0] = *(const f32x4*)(dskip + g * 16 + co0); dv[1] = *(const f32x4*)(dskip + g * 16 + co0 + 4);
#pragma unroll
        for (int ai = 0; ai < 2; ++ai) {
            u32x4 uu[4][2];
#pragma unroll
            for (int m = 0; m < 4; ++m)
#pragma unroll
                for (int bj = 0; bj < 2; ++bj) uu[m][bj] = *(const u32x4*)(acat + ((size_t)g * 512 + row0 + ai * HALF + m * 16) * ACAT_LD + u.pn * BM + bj * HALF + wc * 32 + 8 * fq);
#pragma unroll
            for (int m = 0; m < 4; ++m) { const int rr = row0 + ai * HALF + m * 16, b = rr >> 6, c = rr & 63;
#pragma unroll
                for (int bj = 0; bj < 2; ++bj) { const int col = u.pn * BM + bj * HALF + wc * 32 + 8 * fq, i = col >> 4;
                    f32x4 ua, ub; unpack8(uu[m][bj], ua, ub);
                    f32x4 ya = acc[ai][bj][m][0] + dv[0] * ua, yb = acc[ai][bj][m][1] + dv[1] * ub;
#pragma unroll
                    for (int j = 0; j < 4; ++j) { ya[j] = fgelu_tanh(ya[j]); yb[j] = fgelu_tanh(yb[j]); }
                    *(u32x4*)(geluy + ((size_t)b * SEQ + 64 * c + i) * 512 + 16 * g + co0) = pack8(ya, yb); } }
        }
    }
};
}

constexpr int NWAVES = 8;
constexpr int RING_OFF = 0, RING_BYTES = 131072;
constexpr int LDS_BYTES = 163840;
constexpr int LDSCTL_OFF = LDS_BYTES - 512, MISC_OFF = LDSCTL_OFF + 320;
constexpr int CW_TMO = 0, CW_CODE = 1, CW_TOEP = 64, CW_BAR = 4096;

#define GAS __attribute__((address_space(1)))
#define LAS __attribute__((address_space(3)))
typedef unsigned v4u __attribute__((ext_vector_type(4)));
typedef float f32x4 __attribute__((ext_vector_type(4)));
typedef GAS unsigned gu32;
#define RLX_AGENT __ATOMIC_RELAXED, __HIP_MEMORY_SCOPE_AGENT
#define LDS_WAIT() asm volatile("s_waitcnt lgkmcnt(0)" ::: "memory")
#define VM_WAIT() asm volatile("s_waitcnt vmcnt(0)" ::: "memory")

#define XB_TMO      128
#define XB_XCNT(j)  (256  + 64 * (j))
#define XB_XSUB(j)  (1280 + 64 * (j))
#define XB_XGEN(j)  (2304 + 64 * (j))
#define XB_TOP      3328
#define XB_TOPGEN   3392
#define XCD_BAR_WORDS 3456
#define XB_SPIN_CAP (1u << 18)
__device__ __forceinline__ unsigned xb_ld(unsigned* p)              { return __hip_atomic_load(p, __ATOMIC_RELAXED, __HIP_MEMORY_SCOPE_AGENT); }
__device__ __forceinline__ unsigned xb_add(unsigned* p, unsigned v) { return __hip_atomic_fetch_add(p, v, __ATOMIC_RELAXED, __HIP_MEMORY_SCOPE_AGENT); }
__device__ __forceinline__ unsigned xb_xcc_id() { return (unsigned)__builtin_amdgcn_s_getreg((3 << 11) | 20) & 0xFu; }
#define XB_SPIN(cond, bar) do { unsigned _sp = 0; while (cond) { __builtin_amdgcn_s_sleep(1); \
    if ((++_sp & 255u) == 0u) { if (xb_ld(&(bar)[XB_TMO])) break; if (_sp > XB_SPIN_CAP) { atomicAdd(&(bar)[XB_TMO], 1u); break; } } } } while (0)
struct XcdBarrier { unsigned* bar; unsigned x; volatile LAS unsigned* st; };
__device__ __forceinline__ XcdBarrier xcd_barrier_post(unsigned* bar, volatile LAS unsigned* st) {
    XcdBarrier b; b.bar = bar; b.x = xb_xcc_id(); b.st = st;
    if (threadIdx.x == 0) (void)xb_add(&bar[XB_XCNT(b.x)], 1u);
    return b;
}
__device__ __forceinline__ void xcd_barrier_complete(unsigned* bar, unsigned x, unsigned& nloc, unsigned& nx) {
    const unsigned G = gridDim.x * gridDim.y * gridDim.z;
    unsigned sum, cnt, mine, sp = 0u;
    for (;;) {
        sum = 0u; cnt = 0u; mine = 0u;
#pragma unroll
        for (unsigned j = 0; j < 16; ++j) { const unsigned c = xb_ld(&bar[XB_XCNT(j)]); sum += c; cnt += (c > 0u) ? 1u : 0u; mine = (j == x) ? c : mine; }
        if (sum == G) break;
        __builtin_amdgcn_s_sleep(1);
        if ((++sp & 255u) == 0u) { if (xb_ld(&bar[XB_TMO])) break; if (sp > XB_SPIN_CAP) { atomicAdd(&bar[XB_TMO], 1u); break; } }
    }
    nloc = mine > 0u ? mine : 1u; nx = cnt > 0u ? cnt : 1u;
}
__device__ __forceinline__ void xcd_barrier(const XcdBarrier& b) {
    asm volatile("s_waitcnt vmcnt(0)" ::: "memory");
    __syncthreads();
    if (threadIdx.x == 0) {
        unsigned* bar = b.bar;
        __builtin_amdgcn_s_waitcnt(0);
        unsigned nloc = b.st[0], nx = b.st[1];
        if (nloc == 0u) { xcd_barrier_complete(bar, b.x, nloc, nx); b.st[0] = nloc; b.st[1] = nx; }
        const unsigned old = xb_add(&bar[XB_XSUB(b.x)], 1u);
        const unsigned gen = old / nloc;
        if (old + 1u == (gen + 1u) * nloc) {
            __builtin_amdgcn_fence(__ATOMIC_RELEASE, "agent");
            asm volatile("s_waitcnt vmcnt(0)" ::: "memory");
            const unsigned og = xb_add(&bar[XB_TOP], 1u);
            const unsigned tg = og / nx;
            if (og + 1u == (tg + 1u) * nx) xb_add(&bar[XB_TOPGEN], 1u);
            else XB_SPIN(xb_ld(&bar[XB_TOPGEN]) == tg, bar);
            __builtin_amdgcn_fence(__ATOMIC_ACQUIRE, "agent");
            xb_add(&bar[XB_XGEN(b.x)], 1u);
            asm volatile("s_waitcnt vmcnt(0)" ::: "memory");
        } else {
            XB_SPIN(xb_ld(&bar[XB_XGEN(b.x)]) == gen, bar);
            __builtin_amdgcn_fence(__ATOMIC_ACQUIRE, "agent");
            asm volatile("s_waitcnt vmcnt(0)" ::: "memory");
        }
    }
    __syncthreads();
}

struct Args { const float* in[32]; float* out; unsigned char* ws; int ph_lo, ph_hi, fused, pad; };
struct Frame {
    LAS unsigned char* lds; volatile LAS unsigned* MISC; gu32* ctl;
    int tid, lane, wave, vcu, G;
};
enum Phase { PH_PRO = 0, PH_F1GU, PH_F1D, PH_WIN, PH_MIDA, PH_MIDB, PH_NSA, PH_GLU, PH_WOUT, PH_F2GU, PH_F2D, NPH };

template <class MAP>
__device__ __forceinline__ void transpose_item(const float* W, int ldw, bf16_t* WT, int ldt, int k0, int n0, const MAP& srccol, LAS float* scr, int lane, const float* rowscale = nullptr) {
    const int n4 = (lane & 7) * 4, sc = srccol(n0 + n4), kr = lane >> 3;
    f32x4 v[8];
#pragma unroll
    for (int i = 0; i < 8; ++i) v[i] = sc >= 0 ? *(const f32x4*)(W + (size_t)(k0 + kr + 8 * i) * ldw + sc) : (f32x4){0.f, 0.f, 0.f, 0.f};
    if (rowscale) {
#pragma unroll
        for (int i = 0; i < 8; ++i) v[i] = v[i] * rowscale[k0 + kr + 8 * i];
    }
#pragma unroll
    for (int i = 0; i < 8; ++i) { LAS float* d = scr + (kr + 8 * i) * 33 + n4; d[0] = v[i][0]; d[1] = v[i][1]; d[2] = v[i][2]; d[3] = v[i][3]; }
    LDS_WAIT(); asm volatile("" ::: "memory");
    const int c = lane & 7;
#pragma unroll
    for (int j = 0; j < 4; ++j) { const int n = (lane >> 3) + 8 * j; const LAS float* s = scr + (8 * c) * 33 + n;
        v4u o; o.x = pk2(s[0 * 33], s[1 * 33]); o.y = pk2(s[2 * 33], s[3 * 33]); o.z = pk2(s[4 * 33], s[5 * 33]); o.w = pk2(s[6 * 33], s[7 * 33]);
        *(GAS v4u*)(WT + (size_t)(n0 + n) * ldt + k0 + 8 * c) = o; }
    LDS_WAIT(); asm volatile("" ::: "memory");
}
__device__ __forceinline__ void prep_row2(const float* x0, const float* x1, const float* g, bf16_t* o0, bf16_t* o1, float* q0, float* q1, int lane) {
    const GAS f32x4* xa = (const GAS f32x4*)x0 + lane; const GAS f32x4* xb = (const GAS f32x4*)x1 + lane; (void)g;
    f32x4 va[4], vb[4];
#pragma unroll
    for (int j = 0; j < 4; ++j) { va[j] = xa[64 * j]; vb[j] = xb[64 * j]; }
    GAS unsigned long long* oa = (GAS unsigned long long*)o0 + lane; GAS unsigned long long* ob = (GAS unsigned long long*)o1 + lane;
    float sa = 0.f, sb = 0.f;
#pragma unroll
    for (int j = 0; j < 4; ++j) { const f32x4 a = va[j], b = vb[j];
        sa += (a.x * a.x + a.y * a.y) + (a.z * a.z + a.w * a.w); sb += (b.x * b.x + b.y * b.y) + (b.z * b.z + b.w * b.w);
        oa[64 * j] = (unsigned long long)pk2(a.x, a.y) | ((unsigned long long)pk2(a.z, a.w) << 32);
        ob[64 * j] = (unsigned long long)pk2(b.x, b.y) | ((unsigned long long)pk2(b.z, b.w) << 32); }
    sa = wave_sum(sa); sb = wave_sum(sb);
    if (lane < 16) { q0[lane] = (lane == 0) ? sa : 0.f; q1[lane] = (lane == 0) ? sb : 0.f; }
}
__device__ __forceinline__ void prep_row(const float* xrow, const float* g, bf16_t* orow, float* ssqrow, int lane) {
    const GAS f32x4* xr = (const GAS f32x4*)xrow + lane; const GAS f32x4* gr = (const GAS f32x4*)g + lane;
    GAS unsigned long long* o8 = (GAS unsigned long long*)orow + lane;
    float s = 0.f;
#pragma unroll
    for (int j = 0; j < 4; ++j) { const f32x4 v = xr[64 * j], gg = gr[64 * j]; s += (v.x * v.x + v.y * v.y) + (v.z * v.z + v.w * v.w);
        o8[64 * j] = (unsigned long long)pk2(v.x * gg.x, v.y * gg.y) | ((unsigned long long)pk2(v.z * gg.z, v.w * gg.w) << 32); }
    s = wave_sum(s);
    if (lane < 16) ssqrow[lane] = (lane == 0) ? s : 0.f;
}

struct Cplx { double r, i; };
__device__ __forceinline__ Cplx cmul(Cplx a, Cplx b) { return Cplx{a.r * b.r - a.i * b.i, a.r * b.i + a.i * b.r}; }
__device__ __forceinline__ Cplx apow(double lr, double li, double step, double e) { const double m = exp(lr * step * e), ang = li * step * e; return Cplx{m * cos(ang), m * sin(ang)}; }

__device__ __forceinline__ void ssm_weights_task(const Args& a, int g, int i, int lane, LAS float* scr) {
    unsigned char* ws = a.ws;
    const int p = lane;
    const double lr = a.in[18][g * 64 + p], li = a.in[19][g * 64 + p], step = exp((double)a.in[20][g]);
    const Cplx a1 = apow(lr, li, step, 1.0);
    const double den = lr * lr + li * li;
    const Cplx coef{((a1.r - 1.0) * lr + a1.i * li) / den, (a1.i * lr - (a1.r - 1.0) * li) / den};
    const Cplx ab = apow(lr, li, step, (double)(63 - i)), ac = apow(lr, li, step, (double)i), ad = apow(lr, li, step, (double)(i + 1));
    float zr[16], zi[16];
    bf16_t* w1s = (bf16_t*)(ws + WS_W1S) + ((size_t)g * 128) * 1024;
    {
        unsigned pr[8], pi[8];
#pragma unroll
        for (int c = 0; c < 16; ++c) { const Cplx bb = cmul(coef, Cplx{(double)a.in[21][(g * 64 + p) * 16 + c], (double)a.in[22][(g * 64 + p) * 16 + c]});
            const Cplx zb = cmul(ab, bb), zc = cmul(ac, bb); zr[c] = (float)zc.r; zi[c] = (float)zc.i;
            const unsigned br = f2bf((float)zb.r), bi = f2bf((float)zb.i);
            if (c & 1) { pr[c >> 1] |= br << 16; pi[c >> 1] |= bi << 16; } else { pr[c >> 1] = br; pi[c >> 1] = bi; } }
        v4u* dr = (v4u*)(w1s + (size_t)p * 1024 + i * 16); v4u* di = (v4u*)(w1s + (size_t)(64 + p) * 1024 + i * 16);
        dr[0] = (v4u){pr[0], pr[1], pr[2], pr[3]}; dr[1] = (v4u){pr[4], pr[5], pr[6], pr[7]};
        di[0] = (v4u){pi[0], pi[1], pi[2], pi[3]}; di[1] = (v4u){pi[4], pi[5], pi[6], pi[7]};
    }
#pragma unroll
    for (int c = 0; c < 16; ++c) { scr[p * 16 + c] = zr[c]; scr[1024 + p * 16 + c] = zi[c]; }
    LDS_WAIT(); asm volatile("" ::: "memory");
    {
        const int co = lane >> 2, c4 = (lane & 3) * 4;
        f32x4 acc = {0.f, 0.f, 0.f, 0.f};
        for (int pp = 0; pp < 64; ++pp) { const float cr = a.in[23][(g * 16 + co) * 64 + pp], cm = a.in[24][(g * 16 + co) * 64 + pp];
            const f32x4 r4 = *(const LAS f32x4*)(scr + pp * 16 + c4), i4 = *(const LAS f32x4*)(scr + 1024 + pp * 16 + c4);
            acc += r4 * cr - i4 * cm; }
        *(f32x4*)((float*)(ws + WS_KTAB) + (((size_t)g * 64 + i) * 16 + co) * 16 + c4) = acc;
    }
    LDS_WAIT(); asm volatile("" ::: "memory");
    bf16_t* wt = (bf16_t*)(ws + WS_WTOEP) + ((size_t)g * 1024 + i * 16) * ACAT_LD + 1024;
#pragma unroll 4
    for (int co = 0; co < 16; ++co) { const Cplx z = cmul(Cplx{(double)a.in[23][(g * 16 + co) * 64 + p], (double)a.in[24][(g * 16 + co) * 64 + p]}, ad);
        wt[(size_t)co * ACAT_LD + p] = f2bf((float)z.r); wt[(size_t)co * ACAT_LD + 64 + p] = f2bf((float)(-z.i)); }
}
__device__ __forceinline__ void toep_row(unsigned char* ws, int row, int lane) {
    const int g = row >> 10, i = (row >> 4) & 63, co = row & 15, ip = lane;
    bf16_t* dst = (bf16_t*)(ws + WS_WTOEP) + (size_t)row * ACAT_LD + ip * 16;
    v4u o0 = {0u, 0u, 0u, 0u}, o1 = {0u, 0u, 0u, 0u};
    if (ip <= i) { const f32x4* k = (const f32x4*)((const float*)(ws + WS_KTAB) + (((size_t)g * 64 + (i - ip)) * 16 + co) * 16);
        const f32x4 k0 = k[0], k1 = k[1], k2 = k[2], k3 = k[3];
        o0 = (v4u){pk2(k0[0], k0[1]), pk2(k0[2], k0[3]), pk2(k1[0], k1[1]), pk2(k1[2], k1[3])};
        o1 = (v4u){pk2(k2[0], k2[1]), pk2(k2[2], k2[3]), pk2(k3[0], k3[1]), pk2(k3[2], k3[3])}; }
    ((v4u*)dst)[0] = o0; ((v4u*)dst)[1] = o1;
}
__device__ __forceinline__ void ssm_carry_scan(const Args& a, int g, int pm, int tid) {
    if (tid >= 256) return;
    unsigned char* ws = a.ws;
    const int bl = tid >> 6, p = tid & 63, b = 4 * pm + bl;
    const double lr = a.in[18][g * 64 + p], li = a.in[19][g * 64 + p], step = exp((double)a.in[20][g]);
    const Cplx a64 = apow(lr, li, step, 64.0); const float ar = (float)a64.r, ai = (float)a64.i;
    const float* S = (const float*)(ws + WS_SST) + ((size_t)g * 512 + b * 64) * 128;
    bf16_t* X = (bf16_t*)(ws + WS_ACAT) + ((size_t)g * 512 + b * 64) * ACAT_LD + 1024;
    float xr = 0.f, xi = 0.f;
#pragma unroll 8
    for (int c = 0; c < 64; ++c) {
        X[(size_t)c * ACAT_LD + p] = f2bf(xr); X[(size_t)c * ACAT_LD + 64 + p] = f2bf(xi);
        const float sr = S[c * 128 + p], si = S[c * 128 + 64 + p];
        const float nr = ar * xr - ai * xi + sr, ni = ar * xi + ai * xr + si; xr = nr; xi = ni;
    }
}
namespace nsa {
typedef short bf16x8 __attribute__((ext_vector_type(8)));
typedef short s16x4 __attribute__((ext_vector_type(4)));
typedef float f32x16 __attribute__((ext_vector_type(16)));
typedef unsigned u32x4 __attribute__((ext_vector_type(4)));
typedef LAS const char* lds_cptr;
constexpr int SLOTB = 8192;
constexpr int L_K = 0, L_V = 2 * SLOTB, L_WSF = 4 * SLOTB, L_IMP = L_WSF + 8 * 256, L_SEL = L_IMP + 64 * 65 * 4, L_UNI = L_SEL + 64 * 8, L_TL = L_UNI + 64, L_OACC = L_TL + 512, L_QF = L_OACC + 8 * 8192, L_GT = L_QF + 8 * 4096, L_DUMP = L_GT + 8 * 3 * 64 * 4, L_END = L_DUMP + 1024;
static_assert(L_END <= LDSCTL_OFF && L_QF % 16 == 0, "attention LDS map");
__device__ __forceinline__ int crow(int r, int hi) { return (r & 3) + 8 * (r >> 2) + 4 * hi; }
#define NSA_MFMA(a, b, c) __builtin_amdgcn_mfma_f32_32x32x16_bf16(a, b, c, 0, 0, 0)
enum { M_NONE = 0, M_CAUSAL = 1, M_WINLO = 2, M_CMP = 3, M_SEL = 4, M_SELCAUSAL = 5 };

struct Ctx {
    LAS unsigned char* lds; int wid, lane, r32, hi, th, hh;
};
__device__ __forceinline__ void glds16(const void* gsrc, unsigned lds_dst) { unsigned keep;
    asm volatile("s_mov_b32 %0, m0\n\ts_mov_b32 m0, %2\n\ts_nop 0\n\tglobal_load_lds_dwordx4 %1, off\n\ts_mov_b32 m0, %0" : "=&s"(keep) : "v"(gsrc), "s"(lds_dst) : "memory"); }
__device__ __forceinline__ unsigned lds_addr(const Ctx& c, int off) { return (unsigned)__builtin_amdgcn_readfirstlane((int)(unsigned)(uintptr_t)c.lds + off); }
__device__ __forceinline__ int koff(int i) { return i < 2 ? L_K + i * SLOTB : L_IMP; }
__device__ __forceinline__ int voff(int i) { return i < 2 ? L_V + i * SLOTB : L_IMP + SLOTB; }
__device__ __forceinline__ void dma_kv(const Ctx& c, const bf16_t* Kt, const bf16_t* Vt, int s) {
    const int krow_ = c.wid * 8 + (c.lane >> 3);
    const bf16_t* ks = Kt + krow_ * 64 + ((c.lane & 7) ^ ((krow_ >> 1) & 7)) * 8;
    const bf16_t* vs = Vt + (16 * (c.wid & 3) + (c.lane >> 2)) * 64 + (c.wid >> 2) * 32 + (c.lane & 3) * 8;
    glds16(ks, lds_addr(c, koff(s) + c.wid * 1024));
    glds16(vs, lds_addr(c, voff(s) + c.wid * 1024));
}
__device__ __forceinline__ void dma_v(const Ctx& c, const bf16_t* Vt, int s) {
    const bf16_t* vs = Vt + (16 * (c.wid & 3) + (c.lane >> 2)) * 64 + (c.wid >> 2) * 32 + (c.lane & 3) * 8;
    glds16(vs, lds_addr(c, voff(s) + c.wid * 1024));
}
__device__ __forceinline__ void dma_k(const Ctx& c, const bf16_t* Kt, int s) {
    const int krow_ = c.wid * 8 + (c.lane >> 3);
    const bf16_t* ks = Kt + krow_ * 64 + ((c.lane & 7) ^ ((krow_ >> 1) & 7)) * 8;
    glds16(ks, lds_addr(c, koff(s) + c.wid * 1024));
}
__device__ __forceinline__ void prefetch_tile(const Ctx& c, const bf16_t* t) { glds16(t + c.wid * 512 + c.lane * 8, lds_addr(c, L_DUMP)); }
#define NSA_WAITBAR2() asm volatile("s_waitcnt vmcnt(2) lgkmcnt(0)\n\ts_barrier" ::: "memory")
#define NSA_WAITBAR() asm volatile("s_waitcnt vmcnt(0) lgkmcnt(0)\n\ts_barrier" ::: "memory")

__device__ __forceinline__ int kfrag_off(const Ctx& c, int d0) { return c.r32 * 128 + (((2 * d0 + c.hi) ^ ((c.r32 >> 1) & 7)) << 4); }
__device__ __forceinline__ void qkt(f32x16& p0, f32x16& p1, const Ctx& c, int s, const bf16x8 (&qr)[4]) {
    const lds_cptr kb = (lds_cptr)(c.lds + koff(s));
    p0 = f32x16{}; p1 = f32x16{};
#pragma unroll
    for (int d0 = 0; d0 < 4; ++d0) {
        const int ko = kfrag_off(c, d0);
        const bf16x8 b0 = *(const LAS bf16x8*)(kb + ko), b1 = *(const LAS bf16x8*)(kb + ko + 4096);
        p0 = NSA_MFMA(b0, qr[d0], p0); p1 = NSA_MFMA(b1, qr[d0], p1);
    }
}
__device__ __forceinline__ s16x4 vtr(lds_cptr p) { typedef short v4i16_t __attribute__((ext_vector_type(4))); return __builtin_bit_cast(s16x4, __builtin_amdgcn_ds_read_tr16_b64_v4i16((LAS v4i16_t*)p)); }
__device__ __forceinline__ void pv(f32x16 (&o)[2], const Ctx& c, int s, const bf16x8 (&pa)[4]) {
    const lds_cptr vp = (lds_cptr)(c.lds + voff(s)) + ((c.lane >> 4) & 1) * 32 + (c.lane & 3) * 8 + (4 * c.hi + ((c.lane & 15) >> 2)) * 64;
#pragma unroll
    for (int d0 = 0; d0 < 2; ++d0) {
        s16x4 lo[4], hh[4];
#pragma unroll
        for (int ks = 0; ks < 4; ++ks) { lo[ks] = vtr(vp + d0 * 4096 + ks * 1024); hh[ks] = vtr(vp + d0 * 4096 + ks * 1024 + 512); }
        __builtin_amdgcn_sched_barrier(0);
#pragma unroll
        for (int ks = 0; ks < 4; ++ks) { const bf16x8 vf = {lo[ks][0], lo[ks][1], lo[ks][2], lo[ks][3], hh[ks][0], hh[ks][1], hh[ks][2], hh[ks][3]}; o[d0] = NSA_MFMA(pa[ks], vf, o[d0]); }
        __builtin_amdgcn_sched_barrier(0);
    }
}
__device__ __forceinline__ float rowmax32(const f32x16& p0, const f32x16& p1) {
    float a = fmaxf(p0[0], p1[0]);
#pragma unroll
    for (int r = 1; r < 16; ++r) a = fmaxf(a, fmaxf(p0[r], p1[r]));
    return fmaxf(a, __shfl_xor(a, 32));
}
__device__ __forceinline__ unsigned cvtpk(float lo, float hi) { return pg8::cvt_pk_bf16(lo, hi); }
__device__ __forceinline__ void pack_p(bf16x8 (&pa)[4], const f32x16& p0, const f32x16& p1) {
    pa[0] = __builtin_bit_cast(bf16x8, (u32x4){cvtpk(p0[0], p0[1]), cvtpk(p0[2], p0[3]), cvtpk(p0[4], p0[5]), cvtpk(p0[6], p0[7])});
    pa[1] = __builtin_bit_cast(bf16x8, (u32x4){cvtpk(p0[8], p0[9]), cvtpk(p0[10], p0[11]), cvtpk(p0[12], p0[13]), cvtpk(p0[14], p0[15])});
    pa[2] = __builtin_bit_cast(bf16x8, (u32x4){cvtpk(p1[0], p1[1]), cvtpk(p1[2], p1[3]), cvtpk(p1[4], p1[5]), cvtpk(p1[6], p1[7])});
    pa[3] = __builtin_bit_cast(bf16x8, (u32x4){cvtpk(p1[8], p1[9]), cvtpk(p1[10], p1[11]), cvtpk(p1[12], p1[13]), cvtpk(p1[14], p1[15])});
}
template <int MODE>
__device__ __forceinline__ void apply_mask(f32x16& p0, f32x16& p1, int hi, int ql, int lim, bool rowsel) {
    if (MODE == M_NONE) return;
    const float NEG = -INFINITY;
    const int qh = ql - 4 * hi, lh = lim - 4 * hi;
#pragma unroll
    for (int r = 0; r < 16; ++r) {
        const int kc = (r & 3) + 8 * (r >> 2);
        bool v0 = true, v1 = true;
        if (MODE == M_CAUSAL || MODE == M_SELCAUSAL) { v0 = kc <= qh; v1 = kc + 32 <= qh; }
        if (MODE == M_WINLO) { v0 = kc > qh; v1 = kc + 32 > qh; }
        if (MODE == M_CMP) { v0 = kc <= lh; v1 = kc + 32 <= lh; }
        if (MODE == M_SEL || MODE == M_SELCAUSAL) { v0 = v0 && rowsel; v1 = v1 && rowsel; }
        if (!v0) p0[r] = NEG; if (!v1) p1[r] = NEG;
    }
}
struct Sm { float m, l; };
__device__ __forceinline__ float rowmax32_3(const f32x16& p0, const f32x16& p1) {
    float a = __builtin_fmaxf(__builtin_fmaxf(p0[0], p0[1]), p1[0]), b = __builtin_fmaxf(__builtin_fmaxf(p0[2], p0[3]), p1[1]);
    a = __builtin_fmaxf(__builtin_fmaxf(a, p1[2]), p1[3]);
#pragma unroll
    for (int r = 4; r < 16; r += 4) { a = __builtin_fmaxf(__builtin_fmaxf(a, p0[r]), p0[r + 1]); b = __builtin_fmaxf(__builtin_fmaxf(b, p0[r + 2]), p0[r + 3]);
        a = __builtin_fmaxf(__builtin_fmaxf(a, p1[r]), p1[r + 1]); b = __builtin_fmaxf(__builtin_fmaxf(b, p1[r + 2]), p1[r + 3]); }
    a = __builtin_fmaxf(a, b);
    return __builtin_fmaxf(a, __shfl_xor(a, 32));
}
constexpr float RESCALE_THR = 8.0f;
#define SGB(mask, n) __builtin_amdgcn_sched_group_barrier(mask, n, 0)
__device__ __forceinline__ void rescale_rows(Sm& st, f32x16 (&o)[2], f32x16& p0, f32x16& p1, const Ctx& c, float rm, bool first) {
    const float dl = first ? (rm > -INFINITY ? rm : 0.f) : __builtin_fmaxf(rm, 0.f), f = __builtin_amdgcn_exp2f(-dl);
    st.m += dl; st.l *= f;
#pragma unroll
    for (int r = 0; r < 16; ++r) { p0[r] -= dl; p1[r] -= dl; }
    LAS float* wsf = (LAS float*)(c.lds + L_WSF) + c.wid * 64;
    if (c.hi == 0) wsf[c.r32] = f;
    const LAS float* wsh = wsf + 4 * c.hi;
#pragma unroll
    for (int r = 0; r < 16; ++r) { const float fr_ = wsh[(r & 3) + 8 * (r >> 2)]; o[0][r] *= fr_; o[1][r] *= fr_; }
}
template <int DBG = 0>
__device__ __forceinline__ void exp_sum_pack(Sm& st, f32x16& p0, f32x16& p1, bf16x8 (&pa)[4]) {
    float sum = 0.f;
#pragma unroll
    for (int r = 0; r < 16; ++r) { if (!(DBG & 1)) { p0[r] = __builtin_amdgcn_exp2f(p0[r]); p1[r] = __builtin_amdgcn_exp2f(p1[r]); } sum += p0[r] + p1[r]; }
    st.l += sum;
    pack_p(pa, p0, p1);
}
__device__ __forceinline__ void read_kf(bf16x8 (&kf)[8], const Ctx& c, int ks) {
    const lds_cptr kb = (lds_cptr)(c.lds + koff(ks));
#pragma unroll
    for (int d0 = 0; d0 < 4; ++d0) { const int ko = kfrag_off(c, d0); kf[2 * d0] = *(const LAS bf16x8*)(kb + ko); kf[2 * d0 + 1] = *(const LAS bf16x8*)(kb + ko + 4096); }
}
__device__ __forceinline__ void read_vf(s16x4 (&vf)[16], const Ctx& c, int vs) {
    const lds_cptr vp = (lds_cptr)(c.lds + voff(vs)) + ((c.lane >> 4) & 1) * 32 + (c.lane & 3) * 8 + (4 * c.hi + ((c.lane & 15) >> 2)) * 64;
#pragma unroll
    for (int i = 0; i < 8; ++i) { vf[2 * i] = vtr(vp + (i >> 2) * 4096 + (i & 3) * 1024); vf[2 * i + 1] = vtr(vp + (i >> 2) * 4096 + (i & 3) * 1024 + 512); }
}
template <int DBG = 0>
__device__ __forceinline__ void block_b(f32x16& n0, f32x16& n1, const Ctx& c, const bf16x8 (&kf)[8], const bf16x8 (&qr)[4], s16x4 (&vf)[16], int vs, float cinit, Sm& st, f32x16& p0, f32x16& p1, bf16x8 (&pa)[4]) {
    read_vf(vf, c, vs);
    f32x16 cv;
#pragma unroll
    for (int r = 0; r < 16; ++r) cv[r] = cinit;
#pragma unroll
    for (int d0 = 0; d0 < 4; ++d0) { n0 = NSA_MFMA(kf[2 * d0], qr[d0], d0 == 0 ? cv : n0); n1 = NSA_MFMA(kf[2 * d0 + 1], qr[d0], d0 == 0 ? cv : n1); }
    exp_sum_pack<DBG>(st, p0, p1, pa);
}
template <bool HASN, int DBG = 0, bool NORESC = false>
__device__ __forceinline__ float block_c(f32x16 (&o)[2], const Ctx& c, const s16x4 (&vf)[16], const bf16x8 (&pa)[4], const f32x16& n0, const f32x16& n1, bf16x8 (&kf)[8], int ks2) {
    if (HASN) { if (ks2 >= 0) read_kf(kf, c, ks2); }
    float rm = -INFINITY;
#pragma unroll
    for (int i = 0; i < 8; ++i) { const bf16x8 v8 = {vf[2 * i][0], vf[2 * i][1], vf[2 * i][2], vf[2 * i][3], vf[2 * i + 1][0], vf[2 * i + 1][1], vf[2 * i + 1][2], vf[2 * i + 1][3]}; o[i >> 2] = NSA_MFMA(pa[i & 3], v8, o[i >> 2]); }
    if (HASN && !NORESC) rm = rowmax32_3(n0, n1);
    return rm;
}
#undef SGB
__device__ __forceinline__ void qk_first(f32x16& p0, f32x16& p1, const Ctx& c, int s, float cinit, int mode, int ql) {
    const lds_cptr kb = (lds_cptr)(c.lds + koff(s));
    const lds_cptr qb_ = (lds_cptr)(c.lds + L_QF + c.wid * 4096) + c.hi * 512 + c.r32 * 16;
    bf16x8 qr[4];
#pragma unroll
    for (int d0 = 0; d0 < 4; ++d0) qr[d0] = *(const LAS bf16x8*)(qb_ + d0 * 1024);
#pragma unroll
    for (int r = 0; r < 16; ++r) { p0[r] = cinit; p1[r] = cinit; }
#pragma unroll
    for (int d0 = 0; d0 < 4; ++d0) { const int ko = kfrag_off(c, d0); const bf16x8 b0 = *(const LAS bf16x8*)(kb + ko), b1 = *(const LAS bf16x8*)(kb + ko + 4096); p0 = NSA_MFMA(b0, qr[d0], p0); p1 = NSA_MFMA(b1, qr[d0], p1); }
    if (mode == M_CAUSAL) apply_mask<M_CAUSAL>(p0, p1, c.hi, ql, 0, true); else if (mode == M_WINLO) apply_mask<M_WINLO>(p0, p1, c.hi, ql, 0, true);
}
__device__ __forceinline__ void sm_stats(Sm& st, const Ctx& c, int s, const bf16x8 (&qr)[4], int lim) {
    f32x16 p0, p1; qkt(p0, p1, c, s, qr);
    apply_mask<M_CMP>(p0, p1, c.hi, 0, lim, true);
    const float rm = rowmax32(p0, p1), mn = fmaxf(st.m, rm), f = __builtin_amdgcn_exp2f(st.m - mn);
    st.m = mn;
    float sum = 0.f;
#pragma unroll
    for (int r = 0; r < 16; ++r) sum += __builtin_amdgcn_exp2f(p0[r] - mn) + __builtin_amdgcn_exp2f(p1[r] - mn);
    st.l = st.l * f + sum;
}
__device__ __forceinline__ void acc_scaled(const f32x16 (&o)[2], const Ctx& c, float fac_row) {
    LAS float* wsf = (LAS float*)(c.lds + L_WSF) + c.wid * 64;
    LAS float* oacc = (LAS float*)(c.lds + L_OACC) + c.wid * 2048;
    if (c.hi == 0) wsf[c.r32] = fac_row;
    const LAS float* wsh = wsf + 4 * c.hi; LAS float* oah = oacc + 4 * c.hi * 64 + c.r32;
#pragma unroll
    for (int r = 0; r < 16; ++r) { const int kc = (r & 3) + 8 * (r >> 2); const float fr_ = wsh[kc]; oah[kc * 64] += o[0][r] * fr_; oah[kc * 64 + 32] += o[1][r] * fr_; }
}

struct Tensors { const bf16_t *q, *kcmp, *vcmp, *ks, *vs, *kw, *vw; const float* g3; bf16_t* onsa; bf16_t* owin; bool bounded_slc, bounded_win; };
template <int DBG>
__device__ __forceinline__ void unit(const Tensors& T_, LAS unsigned char* lds, int b, int g, int qb, int flags) {
    int tid_ = threadIdx.x; asm volatile("" : "+v"(tid_));
    Ctx c; c.lds = lds; c.wid = __builtin_amdgcn_readfirstlane(tid_ >> 6); c.lane = tid_ & 63; c.r32 = c.lane & 31; c.hi = c.lane >> 5; c.th = c.wid & 1; c.hh = c.wid >> 1;
    const int tid = tid_, h = 4 * g + c.hh, t0 = qb * 64, ql = 32 * c.th + c.r32, tq = t0 + ql;
    const size_t tok = (size_t)b * SEQ + tq;
    const bf16_t* Qw = T_.q + (((size_t)b * NH + h) * SEQ + t0 + 32 * c.th) * 64;
    bf16x8 qr[4];
#pragma unroll
    for (int d0 = 0; d0 < 4; ++d0) qr[d0] = *(const bf16x8*)(Qw + (size_t)c.r32 * 64 + d0 * 16 + c.hi * 8);
    { LAS bf16x8* qf = (LAS bf16x8*)(lds + L_QF + c.wid * 4096 + c.hi * 512 + c.r32 * 16);
#pragma unroll
      for (int d0 = 0; d0 < 4; ++d0) qf[d0 * 64] = qr[d0]; }
    asm volatile("" :: "v"(qr[0]), "v"(qr[1]), "v"(qr[2]), "v"(qr[3]));
    const size_t bg = (size_t)b * NG + g;
    {
        if (flags & 1) { prefetch_tile(c, T_.kcmp + bg * 256 * 64); prefetch_tile(c, T_.vcmp + bg * 256 * 64);
            prefetch_tile(c, T_.ks + (bg * SEQ + (size_t)qb * 64) * 64); prefetch_tile(c, T_.vs + (bg * SEQ + (size_t)qb * 64) * 64); }
        if (flags & 2) { prefetch_tile(c, T_.kw + (bg * SEQ + (size_t)qb * 64) * 64); prefetch_tile(c, T_.vw + (bg * SEQ + (size_t)qb * 64) * 64);
            if (qb >= 8) { prefetch_tile(c, T_.kw + (bg * SEQ + (size_t)(qb - 8) * 64) * 64); prefetch_tile(c, T_.vw + (bg * SEQ + (size_t)(qb - 8) * 64) * 64); } }
        LAS float* gt = (LAS float*)(lds + L_GT) + c.wid * 192 + c.lane;
        gt[0] = T_.g3[tok * 24 + h]; gt[64] = T_.g3[tok * 24 + 8 + h]; gt[128] = T_.g3[tok * 24 + 16 + h];
    }
    { LAS f32x4* z = (LAS f32x4*)(lds + L_OACC) + c.wid * 512 + c.lane;
#pragma unroll
      for (int i = 0; i < 8; ++i) z[64 * i] = (f32x4){0.f, 0.f, 0.f, 0.f}; }

    if (flags & 1) {
        const bf16_t* KC = T_.kcmp + bg * 256 * 64; const bf16_t* VC = T_.vcmp + bg * 256 * 64;
        const int nct = ((t0 + 63 - 31) >> 4) / 64 + 1;
        const int cmax = (tq >= 31) ? ((tq - 31) >> 4) : -1;
        LAS unsigned* imp = (LAS unsigned*)(lds + L_IMP);
        for (int e = tid; e < 64 * 65; e += 512) imp[e] = 0u;
        Sm st{-1e30f, 0.f};
        dma_k(c, KC, 0);
        for (int n = 0; n < nct; ++n) {
            NSA_WAITBAR();
            if (n + 1 < nct) dma_k(c, KC + (size_t)(n + 1) * 4096, (n + 1) & 1);
            sm_stats(st, c, n & 1, qr, cmax - 64 * n);
        }
        const float lt = st.l + __shfl_xor(st.l, 32), inv = lt > 0.f ? 1.f / lt : 0.f;
        __syncthreads();
        f32x16 o[2]; o[0] = f32x16{}; o[1] = f32x16{};
        dma_kv(c, KC, VC, 0);
        for (int n = 0; n < nct; ++n) {
            NSA_WAITBAR();
            if (n + 1 < nct) dma_kv(c, KC + (size_t)(n + 1) * 4096, VC + (size_t)(n + 1) * 4096, (n + 1) & 1);
            f32x16 p0, p1; qkt(p0, p1, c, n & 1, qr);
            apply_mask<M_CMP>(p0, p1, c.hi, 0, cmax - 64 * n, true);
#pragma unroll
            for (int r = 0; r < 16; ++r) { p0[r] = __builtin_amdgcn_exp2f(p0[r] - st.m) * inv; p1[r] = __builtin_amdgcn_exp2f(p1[r] - st.m) * inv; }
#pragma unroll
            for (int rq = 0; rq < 4; ++rq) {
                const float s0 = (p0[4 * rq] + p0[4 * rq + 1]) + (p0[4 * rq + 2] + p0[4 * rq + 3]), s1 = (p1[4 * rq] + p1[4 * rq + 1]) + (p1[4 * rq + 2] + p1[4 * rq + 3]);
                const int j0 = 16 * n + 2 * rq + c.hi, j1 = j0 + 8;
                LAS unsigned* impr = imp + ql * 65 + 16 * n + c.hi;
                __hip_atomic_fetch_add(&impr[2 * rq], (unsigned)(s0 * 16777216.f + 0.5f), __ATOMIC_RELAXED, __HIP_MEMORY_SCOPE_WORKGROUP);
                __hip_atomic_fetch_add(&impr[2 * rq + 8], (unsigned)(s1 * 16777216.f + 0.5f), __ATOMIC_RELAXED, __HIP_MEMORY_SCOPE_WORKGROUP);
                if (j0 + 1 < 64) __hip_atomic_fetch_add(&impr[2 * rq + 1], (unsigned)(p0[4 * rq + 3] * 16777216.f + 0.5f), __ATOMIC_RELAXED, __HIP_MEMORY_SCOPE_WORKGROUP);
                if (j1 + 1 < 64) __hip_atomic_fetch_add(&impr[2 * rq + 9], (unsigned)(p1[4 * rq + 3] * 16777216.f + 0.5f), __ATOMIC_RELAXED, __HIP_MEMORY_SCOPE_WORKGROUP);
            }
            bf16x8 pa[4]; pack_p(pa, p0, p1);
            pv(o, c, n & 1, pa);
        }
        acc_scaled(o, c, ((LAS float*)(lds + L_GT))[c.wid * 192 + c.lane]);
        __syncthreads();
        {
            int t2_ = tid; asm volatile("" : "+v"(t2_));
            const int tk = t2_ >> 3, jb = (t2_ & 7) * 8;
            unsigned sown[8]; int rank[8];
#pragma unroll
            for (int k = 0; k < 8; ++k) { const int j = jb + k; sown[k] = imp[tk * 65 + j] + ((j == 0 || j == qb || j == qb - 1) ? 0x40000000u : 0u); rank[k] = 0; }
            for (int jp = 0; jp <= qb; ++jp) { const unsigned sp = imp[tk * 65 + jp] + ((jp == 0 || jp == qb || jp == qb - 1) ? 0x40000000u : 0u);
#pragma unroll
                for (int k = 0; k < 8; ++k) rank[k] += (sp > sown[k] || (sp == sown[k] && jp < jb + k)) ? 1 : 0; }
            unsigned bits = 0u;
#pragma unroll
            for (int k = 0; k < 8; ++k) if (jb + k <= qb && rank[k] < 16) bits |= 1u << k;
            ((LAS unsigned char*)(lds + L_SEL))[tk * 8 + (t2_ & 7)] = (unsigned char)bits;
        }
        __syncthreads();
        if (tid < 64) {
            const unsigned long long mine = ((LAS unsigned long long*)(lds + L_SEL))[tid];
            unsigned lo = (unsigned)mine, hi2 = (unsigned)(mine >> 32);
#pragma unroll
            for (int o_ = 1; o_ < 64; o_ <<= 1) { lo |= __shfl_xor(lo, o_); hi2 |= __shfl_xor(hi2, o_); }
            if (tid == 0) { ((LAS unsigned*)(lds + L_UNI))[0] = lo; ((LAS unsigned*)(lds + L_UNI))[1] = hi2; }
        }
        __syncthreads();
    }
    for (int sidx = (flags & 1) ? 0 : 1; sidx < ((flags & 2) ? 2 : 1); ++sidx) {
        unsigned long long tm;
        if (sidx == 0) { const unsigned ul = (unsigned)__builtin_amdgcn_readfirstlane((int)((LAS unsigned*)(lds + L_UNI))[0]), uh = (unsigned)__builtin_amdgcn_readfirstlane((int)((LAS unsigned*)(lds + L_UNI))[1]);
            tm = ((((unsigned long long)uh << 32) | ul) & ((2ull << qb) - 1ull)) | (1ull << qb); }
        else { const int jlo = qb - 7 < 0 ? 0 : qb - 7; tm = ((2ull << qb) - 1ull) & ~((1ull << jlo) - 1ull); }
        if (DBG & 32) tm = 1ull << qb;
        const int NT = __builtin_popcountll(tm);
        unsigned long long selm = ~0ull;
        if (sidx == 0) selm = ((LAS unsigned long long*)(lds + L_SEL))[ql];
        const bool bounded = sidx ? T_.bounded_win : T_.bounded_slc;
        const bf16_t* KB = (sidx ? T_.kw : T_.ks) + bg * SEQ * 64; const bf16_t* VB = (sidx ? T_.vw : T_.vs) + bg * SEQ * 64;
#define TM_TOP(m) (63 - __builtin_clzll(m))
#define TL_RS(j) ((bool)((selm >> (j)) & 1ull))
        Sm st{0.f, 0.f}; f32x16 o[2]; o[0] = f32x16{}; o[1] = f32x16{};
        f32x16 sA0, sA1, sB0, sB1;
        bool first = true;
        if (sidx == 1 && qb >= 8 && !(DBG & 64)) {
            dma_kv(c, KB + (size_t)(qb - 8) * 4096, VB + (size_t)(qb - 8) * 4096, 0);
            NSA_WAITBAR();
            qk_first(sA0, sA1, c, 0, 0.f, M_WINLO, ql);
            const float rm = rowmax32_3(sA0, sA1);
            if (!bounded && __builtin_expect(__any(rm > RESCALE_THR || (rm < -RESCALE_THR && rm > -INFINITY)), 0)) rescale_rows(st, o, sA0, sA1, c, rm, true);
            bf16x8 pa_[4]; exp_sum_pack(st, sA0, sA1, pa_);
            { s16x4 vf0[16]; bf16x8 kfd[8]; read_vf(vf0, c, 0); (void)block_c<false>(o, c, vf0, pa_, sA0, sA1, kfd, -1); }
            first = false;
            asm volatile("s_waitcnt lgkmcnt(0)\n\ts_barrier" ::: "memory");
        }
        unsigned long long tw = tm;
        int jc0 = TM_TOP(tw); tw &= ~(1ull << jc0);
        int jc1 = tw ? TM_TOP(tw) : -1; if (jc1 >= 0) tw &= ~(1ull << jc1);
        int jc2 = tw ? TM_TOP(tw) : -1; if (jc2 >= 0) tw &= ~(1ull << jc2);
        int jc3 = tw ? TM_TOP(tw) : -1; if (jc3 >= 0) tw &= ~(1ull << jc3);
        int jc4 = tw ? TM_TOP(tw) : -1; if (jc4 >= 0) tw &= ~(1ull << jc4);
        dma_k(c, KB + (size_t)jc0 * 4096, 0);
        if (jc1 >= 0) dma_k(c, KB + (size_t)jc1 * 4096, 1);
        dma_v(c, VB + (size_t)jc0 * 4096, 0);
        if (jc2 >= 0) dma_k(c, KB + (size_t)jc2 * 4096, 2);
        NSA_WAITBAR();
        qk_first(sA0, sA1, c, 0, TL_RS(jc0) ? -st.m : -INFINITY, M_CAUSAL, ql);
        float rmc = rowmax32_3(sA0, sA1);
        bf16x8 kf[8];
        if (jc1 >= 0) read_kf(kf, c, 1);
        asm volatile("s_waitcnt lgkmcnt(0)\n\ts_barrier" ::: "memory");
        if (jc3 >= 0) dma_k(c, KB + (size_t)jc3 * 4096, 0);
        if (jc1 >= 0) dma_v(c, VB + (size_t)jc1 * 4096, 1);
        bf16x8 qs[4];
        { const lds_cptr qb_ = (lds_cptr)(lds + L_QF + c.wid * 4096) + c.hi * 512 + c.r32 * 16;
#pragma unroll
          for (int d0 = 0; d0 < 4; ++d0) qs[d0] = *(const LAS bf16x8*)(qb_ + d0 * 1024); }
        int r0 = 0, r1 = 1, r2 = 2;
        s16x4 vf[16];
#define NSA_STEP(n, C0, C1, N0, N1, NR) do { \
            if (jc3 >= 0 && (n) > 0) NSA_WAITBAR2(); else NSA_WAITBAR(); \
            if (jc4 >= 0) dma_k(c, KB + (size_t)jc4 * 4096, r1); \
            if (jc2 >= 0) dma_v(c, VB + (size_t)jc2 * 4096, r2); \
            if (!(NR)) { if (__builtin_expect(__any(rmc > RESCALE_THR || (first && rmc < -RESCALE_THR && rmc > -INFINITY)), 0)) rescale_rows(st, o, C0, C1, c, rmc, first); } \
            first = false; \
            bf16x8 pa_[4]; \
            block_b<DBG>(N0, N1, c, kf, qs, vf, r0, TL_RS(jc1) ? -st.m : -INFINITY, st, C0, C1, pa_); \
            rmc = block_c<true, DBG, NR>(o, c, vf, pa_, N0, N1, kf, jc2 >= 0 ? r2 : -1); \
            { const int t_ = r0; r0 = r1; r1 = r2; r2 = t_; } \
            jc0 = jc1; jc1 = jc2; jc2 = jc3; jc3 = jc4; jc4 = tw ? TM_TOP(tw) : -1; if (jc4 >= 0) tw &= ~(1ull << jc4); \
        } while (0)
        int n = 0;
        bool inA = true;
        if (bounded) {
            rmc = 0.f;
            while (jc1 >= 0) {
                NSA_STEP(n, sA0, sA1, sB0, sB1, true); ++n; inA = false;
                if (jc1 >= 0) { NSA_STEP(n, sB0, sB1, sA0, sA1, true); ++n; inA = true; }
            }
        } else {
            while (jc1 >= 0) {
                NSA_STEP(n, sA0, sA1, sB0, sB1, false); ++n; inA = false;
                if (jc1 >= 0) { NSA_STEP(n, sB0, sB1, sA0, sA1, false); ++n; inA = true; }
            }
        }
        if (!inA) { sA0 = sB0; sA1 = sB1; }
        {
            NSA_WAITBAR();
            if (__builtin_expect(__any(rmc > RESCALE_THR || (first && rmc < -RESCALE_THR && rmc > -INFINITY)), 0)) rescale_rows(st, o, sA0, sA1, c, rmc, first);
            bf16x8 pa_[4]; exp_sum_pack(st, sA0, sA1, pa_);
            read_vf(vf, c, r0);
            (void)block_c<false>(o, c, vf, pa_, sA0, sA1, kf, -1);
            const float lt = st.l + __shfl_xor(st.l, 32);
            acc_scaled(o, c, lt > 0.f ? ((LAS float*)(lds + L_GT))[c.wid * 192 + (sidx ? 128 : 64) + c.lane] / lt : 0.f);
        }
#undef NSA_STEP
#undef TM_TOP
#undef TL_RS
        asm volatile("s_waitcnt lgkmcnt(0)\n\ts_barrier" ::: "memory");
    }
    {
        const LAS float* oacc = (const LAS float*)(lds + L_OACC) + c.wid * 2048;
        const bool to_owin = !(flags & 1);
        bf16_t* dstb = (to_owin ? T_.owin : T_.onsa) + ((size_t)b * SEQ + t0 + 32 * c.th) * 512 + h * 64;
        asm volatile("s_waitcnt lgkmcnt(0)" ::: "memory");
#pragma unroll
        for (int i = 0; i < 4; ++i) { const int row = i * 8 + (c.lane >> 3), ch = c.lane & 7;
            f32x4 a = *(const LAS f32x4*)(oacc + row * 64 + ch * 8), b2 = *(const LAS f32x4*)(oacc + row * 64 + ch * 8 + 4);
            if (!(flags & 2)) { f32x4 wa, wb; epi::unpack8(*(const u32x4*)(T_.owin + ((size_t)b * SEQ + t0 + 32 * c.th + row) * 512 + h * 64 + ch * 8), wa, wb); a += wa; b2 += wb; }
            *(u32x4*)(dstb + (size_t)row * 512 + ch * 8) = epi::pack8(a, b2); }
    }
    __syncthreads();
}
#undef NSA_MFMA
#undef NSA_WAITBAR
}

enum { MAP_ID = 0, MAP_GU = 1, MAP_WIN = 2, MAP_GLU = 3 };
__device__ __forceinline__ int map_col(int mapid, int n) {
    if (mapid == MAP_ID) return n;
    if (mapid == MAP_GU) return ((n >> 8) << 7) + (n & 127);
    if (mapid == MAP_GLU) return (((n >> 7) & 1) << 10) + ((n >> 8) << 7) + (n & 127);
    const int pn = n >> 8, r = n & 255;
    if (pn < 5) { const int bj = r >> 7, wc = (r >> 5) & 3, i = r & 31; return 64 * (4 * pn + wc) + 32 * bj + i; }
    if (pn < 7) return 1304 + 256 * (pn - 5) + r;
    if (pn < 11) return 1816 + 256 * (pn - 7) + r;
    if (pn < 15) return 2840 + 256 * (pn - 11) + r;
    return r < 24 ? 1280 + r : -1;
}
struct TDesc { const float* W; const float* W2; int K, ldw, Nt, mapid; size_t off; const float* gain; };
__device__ __forceinline__ TDesc tdesc(const Args& a, int id) {
    switch (id) {
    case 0: return TDesc{a.in[2], a.in[3], DM, FF, 2 * FF, MAP_GU, WS_W1GU, a.in[1]};
    case 1: return TDesc{a.in[29], a.in[30], DM, FF, 2 * FF, MAP_GU, WS_W2GU, a.in[28]};
    case 2: return TDesc{a.in[4], nullptr, FF, DM, DM, MAP_ID, WS_W1D, nullptr};
    case 3: return TDesc{a.in[31], nullptr, FF, DM, DM, MAP_ID, WS_W2D, nullptr};
    case 4: return TDesc{a.in[6], nullptr, DM, INW, 4096, MAP_WIN, WS_WIN, a.in[5]};
    case 5: return TDesc{a.in[17], nullptr, 512, DM, DM, MAP_ID, WS_WNSA, nullptr};
    case 6: return TDesc{a.in[26], nullptr, 512, 2048, 2048, MAP_GLU, WS_WGLU, nullptr};
    case 7: return TDesc{a.in[27], nullptr, DM, DM, DM, MAP_ID, WS_WOUT, nullptr};
    case 8: return TDesc{a.in[13], nullptr, 2048, 256, 256, MAP_ID, WS_WC1K, nullptr};
    default: return TDesc{a.in[15], nullptr, 2048, 256, 256, MAP_ID, WS_WC1V, nullptr};
    }
}
constexpr int N_TMAT = 10;
__device__ __forceinline__ bool tmat_early(int id) { return id == 0 || id == 2 || id == 4 || id == 8 || id == 9; }
__device__ __forceinline__ int tmat_items(const TDesc& d) { return (d.K / 64) * (d.Nt / 32); }
__device__ __forceinline__ void tmat_item(const Args& a, const TDesc& d, int r, LAS float* scr, int lane) {
    const int nblk = d.Nt / 32, kb = r / nblk, nb = r % nblk, n0 = 32 * nb;
    const float* W = (d.mapid == MAP_GU && ((n0 >> 7) & 1)) ? d.W2 : d.W;
    const int mapid = d.mapid;
    transpose_item(W, d.ldw, (bf16_t*)(a.ws + d.off), d.K, 64 * kb, n0, [mapid](int n) { return map_col(mapid, n); }, scr, lane, d.gain);
}
constexpr int LATE_ITEMS = (DM / 64) * (2 * FF / 32) + (FF / 64) * (DM / 32) + (512 / 64) * (DM / 32) + (512 / 64) * (2048 / 32) + (DM / 64) * (DM / 32);
__device__ __forceinline__ void late_item(const Args& a, int v, LAS float* scr, int lane) {
    const int ids[5] = {1, 3, 5, 6, 7};
    int base = 0;
#pragma unroll
    for (int q = 0; q < 5; ++q) { const TDesc d = tdesc(a, ids[q]); const int n = tmat_items(d); if (v < base + n) { tmat_item(a, d, v - base, scr, lane); return; } base += n; }
}
__device__ __forceinline__ void p0_prologue(Frame& F, const Args& a) {
    LAS float* scr = (LAS float*)(F.lds + RING_OFF + F.wave * 16384);
    const int gw = F.vcu * NWAVES + F.wave, NGW = F.G * NWAVES;
    unsigned char* ws = a.ws;
    { bf16_t* xn = (bf16_t*)(ws + WS_XN); float* ssq = (float*)(ws + WS_SSQ);
      const int per_x = F.G / 8, xcd = F.vcu / per_x, wl = (F.vcu % per_x) * NWAVES + F.wave, nwl = per_x * NWAVES, rows_x = T / 8;
      for (int r = wl; r < rows_x / 2; r += nwl) { const int m = xcd * rows_x + r, m1 = m + rows_x / 2;
          prep_row2(a.in[0] + (size_t)m * DM, a.in[0] + (size_t)m1 * DM, a.in[1], xn + (size_t)m * DM, xn + (size_t)m1 * DM, ssq + (size_t)m * 16, ssq + (size_t)m1 * 16, F.lane); } }
    int base = 0;
    for (int id = 0; id < N_TMAT; ++id) {
        if (!tmat_early(id)) continue;
        const TDesc d = tdesc(a, id);
        const int nitems = tmat_items(d);
        int first = gw - (base % NGW); if (first < 0) first += NGW;
        for (int r = first; r < nitems; r += NGW) tmat_item(a, d, r, scr, F.lane);
        base += nitems;
    }
    for (int wt = gw; wt < SSM_G * 64; wt += NGW) ssm_weights_task(a, wt >> 6, wt & 63, F.lane, scr);
    for (int wt = gw; wt < 64; wt += NGW) { const int kv = wt >> 5, kc = (wt >> 2) & 7, n = (wt & 3) * 64 + F.lane;
        const float* pos = a.in[kv ? 12 : 11]; const float* w1 = a.in[kv ? 15 : 13]; float acc = 0.f;
        for (int k = kc * 256; k < kc * 256 + 256; ++k) acc += pos[k] * w1[(size_t)k * 256 + n];
        ((float*)(ws + WS_MISC))[(kv * 8 + kc) * 256 + n] = acc; }
}

typedef short bf16x8_t __attribute__((ext_vector_type(8)));
typedef float f32x16_t __attribute__((ext_vector_type(16)));
__device__ __forceinline__ void cmp_l2_wave(const bf16_t* hidrows, const float* w2, const float* knorm, bf16_t* outrows, int mrow0, int lane) {
    const int r32 = lane & 31, hi = lane >> 5;
    f32x16_t acc0 = {}, acc1 = {};
    for (int k4 = 0; k4 < 16; k4 += 4) {
        bf16x8_t af[4]; float wv[4][16];
#pragma unroll
        for (int q = 0; q < 4; ++q) { const int ks = k4 + q; af[q] = *(const bf16x8_t*)(hidrows + (size_t)r32 * 256 + 16 * ks + 8 * hi);
#pragma unroll
            for (int j = 0; j < 4; ++j) { const float* wp = w2 + (size_t)(16 * ks + 8 * hi + 2 * j) * 64 + r32; wv[q][4 * j] = wp[0]; wv[q][4 * j + 1] = wp[64]; wv[q][4 * j + 2] = wp[32]; wv[q][4 * j + 3] = wp[64 + 32]; } }
#pragma unroll
        for (int q = 0; q < 4; ++q) {
            const bf16x8_t bf0 = __builtin_bit_cast(bf16x8_t, (v4u){pk2(wv[q][0], wv[q][1]), pk2(wv[q][4], wv[q][5]), pk2(wv[q][8], wv[q][9]), pk2(wv[q][12], wv[q][13])});
            const bf16x8_t bf1 = __builtin_bit_cast(bf16x8_t, (v4u){pk2(wv[q][2], wv[q][3]), pk2(wv[q][6], wv[q][7]), pk2(wv[q][10], wv[q][11]), pk2(wv[q][14], wv[q][15])});
            acc0 = __builtin_amdgcn_mfma_f32_32x32x16_bf16(af[q], bf0, acc0, 0, 0, 0);
            acc1 = __builtin_amdgcn_mfma_f32_32x32x16_bf16(af[q], bf1, acc1, 0, 0, 0);
        }
    }
    const float g0 = knorm ? knorm[r32] : 1.f, g1 = knorm ? knorm[32 + r32] : 1.f;
#pragma unroll
    for (int r = 0; r < 16; ++r) {
        const int row = (r & 3) + 8 * (r >> 2) + 4 * hi;
        float v0 = acc0[r], v1 = acc1[r];
        if (knorm) { float ss = v0 * v0 + v1 * v1;
            ss += __shfl_xor(ss, 1); ss += __shfl_xor(ss, 2); ss += __shfl_xor(ss, 4); ss += __shfl_xor(ss, 8); ss += __shfl_xor(ss, 16);
            const float rn = rsqrtf(ss * (1.f / 64.f) + RMS_EPS); v0 *= rn * g0; v1 *= rn * g1; }
        if (((mrow0 + row) & 255) == 255) { v0 = 0.f; v1 = 0.f; }
        outrows[(size_t)row * 64 + r32] = f2bf(v0); outrows[(size_t)row * 64 + 32 + r32] = f2bf(v1);
    }
}

__global__ void __launch_bounds__(NWAVES * 64, 2) mega(Args args) {
    extern __shared__ __attribute__((aligned(16))) unsigned char lds[];
    Frame F;
    F.lds = (LAS unsigned char*)lds;
    F.MISC = (volatile LAS unsigned*)(F.lds + MISC_OFF);
    F.tid = threadIdx.x; F.lane = F.tid & 63; F.wave = __builtin_amdgcn_readfirstlane(F.tid >> 6);
    F.G = gridDim.x; { const int bx = blockIdx.x; F.vcu = (F.G % 8 == 0) ? (bx % 8) * (F.G / 8) + bx / 8 : bx; }
    unsigned char* ws = args.ws;
    F.ctl = (gu32*)(ws + WS_CTL);
    for (int u = F.tid; u < (LDS_BYTES - LDSCTL_OFF) / 4; u += NWAVES * 64) ((LAS unsigned*)(F.lds + LDSCTL_OFF))[u] = 0u;
    __syncthreads();
    XcdBarrier bar; bar.bar = (unsigned*)(F.ctl + CW_BAR); bar.x = 0; bar.st = nullptr;
    if (args.fused) bar = xcd_barrier_post((unsigned*)(F.ctl + CW_BAR), F.MISC + 8);
    const int lo = args.ph_lo, hi = args.ph_hi;
#define SELF_HANDOFF() do { asm volatile("s_waitcnt vmcnt(0)" ::: "memory"); __syncthreads(); } while (0)
#define IN(k) (lo <= (k) && (k) < hi)
#define SEAM(k) do { if (IN(k) && IN((k) + 1)) xcd_barrier(bar); } while (0)
    float* out = args.out;
    bf16_t* xn = (bf16_t*)(ws + WS_XN); float* ssq = (float*)(ws + WS_SSQ); bf16_t* act = (bf16_t*)(ws + WS_ACT);

    if (IN(PH_PRO)) { p0_prologue(F, args); } SEAM(PH_PRO);

    if (IN(PH_F1GU)) {
        pg8::Gemm g{xn, (const bf16_t*)(ws + WS_W1GU), DM, DM, DM, 0, 0}; pg8::StaticOrder S; S.init(T, 2 * FF, F.G, (int)blockIdx.x);
        epi::EpiSwiGLU E{act, ssq};
        pg8::gemm_phase<epi::EpiSwiGLU, pg8::StaticOrder, PG8_ALIGN, PG8_SP2>(F.lds + RING_OFF, g, S, E);
    } SEAM(PH_F1GU);

    if (IN(PH_F1D)) {
        pg8::Gemm g{act, (const bf16_t*)(ws + WS_W1D), FF, FF, FF, 0, 0}; pg8::StaticOrder S; S.init(T, DM, F.G, (int)blockIdx.x);
        epi::EpiResid<true, false> E{nullptr, xn, nullptr, 0.5f, xn, ssq};
        pg8::gemm_phase<epi::EpiResid<true, false>, pg8::StaticOrder, PG8_ALIGN, PG8_SP2>(F.lds + RING_OFF, g, S, E);
    } SEAM(PH_F1D);

    if (IN(PH_WIN)) {
        pg8::Gemm g{xn, (const bf16_t*)(ws + WS_WIN), DM, DM, DM, 0, 0}; pg8::StaticOrder S; S.init(T, 4096, F.G, (int)blockIdx.x);
        epi::EpiWin E; E.ssq = ssq; E.q = (bf16_t*)(ws + WS_Q); E.ks = (bf16_t*)(ws + WS_KS); E.vs = (bf16_t*)(ws + WS_VS); E.kw = (bf16_t*)(ws + WS_KW); E.vw = (bf16_t*)(ws + WS_VW);
        E.kcr = (bf16_t*)(ws + WS_KCR); E.vcr = (bf16_t*)(ws + WS_VCR); E.acat = (bf16_t*)(ws + WS_ACAT); E.sgn = (bf16_t*)(ws + WS_SGN); E.sgs = (bf16_t*)(ws + WS_SGS); E.g3 = (float*)(ws + WS_G3);
        E.q_norm = args.in[7]; E.k_norm_slc = args.in[9]; E.k_norm_win = args.in[10];
        pg8::gemm_phase<epi::EpiWin, pg8::StaticOrder, PG8_ALIGN, PG8_SP2>(F.lds + RING_OFF, g, S, E);
    } SEAM(PH_WIN);

    if (IN(PH_MIDA)) {
        const int vcu = F.vcu;
        {
            const int cu = (vcu & 7) == 0 ? (vcu >> 3) : -1;
            pg8::Gemm g{(const bf16_t*)(ws + WS_KCR), (const bf16_t*)(ws + WS_WC1K), 1024, 2048, 2048, WS_VCR - WS_KCR, WS_WC1V - WS_WC1K};
            pg8::GroupOrder S; S.init(16, 1, 2, F.G, cu);
            epi::EpiCmp1 E{(bf16_t*)(ws + WS_HID), (const float*)(ws + WS_MISC)};
            pg8::gemm_phase<epi::EpiCmp1, pg8::GroupOrder, false, PG8_SP2>(F.lds + RING_OFF, g, S, E);
            if (cu >= 0) {
                SELF_HANDOFF();
                const int pg = cu >> 4, pm = cu & 15, r0 = pm * 256 + F.wave * 32;
                cmp_l2_wave((const bf16_t*)(ws + WS_HID) + ((size_t)pg * 4096 + r0) * 256, args.in[pg ? 16 : 14], pg ? nullptr : args.in[8],
                            (bf16_t*)(ws + (pg ? WS_VCMP : WS_KCMP)) + (size_t)r0 * 64, r0, F.lane);
            }
        }
        {
            const int cu = (vcu & 3) == 1 ? (vcu >> 2) : -1;
            pg8::Gemm g{(const bf16_t*)(ws + WS_ACAT), (const bf16_t*)(ws + WS_W1S), ACAT_LD, 1024, 1024, (size_t)512 * ACAT_LD * 2, (size_t)128 * 1024 * 2};
            pg8::GroupOrder S; S.init(2, 1, SSM_G, F.G, cu);
            epi::EpiSst E{(float*)(ws + WS_SST)};
            pg8::gemm_phase<epi::EpiSst, pg8::GroupOrder, false, PG8_SP2>(F.lds + RING_OFF, g, S, E);
            if (cu >= 0) {
                SELF_HANDOFF();
                ssm_carry_scan(args, cu >> 1, cu & 1, F.tid);
            }
        }
        {
            unsigned* ctr = (unsigned*)(F.ctl + CW_TOEP);
            LAS float* scr = (LAS float*)(F.lds + RING_OFF + F.wave * 16384);
            for (;;) { int v = 0; if (F.lane == 0) v = (int)__hip_atomic_fetch_add(ctr, 1u, RLX_AGENT); v = __builtin_amdgcn_readfirstlane(v);
                if (v >= LATE_ITEMS + SSM_G * 128) break;
                if (v < LATE_ITEMS) late_item(args, v, scr, F.lane);
                else { const int r0 = (v - LATE_ITEMS) * 8; for (int r = 0; r < 8; ++r) toep_row(ws, r0 + r, F.lane); } }
        }
    } SEAM(PH_MIDA);

    if (IN(PH_MIDB)) {
        if (args.pad & 4) {
            pg8::GroupOrder S; S.init(2, 4, SSM_G, F.G, F.vcu);
            pg8::Unit u0;
            (void)u0;
            pg8::Gemm g{(const bf16_t*)(ws + WS_ACAT), (const bf16_t*)(ws + WS_WTOEP), ACAT_LD, ACAT_LD, ACAT_LD, (size_t)512 * ACAT_LD * 2, (size_t)1024 * ACAT_LD * 2};
            epi::EpiSsmOut E{(const bf16_t*)(ws + WS_ACAT), args.in[25], ((bf16_t*)out + (size_t)T * 512)};
            pg8::gemm_phase<epi::EpiSsmOut, pg8::GroupOrder, false, PG8_SP2>(F.lds + RING_OFF, g, S, E);
        }
        if (args.pad & 3) {
            nsa::Tensors AT{(const bf16_t*)(ws + WS_Q), (const bf16_t*)(ws + WS_KCMP), (const bf16_t*)(ws + WS_VCMP), (const bf16_t*)(ws + WS_KS), (const bf16_t*)(ws + WS_VS),
                            (const bf16_t*)(ws + WS_KW), (const bf16_t*)(ws + WS_VW), (const float*)(ws + WS_G3), ((bf16_t*)out), (bf16_t*)(ws + WS_OWIN), false, false};
            {
                const float gq = wave_max(fabsf(args.in[7][F.lane])), gks = wave_max(fabsf(args.in[9][F.lane])), gkw = wave_max(fabsf(args.in[10][F.lane]));
                AT.bounded_slc = C2 * 64.f * gq * gks < 24.f; AT.bounded_win = C2 * 64.f * gq * gkw < 24.f;
            }
            const int bgi = F.vcu >> 4, sidx = F.vcu & 15;
            for (int i = 0; i < 4; ++i) { const int qb = (i == 0) ? sidx : (i == 1) ? 31 - sidx : (i == 2) ? 32 + sidx : 63 - sidx;

#if defined(PROBE_ATT)
                if (args.pad & 16) nsa::unit<PROBE_ATT>(AT, F.lds + RING_OFF, bgi >> 1, bgi & 1, qb, args.pad & 3); else
#endif
                nsa::unit<0>(AT, F.lds + RING_OFF, bgi >> 1, bgi & 1, qb, args.pad & 3); }
        }
    } SEAM(PH_MIDB);

    if (IN(PH_NSA)) {
        pg8::StaticOrder S; S.init(T, DM, F.G, (int)blockIdx.x);
        { pg8::Gemm g{((const bf16_t*)out), (const bf16_t*)(ws + WS_WNSA), 512, 512, 512, 0, 0};
          epi::EpiNsa E{(const bf16_t*)(ws + WS_SGN), (bf16_t*)(ws + WS_M1)};
          pg8::gemm_phase<epi::EpiNsa, pg8::StaticOrder, PG8_ALIGN, PG8_SP2>(F.lds + RING_OFF, g, S, E); }
        SELF_HANDOFF();
        { pg8::Gemm g{((const bf16_t*)out + (size_t)T * 512), (const bf16_t*)(ws + WS_WGLU), 512, 512, 512, 0, 0}; pg8::SplitOrder L{S};
          epi::EpiGlu E{(const bf16_t*)(ws + WS_SGS), (const bf16_t*)(ws + WS_M1), (bf16_t*)(ws + WS_MERGED)};
          pg8::gemm_phase<epi::EpiGlu, pg8::SplitOrder, PG8_ALIGN, PG8_SP2>(F.lds + RING_OFF, g, L, E); }
    } SEAM(PH_NSA);

    if (IN(PH_WOUT)) {
        pg8::Gemm g{(const bf16_t*)(ws + WS_MERGED), (const bf16_t*)(ws + WS_WOUT), DM, DM, DM, 0, 0}; pg8::StaticOrder S; S.init(T, DM, F.G, (int)blockIdx.x);
        epi::EpiResid<true, false> E{nullptr, xn, nullptr, 1.0f, xn, ssq};
        pg8::gemm_phase<epi::EpiResid<true, false>, pg8::StaticOrder, PG8_ALIGN, PG8_SP2>(F.lds + RING_OFF, g, S, E);
    } SEAM(PH_WOUT);

    if (IN(PH_F2GU)) {
        pg8::Gemm g{xn, (const bf16_t*)(ws + WS_W2GU), DM, DM, DM, 0, 0}; pg8::StaticOrder S; S.init(T, 2 * FF, F.G, (int)blockIdx.x);
        epi::EpiSwiGLU E{act, ssq};
        pg8::gemm_phase<epi::EpiSwiGLU, pg8::StaticOrder, PG8_ALIGN, PG8_SP2>(F.lds + RING_OFF, g, S, E);
    } SEAM(PH_F2GU);

    if (IN(PH_F2D)) {
        pg8::Gemm g{act, (const bf16_t*)(ws + WS_W2D), FF, FF, FF, 0, 0}; pg8::StaticOrder S; S.init(T, DM, F.G, (int)blockIdx.x);
        epi::EpiResid<true, true> E{nullptr, xn, out, 0.5f, nullptr, nullptr};
        pg8::gemm_phase<epi::EpiResid<true, true>, pg8::StaticOrder, PG8_ALIGN, PG8_SP2>(F.lds + RING_OFF, g, S, E);
    }
#undef IN
#undef SEAM
}

template <int NB, class AL, class BL, class EPI>
__device__ __forceinline__ void tgemm(int m0, int n0, int K, const AL& al, const BL& bl, const EPI& epi) {
    __shared__ float As[16][64 + 4];
    __shared__ float Bs[NB][16][64 + 4];
    __shared__ float Cs[NB][64][65];
    const int tid = threadIdx.x, ty = tid >> 4, tx = tid & 15;
    float acc[NB][4][4];
#pragma unroll
    for (int b = 0; b < NB; ++b)
#pragma unroll
        for (int i = 0; i < 4; ++i)
#pragma unroll
            for (int j = 0; j < 4; ++j) acc[b][i][j] = 0.f;
    for (int k0 = 0; k0 < K; k0 += 16) {
        {
            const int m = tid >> 2, kk = (tid & 3) * 4;
#pragma unroll
            for (int i = 0; i < 4; ++i) As[kk + i][m] = al(m0 + m, k0 + kk + i);
        }
        {
            const int kk = tid >> 4, nn = (tid & 15) * 4;
#pragma unroll
            for (int b = 0; b < NB; ++b)
#pragma unroll
                for (int j = 0; j < 4; ++j) Bs[b][kk][nn + j] = bl(b, k0 + kk, n0 + nn + j);
        }
        __syncthreads();
#pragma unroll
        for (int kk = 0; kk < 16; ++kk) {
            float a[4];
#pragma unroll
            for (int i = 0; i < 4; ++i) a[i] = As[kk][ty * 4 + i];
#pragma unroll
            for (int b = 0; b < NB; ++b) {
                float bv[4];
#pragma unroll
                for (int j = 0; j < 4; ++j) bv[j] = Bs[b][kk][tx * 4 + j];
#pragma unroll
                for (int i = 0; i < 4; ++i)
#pragma unroll
                    for (int j = 0; j < 4; ++j) acc[b][i][j] += a[i] * bv[j];
            }
        }
        __syncthreads();
    }
#pragma unroll
    for (int b = 0; b < NB; ++b)
#pragma unroll
        for (int i = 0; i < 4; ++i)
#pragma unroll
            for (int j = 0; j < 4; ++j) Cs[b][ty * 4 + i][tx * 4 + j] = acc[b][i][j];
    __syncthreads();
    epi(Cs, m0, n0);
}

__device__ __forceinline__ float row_rstd(const float* ssq, int t) {
    float s = 0.f;
#pragma unroll
    for (int i = 0; i < 16; ++i) s += ssq[(size_t)t * 16 + i];
    return rsqrtf(s * (1.f / DM) + RMS_EPS);
}

__global__ void __launch_bounds__(256) k_prep_rows(const float* x, const float* g, bf16_t* xn, float* ssq) {
    const int row = blockIdx.x * 4 + (threadIdx.x >> 6), lane = threadIdx.x & 63;
    const float* xr = x + (size_t)row * DM;
    float s = 0.f;
    for (int c = lane; c < DM; c += 64) { const float v = xr[c]; s += v * v; xn[(size_t)row * DM + c] = f2bf(v * g[c]); }
    s = wave_sum(s);
    if (lane < 16) ssq[(size_t)row * 16 + lane] = (lane == 0) ? s : 0.f;
}
__global__ void __launch_bounds__(256) k_row_ssq(const float* x, float* ssq) {
    const int row = blockIdx.x * 4 + (threadIdx.x >> 6), lane = threadIdx.x & 63;
    const float* xr = x + (size_t)row * DM;
    float s = 0.f;
    for (int c = lane; c < DM; c += 64) { const float v = xr[c]; s += v * v; }
    s = wave_sum(s);
    if (lane < 16) ssq[(size_t)row * 16 + lane] = (lane == 0) ? s : 0.f;
}

__global__ void __launch_bounds__(256) k_ffn_gu(const bf16_t* xn, const float* ssq, const float* wg, const float* wu, bf16_t* act) {
    const int m0 = blockIdx.y * 64, n0 = blockIdx.x * 64;
    auto al = [&](int m, int k) { return bf2f(xn[(size_t)m * DM + k]); };
    auto bl = [&](int b, int k, int n) { return (b == 0 ? wg : wu)[(size_t)k * FF + n]; };
    auto epi = [&](float (*Cs)[64][65], int m0_, int n0_) {
        const int tid = threadIdx.x;
        for (int e = tid; e < 64 * 64; e += 256) {
            const int r = e >> 6, c = e & 63, t = m0_ + r;
            const float rs = row_rstd(ssq, t);
            const float gv = Cs[0][r][c] * rs, uv = Cs[1][r][c] * rs;
            act[(size_t)t * FF + n0_ + c] = f2bf(gv * sigmoidf_(gv) * uv);
        }
    };
    tgemm<2>(m0, n0, DM, al, bl, epi);
}
__global__ void __launch_bounds__(256) k_ffn_down(const bf16_t* act, const float* wd, const float* xin, float* out, const float* gnext, bf16_t* xn) {
    const int m0 = blockIdx.y * 64, n0 = blockIdx.x * 64;
    auto al = [&](int m, int k) { return bf2f(act[(size_t)m * FF + k]); };
    auto bl = [&](int b, int k, int n) { return wd[(size_t)k * DM + n]; };
    auto epi = [&](float (*Cs)[64][65], int m0_, int n0_) {
        for (int e = threadIdx.x; e < 64 * 64; e += 256) {
            const int r = e >> 6, c = e & 63, t = m0_ + r, n = n0_ + c;
            const float o = xin[(size_t)t * DM + n] + 0.5f * Cs[0][r][c];
            out[(size_t)t * DM + n] = o;
            if (xn) xn[(size_t)t * DM + n] = f2bf(o * gnext[n]);
        }
    };
    tgemm<1>(m0, n0, FF, al, bl, epi);
}

__device__ __forceinline__ int win_origcol(int v) {
    if (v < 1280) return v;
    if (v < 1792) return 1304 + (v - 1280);
    if (v < 2816) return 1816 + (v - 1792);
    if (v < 3840) return 2840 + (v - 2816);
    if (v < 3864) return 1280 + (v - 3840);
    return -1;
}
struct WinOut {
    bf16_t *q, *ks, *vs, *kw, *vw, *kcr, *vcr, *acat, *sgn, *sgs; float* g3;
    const float *q_norm, *k_norm_slc, *k_norm_win;
};
__global__ void __launch_bounds__(256) k_win_proj(const bf16_t* xn, const float* ssq, const float* win, WinOut o, int skip_lo, int skip_hi) {
    const int m0 = blockIdx.y * 64, nt = blockIdx.x, n0 = nt * 64;
    if (nt > 60) return;
    if (nt >= skip_lo && nt < skip_hi) return;
    auto al = [&](int m, int k) { return bf2f(xn[(size_t)m * DM + k]); };
    auto bl = [&](int b, int k, int n) { const int oc = win_origcol(n); return oc >= 0 ? win[(size_t)k * INW + oc] : 0.f; };
    auto epi = [&](float (*Cs)[64][65], int m0_, int n0_) {
        const int tid = threadIdx.x;
        if (tid >= 64) return;
        const int r = tid, t = m0_ + r, b = t / SEQ, s = t % SEQ;
        const float rs = row_rstd(ssq, t);
        float v[64];
#pragma unroll
        for (int c = 0; c < 64; ++c) v[c] = Cs[0][r][c] * rs;
        if (nt < 8 || nt == 12 || nt == 13 || nt == 16 || nt == 17) {
            float ss = 0.f;
#pragma unroll
            for (int c = 0; c < 64; ++c) ss += v[c] * v[c];
            const float rn = rsqrtf(ss * (1.f / 64.f) + RMS_EPS);
            if (nt < 8) { bf16_t* dst = o.q + (((size_t)b * NH + nt) * SEQ + s) * 64;
#pragma unroll
                for (int c = 0; c < 64; ++c) dst[c] = f2bf(v[c] * rn * o.q_norm[c] * C2); }
            else { const bool isS = nt < 16; const int g = isS ? nt - 12 : nt - 16; bf16_t* dst = (isS ? o.ks : o.kw) + (((size_t)b * NG + g) * SEQ + s) * 64; const float* gn = isS ? o.k_norm_slc : o.k_norm_win;
#pragma unroll
                for (int c = 0; c < 64; ++c) dst[c] = f2bf(v[c] * rn * gn[c]); }
        } else if (nt < 20) {
            bf16_t* base; int g;
            if (nt < 10) { base = o.kcr; g = nt - 8; } else if (nt < 12) { base = o.vcr; g = nt - 10; } else if (nt < 16) { base = o.vs; g = nt - 14; } else { base = o.vw; g = nt - 18; }
            bf16_t* dst = base + (((size_t)b * NG + g) * SEQ + s) * 64;
#pragma unroll
            for (int c = 0; c < 64; ++c) dst[c] = f2bf(v[c]);
        } else if (nt < 28) {
#pragma unroll
            for (int c = 0; c < 64; ++c) { const int ch = 64 * (nt - 20) + c, g = ch >> 4, ci = ch & 15;
                o.acat[((size_t)g * 512 + b * 64 + (s >> 6)) * ACAT_LD + (s & 63) * 16 + ci] = f2bf(v[c]); }
        } else if (nt < 60) {
            const bool isN = nt < 44; bf16_t* dst = (isN ? o.sgn : o.sgs) + (size_t)t * DM + (isN ? nt - 28 : nt - 44) * 64;
#pragma unroll
            for (int c = 0; c < 64; ++c) dst[c] = f2bf(sigmoidf_(v[c]));
        } else {
#pragma unroll
            for (int c = 0; c < 24; ++c) o.g3[(size_t)t * 24 + c] = sigmoidf_(v[c]);
        }
    };
    tgemm<1>(m0, n0, DM, al, bl, epi);
}

__global__ void __launch_bounds__(256) k_cmp_l1(const bf16_t* kcr, const bf16_t* vcr, const float* posk, const float* posv, const float* w1k, const float* w1v, bf16_t* hid) {
    const int kv = blockIdx.z, m0 = blockIdx.y * 64, n0 = blockIdx.x * 64;
    const bf16_t* src = kv ? vcr : kcr; const float* pos = kv ? posv : posk; const float* w1 = kv ? w1v : w1k;
    auto al = [&](int m, int k) { const int bg = m >> 8, c = m & 255, s = k >> 6, d = k & 63, tok = 16 * c + s;
        if (tok >= SEQ) return 0.f; return bf2f(src[((size_t)bg * SEQ + tok) * 64 + d]) + pos[k]; };
    auto bl = [&](int b, int k, int n) { return w1[(size_t)k * 256 + n]; };
    auto epi = [&](float (*Cs)[64][65], int m0_, int n0_) {
        for (int e = threadIdx.x; e < 64 * 64; e += 256) { const int r = e >> 6, c = e & 63;
            hid[((size_t)kv * 4096 + m0_ + r) * 256 + n0_ + c] = f2bf(gelu_tanh(Cs[0][r][c])); }
    };
    tgemm<1>(m0, n0, 2048, al, bl, epi);
}
__global__ void __launch_bounds__(256) k_cmp_l2(const bf16_t* hid, const float* w2k, const float* w2v, const float* knorm, bf16_t* kcmp, bf16_t* vcmp) {
    const int gw = blockIdx.x * 4 + (threadIdx.x >> 6), lane = threadIdx.x & 63;
    const int kv = gw >> 12, m = gw & 4095;
    const float* w2 = kv ? w2v : w2k; const bf16_t* h = hid + ((size_t)kv * 4096 + m) * 256;
    float acc = 0.f;
    for (int k = 0; k < 256; ++k) acc += bf2f(h[k]) * w2[k * 64 + lane];
    if (!kv) { const float ss = wave_sum(acc * acc); acc = acc * rsqrtf(ss * (1.f / 64.f) + RMS_EPS) * knorm[lane]; }
    if ((m & 255) == 255) acc = 0.f;
    (kv ? vcmp : kcmp)[(size_t)m * 64 + lane] = f2bf(acc);
}

constexpr int SSMP_AB = 0, SSMP_BB = SSM_G * SSM_P * 2;
__global__ void k_ssm_params(const float* lre, const float* lim, const float* lstep, const float* bre, const float* bim, float* sp) {
    const int g = blockIdx.x, p = threadIdx.x;
    const double lr = lre[g * 64 + p], li = lim[g * 64 + p], step = exp((double)lstep[g]);
    const double mag = exp(lr * step), ar = mag * cos(li * step), ai = mag * sin(li * step);
    const double den = lr * lr + li * li, cr = ((ar - 1.0) * lr + ai * li) / den, ci = (ai * lr - (ar - 1.0) * li) / den;
    sp[SSMP_AB + (g * 64 + p) * 2 + 0] = (float)ar; sp[SSMP_AB + (g * 64 + p) * 2 + 1] = (float)ai;
    for (int c = 0; c < 16; ++c) { const double br = bre[(g * 64 + p) * 16 + c], bi = bim[(g * 64 + p) * 16 + c];
        sp[SSMP_BB + ((g * 64 + p) * 16 + c) * 2 + 0] = (float)(cr * br - ci * bi); sp[SSMP_BB + ((g * 64 + p) * 16 + c) * 2 + 1] = (float)(cr * bi + ci * br); }
}
__global__ void __launch_bounds__(64) k_ssm_scan(const bf16_t* acat, const float* sp, const float* cre, const float* cim, const float* dsk, bf16_t* geluy) {
    __shared__ float Cre[16][65], Cim[16][65], U[64][16], XR[64], XI[64];
    const int b = blockIdx.x / SSM_G, g = blockIdx.x % SSM_G, p = threadIdx.x;
    for (int e = p; e < 16 * 64; e += 64) { Cre[e >> 6][e & 63] = cre[(g * 16 + (e >> 6)) * 64 + (e & 63)]; Cim[e >> 6][e & 63] = cim[(g * 16 + (e >> 6)) * 64 + (e & 63)]; }
    const float ar = sp[SSMP_AB + (g * 64 + p) * 2], ai = sp[SSMP_AB + (g * 64 + p) * 2 + 1];
    float br[16], bi[16];
#pragma unroll
    for (int c = 0; c < 16; ++c) { br[c] = sp[SSMP_BB + ((g * 64 + p) * 16 + c) * 2]; bi[c] = sp[SSMP_BB + ((g * 64 + p) * 16 + c) * 2 + 1]; }
    const int co = p & 15, qd = p >> 4; const float dv = dsk[g * 16 + co];
    float xr = 0.f, xi = 0.f;
    for (int ch = 0; ch < 64; ++ch) {
        __syncthreads();
        const bf16_t* urow = acat + ((size_t)g * 512 + b * 64 + ch) * ACAT_LD;
        for (int e = p; e < 1024; e += 64) U[e >> 4][e & 15] = bf2f(urow[e]);
        __syncthreads();
        for (int i = 0; i < 64; ++i) {
            float ur = 0.f, ui = 0.f;
#pragma unroll
            for (int c = 0; c < 16; ++c) { ur += br[c] * U[i][c]; ui += bi[c] * U[i][c]; }
            const float nr = ar * xr - ai * xi + ur, ni = ar * xi + ai * xr + ui; xr = nr; xi = ni;
            XR[p] = xr; XI[p] = xi;
            __syncthreads();
            float y = 0.f;
#pragma unroll
            for (int pp = 0; pp < 16; ++pp) { const int P_ = qd * 16 + pp; y += Cre[co][P_] * XR[P_] - Cim[co][P_] * XI[P_]; }
            y += __shfl_xor(y, 16); y += __shfl_xor(y, 32);
            if (qd == 0) { y += dv * U[i][co]; geluy[((size_t)b * SEQ + ch * 64 + i) * 512 + g * 16 + co] = f2bf(gelu_tanh(y)); }
            __syncthreads();
        }
    }
}

__global__ void __launch_bounds__(256) k_win_attn(const bf16_t* q, const bf16_t* kw, const bf16_t* vw, const float* g3, bf16_t* owin) {
    const int gw = blockIdx.x * 4 + (threadIdx.x >> 6), lane = threadIdx.x & 63;
    const int t = gw >> 3, h = gw & 7, b = t / SEQ, s = t % SEQ, g = h >> 2;
    const float qv = bf2f(q[(((size_t)b * NH + h) * SEQ + s) * 64 + lane]);
    const bf16_t* K = kw + ((size_t)b * NG + g) * SEQ * 64; const bf16_t* V = vw + ((size_t)b * NG + g) * SEQ * 64;
    float m = -1e30f, l = 0.f, acc = 0.f;
    const int k0 = s - 511 < 0 ? 0 : s - 511;
    for (int k = k0; k <= s; ++k) {
        const float sc = wave_sum(qv * bf2f(K[(size_t)k * 64 + lane]));
        const float mn = fmaxf(m, sc), f = exp2f(m - mn), p = exp2f(sc - mn);
        l = l * f + p; acc = acc * f + p * bf2f(V[(size_t)k * 64 + lane]); m = mn;
    }
    owin[(size_t)t * 512 + h * 64 + lane] = f2bf(g3[(size_t)t * 24 + 16 + h] * acc / l);
}

__global__ void __launch_bounds__(256) k_cmp_slc_attn(const bf16_t* q, const bf16_t* kcmp, const bf16_t* vcmp, const bf16_t* ks, const bf16_t* vs, const float* g3, const bf16_t* owin, bf16_t* onsa) {
    __shared__ float Ps[4][4][256];
    __shared__ float Sc[4][1024];
    const int w = threadIdx.x >> 6, lane = threadIdx.x & 63;
    const int gw = blockIdx.x * 4 + w, t = gw >> 1, g = gw & 1, b = t / SEQ, s = t % SEQ, qblk = s >> 6;
    const bf16_t* KC = kcmp + ((size_t)b * NG + g) * 256 * 64; const bf16_t* VC = vcmp + ((size_t)b * NG + g) * 256 * 64;
    const bf16_t* KS = ks + ((size_t)b * NG + g) * SEQ * 64; const bf16_t* VS = vs + ((size_t)b * NG + g) * SEQ * 64;
    const int ncv = (s >= 31) ? ((s - 31) >> 4) + 1 : 0;
    __shared__ float Ocmp[4][4][64];
    for (int r = 0; r < 4; ++r) {
        const bf16_t* qp = q + (((size_t)b * NH + g * 4 + r) * SEQ + s) * 64;
        float sc[4]; float mx = -1e30f;
#pragma unroll
        for (int j = 0; j < 4; ++j) { const int c = lane + 64 * j; float a = -1e30f;
            if (c < ncv) { a = 0.f; for (int d = 0; d < 64; ++d) a += bf2f(qp[d]) * bf2f(KC[(size_t)c * 64 + d]); }
            sc[j] = a; mx = fmaxf(mx, a); }
        mx = wave_max(mx); float den = 0.f;
#pragma unroll
        for (int j = 0; j < 4; ++j) { const int c = lane + 64 * j; sc[j] = (c < ncv) ? exp2f(sc[j] - mx) : 0.f; den += sc[j]; }
        den = wave_sum(den); const float inv = den > 0.f ? 1.f / den : 1.f;
#pragma unroll
        for (int j = 0; j < 4; ++j) Ps[w][r][lane + 64 * j] = sc[j] * inv;
        __syncthreads();
        float a = 0.f;
        for (int c = 0; c < ncv; ++c) a += Ps[w][r][c] * bf2f(VC[(size_t)c * 64 + lane]);
        Ocmp[w][r][lane] = a;
    }
    __syncthreads();
    float imp = 0.f;
    for (int r = 0; r < 4; ++r) for (int c = 4 * lane - 1; c <= 4 * lane + 3; ++c) if (c >= 0 && c < NCMP) imp += Ps[w][r][c];
    const bool force = (lane == 0) || (lane == qblk) || (lane == qblk - 1);
    const float score = (lane <= qblk) ? imp + (force ? 1000.f : 0.f) : -1e30f;
    int rank = 0;
    for (int j = 0; j < 64; ++j) { const float o = __shfl(score, j); rank += (o > score || (o == score && j < lane)) ? 1 : 0; }
    const unsigned long long selmask = __ballot(rank < 16 && lane <= qblk);
    for (int r = 0; r < 4; ++r) {
        const bf16_t* qp = q + (((size_t)b * NH + g * 4 + r) * SEQ + s) * 64;
        int nb = 0; float mx = -1e30f;
        for (int j = 0; j < 64; ++j) if ((selmask >> j) & 1ull) {
            const int key = 64 * j + lane; float a = -1e30f;
            if (key <= s) { a = 0.f; for (int d = 0; d < 64; ++d) a += bf2f(qp[d]) * bf2f(KS[(size_t)key * 64 + d]); }
            Sc[w][nb * 64 + lane] = a; mx = fmaxf(mx, a); ++nb;
        }
        mx = wave_max(mx); float den = 0.f;
        for (int i = 0; i < nb; ++i) { const float a = Sc[w][i * 64 + lane]; const float p = (a > -1e29f) ? exp2f(a - mx) : 0.f; Sc[w][i * 64 + lane] = p; den += p; }
        den = wave_sum(den); const float inv = den > 0.f ? 1.f / den : 1.f;
        __syncthreads();
        float a = 0.f; nb = 0;
        for (int j = 0; j < 64; ++j) if ((selmask >> j) & 1ull) {
            for (int kk = 0; kk < 64; ++kk) { const float p = Sc[w][nb * 64 + kk]; if (p != 0.f) a += p * bf2f(VS[(size_t)(64 * j + kk) * 64 + lane]); }
            ++nb;
        }
        const int h = g * 4 + r;
        const float o = g3[(size_t)t * 24 + h] * Ocmp[w][r][lane] + g3[(size_t)t * 24 + 8 + h] * (a * inv) + bf2f(owin[(size_t)t * 512 + h * 64 + lane]);
        onsa[(size_t)t * 512 + h * 64 + lane] = f2bf(o);
        __syncthreads();
    }
}

__global__ void __launch_bounds__(256) k_nsa_proj(const bf16_t* onsa, const float* w, const bf16_t* sgn, bf16_t* m1) {
    const int m0 = blockIdx.y * 64, n0 = blockIdx.x * 64;
    auto al = [&](int m, int k) { return bf2f(onsa[(size_t)m * 512 + k]); };
    auto bl = [&](int b, int k, int n) { return w[(size_t)k * DM + n]; };
    auto epi = [&](float (*Cs)[64][65], int m0_, int n0_) {
        for (int e = threadIdx.x; e < 64 * 64; e += 256) { const int r = e >> 6, c = e & 63; const size_t ix = (size_t)(m0_ + r) * DM + n0_ + c;
            m1[ix] = f2bf(bf2f(sgn[ix]) * Cs[0][r][c]); }
    };
    tgemm<1>(m0, n0, 512, al, bl, epi);
}
__global__ void __launch_bounds__(256) k_glu(const bf16_t* geluy, const float* w, const bf16_t* sgs, const bf16_t* m1, bf16_t* merged) {
    const int m0 = blockIdx.y * 64, n0 = blockIdx.x * 64;
    auto al = [&](int m, int k) { return bf2f(geluy[(size_t)m * 512 + k]); };
    auto bl = [&](int b, int k, int n) { return w[(size_t)k * 2048 + b * 1024 + n]; };
    auto epi = [&](float (*Cs)[64][65], int m0_, int n0_) {
        for (int e = threadIdx.x; e < 64 * 64; e += 256) { const int r = e >> 6, c = e & 63; const size_t ix = (size_t)(m0_ + r) * DM + n0_ + c;
            merged[ix] = f2bf(bf2f(m1[ix]) + bf2f(sgs[ix]) * Cs[0][r][c] * sigmoidf_(Cs[1][r][c])); }
    };
    tgemm<2>(m0, n0, 512, al, bl, epi);
}
__global__ void __launch_bounds__(256) k_wout(const bf16_t* merged, const float* w, float* out, const float* gnext, bf16_t* xn) {
    const int m0 = blockIdx.y * 64, n0 = blockIdx.x * 64;
    auto al = [&](int m, int k) { return bf2f(merged[(size_t)m * DM + k]); };
    auto bl = [&](int b, int k, int n) { return w[(size_t)k * DM + n]; };
    auto epi = [&](float (*Cs)[64][65], int m0_, int n0_) {
        for (int e = threadIdx.x; e < 64 * 64; e += 256) { const int r = e >> 6, c = e & 63; const size_t ix = (size_t)(m0_ + r) * DM + n0_ + c;
            const float o = out[ix] + Cs[0][r][c]; out[ix] = o; xn[ix] = f2bf(o * gnext[n0_ + c]); }
    };
    tgemm<1>(m0, n0, DM, al, bl, epi);
}

static void launch_mega(const Args& a0, int lo, int hi, int fused, int grid, hipStream_t stream, int aflags = 7) {
    Args a = a0; a.ph_lo = lo; a.ph_hi = hi; a.fused = fused; a.pad = aflags;
    hipLaunchKernelGGL(mega, dim3(grid), dim3(NWAVES * 64), LDS_BYTES, stream, a);
}
extern "C" void kernel_launch(void* const* d_in, const int* in_sizes, int n_in, void* d_out, int out_size, void* d_ws, size_t ws_size, hipStream_t stream) {
    static int grid = 0;
    if (grid == 0) {
        if (n_in != 32 || out_size != T * DM || ws_size < WS_END) { fprintf(stderr, "kernel_launch: unexpected shapes n_in %d out %d ws %zu\n", n_in, out_size, ws_size); grid = -1; return; }
        int dev = 0, cus = 0;
        if (hipGetDevice(&dev) != hipSuccess || hipDeviceGetAttribute(&cus, hipDeviceAttributeMultiprocessorCount, dev) != hipSuccess) { grid = -1; return; }
        if (hipFuncSetAttribute((const void*)mega, hipFuncAttributeMaxDynamicSharedMemorySize, LDS_BYTES) != hipSuccess) { fprintf(stderr, "kernel_launch: hipFuncSetAttribute failed\n"); grid = -1; return; }
        if (cus < 256) { fprintf(stderr, "kernel_launch: this kernel's unit maps need 256 co-resident workgroups (one per CU); the device has %d CUs\n", cus); grid = -1; return; }
        grid = 256;
    }
    if (grid < 0) return;
    const float* in[32]; for (int i = 0; i < 32; ++i) in[i] = (const float*)d_in[i];
    unsigned char* ws = (unsigned char*)d_ws; float* out = (float*)d_out;
    (void)hipMemsetAsync(ws + WS_CTL, 0, CTL_ZERO_BYTES, stream);
    Args a{}; for (int i = 0; i < 32; ++i) a.in[i] = in[i]; a.out = out; a.ws = ws;
    float* ssq = (float*)(ws + WS_SSQ); float* g3 = (float*)(ws + WS_G3); bf16_t* hid = (bf16_t*)(ws + WS_HID);
    bf16_t* kcmp = (bf16_t*)(ws + WS_KCMP); bf16_t* vcmp = (bf16_t*)(ws + WS_VCMP); float* ssmp = (float*)(ws + WS_SSMP);
    bf16_t* xn = (bf16_t*)(ws + WS_XN);
    WinOut wo; wo.q = (bf16_t*)(ws + WS_Q); wo.ks = (bf16_t*)(ws + WS_KS); wo.vs = (bf16_t*)(ws + WS_VS); wo.kw = (bf16_t*)(ws + WS_KW); wo.vw = (bf16_t*)(ws + WS_VW);
    wo.kcr = (bf16_t*)(ws + WS_KCR); wo.vcr = (bf16_t*)(ws + WS_VCR); wo.acat = (bf16_t*)(ws + WS_ACAT); wo.sgn = (bf16_t*)(ws + WS_SGN); wo.sgs = (bf16_t*)(ws + WS_SGS); wo.g3 = g3;
    wo.q_norm = in[7]; wo.k_norm_slc = in[9]; wo.k_norm_win = in[10];
    bf16_t* owin = (bf16_t*)(ws + WS_OWIN); bf16_t* onsa = (bf16_t*)(ws + WS_ONSA); bf16_t* geluy = (bf16_t*)(ws + WS_GELUY);
    bf16_t* m1 = (bf16_t*)(ws + WS_M1); bf16_t* merged = (bf16_t*)(ws + WS_MERGED);

#if defined(PROBE_ATT)
    for (int ph = 0; ph < NPH; ++ph) { launch_mega(a, ph, ph + 1, 0, grid, stream); if (ph == PH_MIDB) for (int r_ = 0; r_ < 4; ++r_) launch_mega(a, ph, ph + 1, 0, grid, stream, 2 | 16); }
#elif defined(PROBE_MIDB)
    for (int ph = 0; ph < NPH; ++ph) {
        if (ph == PH_MIDB && PROBE_MIDB == 4) launch_mega(a, ph, ph + 1, 0, grid, stream, 2);
        launch_mega(a, ph, ph + 1, 0, grid, stream);
        if (ph == PH_MIDB) launch_mega(a, ph, ph + 1, 0, grid, stream, PROBE_MIDB == 1 ? 4 : PROBE_MIDB == 2 ? 3 : PROBE_MIDB == 3 ? 2 : PROBE_MIDB == 5 ? 7 : 1);
    }
#elif defined(PROBE_F1D)
    for (int ph = 0; ph < NPH; ++ph) { launch_mega(a, ph, ph + 1, 0, grid, stream); if (ph == PH_F1D) launch_mega(a, ph, ph + 1, 0, grid, stream, 7 | 8); }
#elif defined(REP_PHASE)
    for (int ph = 0; ph < NPH; ++ph) for (int r = 0; r < (ph == REP_PHASE ? 2 : 1); ++r) launch_mega(a, ph, ph + 1, 0, grid, stream);
#elif defined(MK_PER_PHASE)
    for (int ph = 0; ph < NPH; ++ph) launch_mega(a, ph, ph + 1, 0, grid, stream);
#else
    launch_mega(a, 0, NPH, 1, grid, stream);
#endif
}
```

```cpp
#include <hip/hip_runtime.h>
#include <cstdint>
#include <cstdio>

typedef unsigned short bf16_t;
constexpr int BATCH = 8, SEQ = 4096, DM = 1024, T = BATCH * SEQ;
constexpr int FF = 2816, NH = 8, NG = 2, HD = 64;
constexpr int INW = 3864, NCMP = 255;
constexpr int SSM_G = 32, SSM_C = 16, SSM_P = 64;
constexpr float RMS_EPS = 1e-6f;
constexpr float C2 = 0.125f * 1.4426950408889634f;

__device__ __forceinline__ float bf2f(bf16_t v) { return __uint_as_float(((unsigned)v) << 16); }
__device__ __forceinline__ bf16_t f2bf(float f) { unsigned u = __float_as_uint(f); return (bf16_t)((u + 0x7fffu + ((u >> 16) & 1u)) >> 16); }
__device__ __forceinline__ unsigned pk2(float lo, float hi) { return (unsigned)f2bf(lo) | ((unsigned)f2bf(hi) << 16); }
__device__ __forceinline__ float sigmoidf_(float x) { return 1.f / (1.f + __expf(-x)); }
__device__ __forceinline__ float gelu_tanh(float x) { const float u = 0.7978845608028654f * (x + 0.044715f * x * x * x); return 0.5f * x * (1.f + tanhf(u)); }
__device__ __forceinline__ float fsigmoid(float x) { return __builtin_amdgcn_rcpf(1.f + __builtin_amdgcn_exp2f(-1.4426950408889634f * x)); }
__device__ __forceinline__ float fgelu_tanh(float x) { const float u = 0.7978845608028654f * (x + 0.044715f * x * x * x); return x * fsigmoid(2.f * u); }
__device__ __forceinline__ float wave_sum(float v) {
#pragma unroll
    for (int o = 1; o < 64; o <<= 1) v += __shfl_xor(v, o);
    return v;
}
__device__ __forceinline__ float wave_max(float v) {
#pragma unroll
    for (int o = 1; o < 64; o <<= 1) v = fmaxf(v, __shfl_xor(v, o));
    return v;
}

constexpr size_t MiB = 1u << 20;
constexpr size_t WS_CTL = 0, CTL_ZERO_BYTES = 32 * 1024;
constexpr size_t WS_W1GU = 1 * MiB;
constexpr size_t WS_W1D = 12 * MiB;
constexpr size_t WS_WIN = 18 * MiB;
constexpr size_t WS_WC1K = 26 * MiB;
constexpr size_t WS_WC1V = 27 * MiB;
constexpr size_t WS_MISC = 28 * MiB;
constexpr size_t WS_WNSA = 29 * MiB;
constexpr size_t WS_WGLU = 30 * MiB;
constexpr size_t WS_WOUT = 32 * MiB;
constexpr size_t WS_W2GU = 34 * MiB;
constexpr size_t WS_W2D = 45 * MiB;
constexpr size_t WS_W1S = 51 * MiB;
constexpr size_t WS_WTOEP = 60 * MiB;
constexpr size_t WS_KTAB = 132 * MiB;
constexpr size_t WS_SSQ = 134 * MiB;
constexpr size_t WS_G3 = 136 * MiB;
constexpr size_t WS_HID = 139 * MiB;
constexpr size_t WS_KCMP = 143 * MiB;
constexpr size_t WS_VCMP = 143 * MiB + 512 * 1024;
constexpr size_t WS_SSMP = 144 * MiB;
constexpr size_t WS_SST = 145 * MiB;
constexpr size_t WS_XN = 161 * MiB;
constexpr size_t WS_BIG = 225 * MiB;
constexpr size_t WS_ACT = WS_BIG;
constexpr size_t WS_SGN = WS_BIG;
constexpr size_t WS_SGS = WS_BIG + 64 * MiB;
constexpr size_t WS_Q = WS_BIG + 128 * MiB;
constexpr size_t WS_KS = WS_BIG + 160 * MiB;
constexpr size_t WS_VS = WS_BIG + 168 * MiB;
constexpr size_t WS_KW = WS_BIG + 176 * MiB;
constexpr size_t WS_VW = WS_BIG + 184 * MiB;
constexpr size_t WS_KCR = WS_BIG + 192 * MiB;
constexpr size_t WS_VCR = WS_BIG + 201 * MiB;
constexpr size_t WS_ACAT = WS_BIG + 210 * MiB;
constexpr size_t WS_OWIN = WS_BIG + 246 * MiB;
constexpr size_t WS_M1 = WS_BIG + 128 * MiB;
constexpr size_t WS_MERGED = WS_BIG + 192 * MiB;
constexpr size_t WS_ONSA = WS_XN;
constexpr size_t WS_GELUY = WS_XN + 32 * MiB;
constexpr size_t WS_END = 512 * MiB;
constexpr int ACAT_LD = 1152;

namespace pg8 {
#define PG8_LAS __attribute__((address_space(3)))
typedef short bf16x8 __attribute__((ext_vector_type(8)));
typedef float f32x4 __attribute__((ext_vector_type(4)));
typedef float f32x2 __attribute__((ext_vector_type(2)));
typedef unsigned u32x4 __attribute__((ext_vector_type(4)));
typedef unsigned u32x2 __attribute__((ext_vector_type(2)));
constexpr int BM = 256, BK = 64, HALF = 128, HTB = HALF * BK * 2  , STAGE_BYTES = 8 * HTB, NXCD = 8, WGM = 8;

__host__ __device__ __forceinline__ int lds_byte(int r, int c) { const int st = (r >> 4) * 2 + (c >> 5), rr = r & 15, cc = c & 31, ob = rr * 64 + cc * 2; return st * 1024 + (ob ^ (((ob >> 9) & 1) << 5)); }
__host__ __device__ __forceinline__ void stage_rc(int b, int& R, int& C) { const int st = b / 1024, sb = b % 1024, swz = sb ^ (((sb >> 9) & 1) << 5); R = (st >> 1) * 16 + swz / 64; C = (st & 1) * 32 + (swz % 64) / 2; }
__host__ __device__ __forceinline__ int perm32(int rho) { const int n = rho >> 4, i = rho & 15; return 8 * (i >> 2) + 4 * n + (i & 3); }

struct Unit { int pm, pn, pg; };
struct Gemm { const bf16_t* A; const bf16_t* Bt; int lda, ldb, K; size_t gsA, gsB; };

struct StaticOrder {
    int nM, nN, nwg, G, c;
    __host__ __device__ __forceinline__ void init(int M, int N, int G_, int c_) { nM = M / BM; nN = N / BM; nwg = nM * nN; G = G_; c = c_; }
    __host__ __device__ __forceinline__ bool next(int i, Unit& u) const {
        const long L = (long)i * G + c; if (L >= nwg) return false;
        int wgid = (int)L; { const int q = nwg / NXCD, r = nwg % NXCD, xcd = wgid % NXCD, off = wgid / NXCD; wgid = (xcd < r ? xcd * (q + 1) : r * (q + 1) + (xcd - r) * q) + off; }
        const int nig = WGM * nN, gid = wgid / nig, fm = gid * WGM, gsz = (nM - fm) < WGM ? (nM - fm) : WGM;
        u.pm = fm + ((wgid % nig) % gsz); u.pn = (wgid % nig) / gsz; u.pg = 0; return true;
    }
};
struct GroupOrder {
    int nM, nN, ng, G, c;
    __host__ __device__ __forceinline__ void init(int nM_, int nN_, int ng_, int G_, int c_) { nM = nM_; nN = nN_; ng = ng_; G = G_; c = c_; }
    __host__ __device__ __forceinline__ bool next(int i, Unit& u) const {
        if (c < 0) return false;
        const long L = (long)i * G + c; if (L >= (long)ng * nM * nN) return false;
        const int per = nM * nN, r = (int)(L % per); u.pg = (int)(L / per); u.pm = r % nM; u.pn = r / nM; return true;
    }
};

struct SplitOrder {
    StaticOrder S;
    __host__ __device__ __forceinline__ bool next(int i, Unit& u) const { Unit t; if (!S.next(i >> 1, t)) return false; u.pm = t.pm; u.pn = 2 * t.pn + (i & 1); u.pg = 0; return true; }
};
typedef __bf16 bf16x2_t __attribute__((ext_vector_type(2)));
__device__ __forceinline__ unsigned cvt_pk_bf16(float lo, float hi) { f32x2 v = {lo, hi}; bf16x2_t b = __builtin_convertvector(v, bf16x2_t); return __builtin_bit_cast(unsigned, b); }

template <class Epi, class Sched, bool ALIGN_EPI = false, bool SP2 = false>
__device__ __forceinline__ void gemm_phase(PG8_LAS unsigned char* lds, const Gemm g, const Sched& S, const Epi& E) {
    const int tid = threadIdx.x, wid = __builtin_amdgcn_readfirstlane(tid >> 6), lane = tid & 63, wr = wid >> 2, wc = wid & 3, fr = lane & 15, fq = lane >> 4;
    const int K = g.K, nt = K / BK;
    unsigned voffA[2], voffB[2];
#pragma unroll
    for (int i = 0; i < 2; ++i) { int R, C; stage_rc(tid * 16 + i * 8192, R, C); const int Rb = Epi::PERM ? ((R & ~31) + perm32(R & 31)) : R;
        voffA[i] = (unsigned)(R * g.lda + C) * 2u; voffB[i] = (unsigned)(Rb * g.ldb + C) * 2u; }
    const size_t kstep = (size_t)(BK * 2);
    const size_t hstepA = (size_t)HALF * g.lda * 2, hstepB = (size_t)HALF * g.ldb * 2;
    const size_t tstepA = 2 * hstepA, tstepB = 2 * hstepB;
    const unsigned ldsw = (unsigned)wid * 1024u;
    const int aoff = lds_byte(wr * 64 + fr, fq * 8), boff = lds_byte(wc * 32 + fr, fq * 8);
#define PG8_SA(b, h) (((b) * 2 + (h)) * HTB)
#define PG8_SB(b, h) ((4 + (b) * 2 + (h)) * HTB)
#define PG8_STAGE(bufoff, gbase, voff) do { _Pragma("unroll") for (int _i = 0; _i < 2; ++_i) \
        __builtin_amdgcn_global_load_lds((const unsigned*)((const char*)(gbase) + (voff)[_i]), (PG8_LAS unsigned*)(lds + (bufoff) + ldsw + _i * 8192), 16, 0, 0); } while (0)
#define PG8_LDA(dst, b, h) do { _Pragma("unroll") for (int m = 0; m < 4; ++m) _Pragma("unroll") for (int k = 0; k < 2; ++k) dst[m][k] = *(const PG8_LAS bf16x8*)(lds + PG8_SA(b, h) + aoff + m * 2048 + k * 1024); } while (0)
#define PG8_LDB(dst, b, h) do { _Pragma("unroll") for (int n = 0; n < 2; ++n) _Pragma("unroll") for (int k = 0; k < 2; ++k) dst[n][k] = *(const PG8_LAS bf16x8*)(lds + PG8_SB(b, h) + boff + n * 2048 + k * 1024); } while (0)
#define PG8_MMA(ai, bj, At, Bt) do { __builtin_amdgcn_s_setprio(1); _Pragma("unroll") for (int m = 0; m < 4; ++m) _Pragma("unroll") for (int n = 0; n < 2; ++n) _Pragma("unroll") for (int k = 0; k < 2; ++k) \
        acc[ai][bj][m][n] = __builtin_amdgcn_mfma_f32_16x16x32_bf16(Bt[n][k], At[m][k], acc[ai][bj][m][n], 0, 0, 0); __builtin_amdgcn_s_setprio(0); } while (0)
#define PG8_WAIT_V(n) asm volatile("s_waitcnt vmcnt(" #n ")" ::: "memory")
#define PG8_WAIT_L(n) asm volatile("s_waitcnt lgkmcnt(" #n ")" ::: "memory")
#define PG8_BAR __builtin_amdgcn_s_barrier()
#define PG8_SCHED __builtin_amdgcn_sched_barrier(0)
    Unit cur, nxt; int ui = 0;
    if (!S.next(0, cur)) return;
    f32x4 acc[2][2][4][2];
    if constexpr (Epi::HAS_INIT) E.init(acc, cur, wr, wc, fr, fq);
    else {
#pragma unroll
    for (int a = 0; a < 2; ++a)
#pragma unroll
        for (int b = 0; b < 2; ++b)
#pragma unroll
            for (int m = 0; m < 4; ++m)
#pragma unroll
                for (int n = 0; n < 2; ++n) acc[a][b][m][n] = (f32x4){0.f, 0.f, 0.f, 0.f};
    }
    bf16x8 At[4][2], B0[2][2], B1[2][2];
    const char* cA = (const char*)g.A + (size_t)cur.pg * g.gsA + (size_t)cur.pm * tstepA; const char* cB = (const char*)g.Bt + (size_t)cur.pg * g.gsB + (size_t)cur.pn * tstepB;
    if constexpr (SP2) {
        PG8_STAGE(PG8_SB(0, 0), cB, voffB); PG8_STAGE(PG8_SB(0, 1), cB + hstepB, voffB); PG8_STAGE(PG8_SA(0, 0), cA, voffA); PG8_STAGE(PG8_SA(0, 1), cA + hstepA, voffA);
        if (wr == 1) PG8_BAR;
        PG8_WAIT_V(2); PG8_BAR;
        PG8_STAGE(PG8_SB(1, 0), cB + kstep, voffB); PG8_STAGE(PG8_SA(1, 0), cA + kstep, voffA); PG8_STAGE(PG8_SB(1, 1), cB + hstepB + kstep, voffB);
        PG8_WAIT_V(6); PG8_BAR;
    } else {
        PG8_STAGE(PG8_SB(0, 0), cB, voffB); PG8_STAGE(PG8_SA(0, 0), cA, voffA); PG8_STAGE(PG8_SB(0, 1), cB + hstepB, voffB); PG8_STAGE(PG8_SA(0, 1), cA + hstepA, voffA);
        if (wr == 1) PG8_BAR;
        PG8_WAIT_V(4); PG8_BAR;
        PG8_STAGE(PG8_SB(1, 0), cB + kstep, voffB); PG8_STAGE(PG8_SA(1, 0), cA + kstep, voffA); PG8_STAGE(PG8_SB(1, 1), cB + hstepB + kstep, voffB);
        PG8_WAIT_V(6); PG8_BAR;
    }
    for (;;) {
        const bool has_next = S.next(ui + 1, nxt);
        const char* nA = has_next ? (const char*)g.A + (size_t)nxt.pg * g.gsA + (size_t)nxt.pm * tstepA : cA; const char* nB = has_next ? (const char*)g.Bt + (size_t)nxt.pg * g.gsB + (size_t)nxt.pn * tstepB : cB;
        for (int t = 0; t < nt; t += 2) {
            const bool last = (t == nt - 2);
            const char* a1 = cA + (size_t)(t + 1) * kstep;
            const char* a2 = last ? nA : cA + (size_t)(t + 2) * kstep; const char* b2 = last ? nB : cB + (size_t)(t + 2) * kstep;
            const char* a3 = a2 + kstep; const char* b3 = b2 + kstep;
            if constexpr (SP2) {
            PG8_LDB(B0, 0, 0); PG8_LDB(B1, 0, 1); PG8_SCHED; PG8_LDA(At, 0, 0); PG8_STAGE(PG8_SA(1, 1), a1 + hstepA, voffA);
            PG8_WAIT_V(8); PG8_WAIT_L(0); PG8_BAR; PG8_MMA(0, 0, At, B0); PG8_MMA(0, 1, At, B1); PG8_BAR; PG8_SCHED;
            PG8_LDA(At, 0, 1); PG8_STAGE(PG8_SB(0, 0), b2, voffB); PG8_STAGE(PG8_SB(0, 1), b2 + hstepB, voffB); PG8_STAGE(PG8_SA(0, 0), a2, voffA);
            PG8_WAIT_V(8); PG8_WAIT_L(0); PG8_BAR; PG8_MMA(1, 0, At, B0); PG8_MMA(1, 1, At, B1); PG8_BAR; PG8_SCHED;
            PG8_LDB(B0, 1, 0); PG8_LDB(B1, 1, 1); PG8_SCHED; PG8_LDA(At, 1, 0); PG8_STAGE(PG8_SA(0, 1), a2 + hstepA, voffA);
            PG8_WAIT_V(8); PG8_WAIT_L(0); PG8_BAR; PG8_MMA(0, 0, At, B0); PG8_MMA(0, 1, At, B1); PG8_BAR; PG8_SCHED;
            PG8_LDA(At, 1, 1); PG8_STAGE(PG8_SB(1, 0), b3, voffB); PG8_STAGE(PG8_SB(1, 1), b3 + hstepB, voffB); PG8_STAGE(PG8_SA(1, 0), a3, voffA);
            PG8_WAIT_V(8); PG8_WAIT_L(0); PG8_BAR; PG8_MMA(1, 0, At, B0); PG8_MMA(1, 1, At, B1); PG8_BAR; PG8_SCHED;
            } else {
            PG8_LDB(B0, 0, 0); PG8_SCHED; PG8_LDA(At, 0, 0); PG8_STAGE(PG8_SA(1, 1), a1 + hstepA, voffA);
            PG8_WAIT_L(8); PG8_BAR; PG8_WAIT_L(0); PG8_MMA(0, 0, At, B0); PG8_BAR; PG8_SCHED;
            PG8_LDB(B1, 0, 1); PG8_STAGE(PG8_SB(0, 0), b2, voffB);
            PG8_BAR; PG8_WAIT_L(0); PG8_MMA(0, 1, At, B1); PG8_BAR;
            PG8_LDA(At, 0, 1); PG8_STAGE(PG8_SA(0, 0), a2, voffA);
            PG8_BAR; PG8_WAIT_L(0); PG8_MMA(1, 0, At, B0); PG8_BAR; PG8_SCHED;
            PG8_STAGE(PG8_SB(0, 1), b2 + hstepB, voffB);
            PG8_WAIT_V(6); PG8_BAR; PG8_MMA(1, 1, At, B1); PG8_BAR;
            PG8_LDB(B0, 1, 0); PG8_SCHED; PG8_LDA(At, 1, 0); PG8_STAGE(PG8_SA(0, 1), a2 + hstepA, voffA);
            PG8_WAIT_L(8); PG8_BAR; PG8_WAIT_L(0); PG8_MMA(0, 0, At, B0); PG8_BAR; PG8_SCHED;
            PG8_LDB(B1, 1, 1); PG8_STAGE(PG8_SB(1, 0), b3, voffB);
            PG8_BAR; PG8_WAIT_L(0); PG8_MMA(0, 1, At, B1); PG8_BAR;
            PG8_LDA(At, 1, 1); PG8_STAGE(PG8_SA(1, 0), a3, voffA);
            PG8_BAR; PG8_WAIT_L(0); PG8_MMA(1, 0, At, B0); PG8_BAR; PG8_SCHED;
            PG8_STAGE(PG8_SB(1, 1), b3 + hstepB, voffB);
            PG8_WAIT_V(6); PG8_BAR; PG8_MMA(1, 1, At, B1); PG8_BAR;
            }
        }
        if constexpr (ALIGN_EPI) { if (wr == 0) PG8_BAR; }
        if constexpr (!Epi::AFTER_DRAIN) { E(acc, cur, wr, wc, fr, fq); }
        if (!has_next) break;
        if constexpr (Epi::HAS_INIT) E.init(acc, nxt, wr, wc, fr, fq);
        else {
#pragma unroll
        for (int a = 0; a < 2; ++a)
#pragma unroll
            for (int b = 0; b < 2; ++b)
#pragma unroll
                for (int m = 0; m < 4; ++m)
#pragma unroll
                    for (int n = 0; n < 2; ++n) acc[a][b][m][n] = (f32x4){0.f, 0.f, 0.f, 0.f};
        }
        cur = nxt; cA = nA; cB = nB; ++ui;
        if constexpr (ALIGN_EPI) { if (wr == 1) PG8_BAR; }
    }
    PG8_WAIT_V(0);
    if constexpr (!ALIGN_EPI) { if (wr == 0) PG8_BAR; }
    PG8_BAR;
    if constexpr (Epi::AFTER_DRAIN) { E.fused(acc, cur, wr, wc, fr, fq, lds, wid, lane); }
#undef PG8_SA
#undef PG8_SB
#undef PG8_STAGE
#undef PG8_LDA
#undef PG8_LDB
#undef PG8_MMA
#undef PG8_WAIT_V
#undef PG8_WAIT_L
#undef PG8_BAR
#undef PG8_SCHED
}
}
#define PG8_SP2 true
#define PG8_ALIGN true

namespace epi {
using pg8::f32x4; using pg8::u32x4; using pg8::u32x2; using pg8::Unit; using pg8::cvt_pk_bf16;
constexpr int HALF = 128, BM = 256;

__device__ __forceinline__ float rstd_row(const float* ssq, int row, int fq) {
    const f32x4 p = *(const f32x4*)(ssq + (size_t)row * 16 + 4 * fq);
    float s = (p[0] + p[1]) + (p[2] + p[3]);
    s += __shfl_xor(s, 16); s += __shfl_xor(s, 32);
    return rsqrtf(s * (1.f / DM) + RMS_EPS);
}
__device__ __forceinline__ void rstd8(const float* ssq, int row0, int fq, float (&rs)[8]) {
    f32x4 p[8];
#pragma unroll
    for (int i = 0; i < 8; ++i) p[i] = *(const f32x4*)(ssq + (size_t)(row0 + (i >> 2) * HALF + (i & 3) * 16) * 16 + 4 * fq);
#pragma unroll
    for (int i = 0; i < 8; ++i) { float s = (p[i][0] + p[i][1]) + (p[i][2] + p[i][3]); s += __shfl_xor(s, 16); s += __shfl_xor(s, 32); rs[i] = rsqrtf(s * (1.f / DM) + RMS_EPS); }
}
__device__ __forceinline__ void rstd8_cached(const float* ssq, int pm, int& cached_pm, PG8_LAS float* tab, int row0, int wr, int wc, int fr, int fq, float (&rs)[8]) {
    PG8_LAS f32x4* mine = (PG8_LAS f32x4*)(tab + (((wr * 4 + wc) * 64 + fq * 16 + fr) * 8));
    if (pm != cached_pm) { rstd8(ssq, row0, fq, rs); mine[0] = (f32x4){rs[0], rs[1], rs[2], rs[3]}; mine[1] = (f32x4){rs[4], rs[5], rs[6], rs[7]}; cached_pm = pm; }
    else { const f32x4 a = mine[0], b = mine[1]; rs[0] = a[0]; rs[1] = a[1]; rs[2] = a[2]; rs[3] = a[3]; rs[4] = b[0]; rs[5] = b[1]; rs[6] = b[2]; rs[7] = b[3]; }
}
__device__ __forceinline__ u32x4 pack8(const f32x4& a, const f32x4& b) { u32x4 w; w.x = cvt_pk_bf16(a[0], a[1]); w.y = cvt_pk_bf16(a[2], a[3]); w.z = cvt_pk_bf16(b[0], b[1]); w.w = cvt_pk_bf16(b[2], b[3]); return w; }

struct EpiSwiGLU {
    static constexpr bool PERM = true, AFTER_DRAIN = false, HAS_INIT = false;
    bf16_t* act; const float* ssq; PG8_LAS float* rs_tab; mutable int cached_pm;
    __device__ __forceinline__ void operator()(const f32x4 (&acc)[2][2][4][2], const Unit& u, int wr, int wc, int fr, int fq) const {
        const int row0 = u.pm * BM + wr * 64 + fr, col0 = u.pn * HALF + wc * 32 + 8 * fq;
        float rs8[8]; rstd8_cached(ssq, u.pm, cached_pm, rs_tab, row0, wr, wc, fr, fq, rs8);
#pragma unroll
        for (int ai = 0; ai < 2; ++ai)
#pragma unroll
            for (int m = 0; m < 4; ++m) { const int row = row0 + ai * HALF + m * 16; const float rs = rs8[ai * 4 + m];
                f32x4 o[2];
#pragma unroll
                for (int n = 0; n < 2; ++n)
#pragma unroll
                    for (int j = 0; j < 4; ++j) { const float gv = acc[ai][0][m][n][j] * rs, uv = acc[ai][1][m][n][j] * rs; o[n][j] = gv * fsigmoid(gv) * uv; }
                *(u32x4*)(act + (size_t)row * FF + col0) = pack8(o[0], o[1]); }
    }
};

__device__ __forceinline__ void unpack8(const u32x4& w, f32x4& a, f32x4& b) {
    a[0] = __uint_as_float(w.x << 16); a[1] = __uint_as_float(w.x & 0xffff0000u); a[2] = __uint_as_float(w.y << 16); a[3] = __uint_as_float(w.y & 0xffff0000u);
    b[0] = __uint_as_float(w.z << 16); b[1] = __uint_as_float(w.z & 0xffff0000u); b[2] = __uint_as_float(w.w << 16); b[3] = __uint_as_float(w.w & 0xffff0000u);
}
template <bool IN_BF16, bool OUT_F32>
struct EpiResid {
    static constexpr bool PERM = true, AFTER_DRAIN = false, HAS_INIT = true;
    const float* xin; const bf16_t* xb_in; float* out; float alpha; bf16_t* xb_out; float* ssq;
    __device__ __forceinline__ void init(f32x4 (&acc)[2][2][4][2], const Unit& u, int wr, int wc, int fr, int fq) const {
        const int row0 = u.pm * BM + wr * 64 + fr, col0 = u.pn * BM + wc * 32 + 8 * fq; const float ia = 1.f / alpha;
        if constexpr (IN_BF16) {
            u32x4 t[2][4][2];
#pragma unroll
            for (int ai = 0; ai < 2; ++ai)
#pragma unroll
                for (int m = 0; m < 4; ++m)
#pragma unroll
                    for (int bj = 0; bj < 2; ++bj) t[ai][m][bj] = *(const u32x4*)(xb_in + (size_t)(row0 + ai * HALF + m * 16) * DM + col0 + bj * HALF);
#pragma unroll
            for (int ai = 0; ai < 2; ++ai)
#pragma unroll
                for (int m = 0; m < 4; ++m)
#pragma unroll
                    for (int bj = 0; bj < 2; ++bj) { f32x4 a, b; unpack8(t[ai][m][bj], a, b); acc[ai][bj][m][0] = a * ia; acc[ai][bj][m][1] = b * ia; }
        } else {
#pragma unroll
            for (int ai = 0; ai < 2; ++ai)
#pragma unroll
                for (int m = 0; m < 4; ++m)
#pragma unroll
                    for (int bj = 0; bj < 2; ++bj) { const size_t ix = (size_t)(row0 + ai * HALF + m * 16) * DM + col0 + bj * HALF;
                        acc[ai][bj][m][0] = *(const f32x4*)(xin + ix); acc[ai][bj][m][1] = *(const f32x4*)(xin + ix + 4); }
#pragma unroll
            for (int ai = 0; ai < 2; ++ai)
#pragma unroll
                for (int m = 0; m < 4; ++m)
#pragma unroll
                    for (int bj = 0; bj < 2; ++bj) { acc[ai][bj][m][0] *= ia; acc[ai][bj][m][1] *= ia; }
        }
    }
    __device__ __forceinline__ void operator()(const f32x4 (&acc)[2][2][4][2], const Unit& u, int wr, int wc, int fr, int fq) const {
        const int row0 = u.pm * BM + wr * 64 + fr, col0 = u.pn * BM + wc * 32 + 8 * fq;
#pragma unroll
        for (int ai = 0; ai < 2; ++ai)
#pragma unroll
            for (int m = 0; m < 4; ++m) { const int row = row0 + ai * HALF + m * 16; float ss = 0.f;
#pragma unroll
                for (int bj = 0; bj < 2; ++bj) { const size_t ix = (size_t)row * DM + col0 + bj * HALF;
                    const f32x4 o0 = acc[ai][bj][m][0] * alpha, o1 = acc[ai][bj][m][1] * alpha;
                    if constexpr (OUT_F32) { *(f32x4*)(out + ix) = o0; *(f32x4*)(out + ix + 4) = o1; }
                    else { *(u32x4*)(xb_out + ix) = pack8(o0, o1);
                        ss += (o0[0] * o0[0] + o0[1] * o0[1]) + (o0[2] * o0[2] + o0[3] * o0[3]) + (o1[0] * o1[0] + o1[1] * o1[1]) + (o1[2] * o1[2] + o1[3] * o1[3]); } }
                if constexpr (!OUT_F32) { ss += __shfl_xor(ss, 16); ss += __shfl_xor(ss, 32); if (fq == 0) ssq[(size_t)row * 16 + u.pn * 4 + wc] = ss; } }
    }
};

__device__ __forceinline__ void unpack8u(const u32x2& w, f32x4& a, f32x4& b) {
    const float k = 1.f / 255.f;
    a[0] = (float)(w.x & 255u) * k; a[1] = (float)((w.x >> 8) & 255u) * k; a[2] = (float)((w.x >> 16) & 255u) * k; a[3] = (float)(w.x >> 24) * k;
    b[0] = (float)(w.y & 255u) * k; b[1] = (float)((w.y >> 8) & 255u) * k; b[2] = (float)((w.y >> 16) & 255u) * k; b[3] = (float)(w.y >> 24) * k;
}
struct EpiWin {
    static constexpr bool PERM = true, AFTER_DRAIN = false, HAS_INIT = false;
    const float* ssq; bf16_t *q, *ks, *vs, *kw, *vw, *kcr, *vcr, *acat, *sgn, *sgs; float* g3; const float *q_norm, *k_norm_slc, *k_norm_win; PG8_LAS float* rs_tab; mutable int cached_pm;
    __device__ __forceinline__ void operator()(const f32x4 (&acc)[2][2][4][2], const Unit& u, int wr, int wc, int fr, int fq) const {
        const int row0 = u.pm * BM + wr * 64 + fr, pn = u.pn;
        float rs8[8]; rstd8_cached(ssq, u.pm, cached_pm, rs_tab, row0, wr, wc, fr, fq, rs8);
        if (pn < 5) {
            const int slot = 4 * pn + wc;
            bf16_t* base; int nh, idx; const float* gain = nullptr; float scale = 1.f;
            if (slot < 8) { base = q; nh = NH; idx = slot; gain = q_norm; scale = C2; }
            else if (slot < 10) { base = kcr; nh = NG; idx = slot - 8; }
            else if (slot < 12) { base = vcr; nh = NG; idx = slot - 10; }
            else if (slot < 14) { base = ks; nh = NG; idx = slot - 12; gain = k_norm_slc; }
            else if (slot < 16) { base = vs; nh = NG; idx = slot - 14; }
            else if (slot < 18) { base = kw; nh = NG; idx = slot - 16; gain = k_norm_win; }
            else { base = vw; nh = NG; idx = slot - 18; }
            f32x4 gv[2][2];
#pragma unroll
            for (int bj = 0; bj < 2; ++bj)
#pragma unroll
                for (int n = 0; n < 2; ++n) gv[bj][n] = gain ? *(const f32x4*)(gain + 32 * bj + 8 * fq + 4 * n) * scale : (f32x4){1.f, 1.f, 1.f, 1.f};
#pragma unroll
            for (int ai = 0; ai < 2; ++ai)
#pragma unroll
                for (int m = 0; m < 4; ++m) { const int row = row0 + ai * HALF + m * 16; const float rs = rs8[ai * 4 + m]; const int b = row / SEQ, s = row % SEQ;
                    f32x4 v[2][2]; float ss = 0.f;
#pragma unroll
                    for (int bj = 0; bj < 2; ++bj)
#pragma unroll
                        for (int n = 0; n < 2; ++n) { v[bj][n] = acc[ai][bj][m][n] * rs; ss += (v[bj][n][0] * v[bj][n][0] + v[bj][n][1] * v[bj][n][1]) + (v[bj][n][2] * v[bj][n][2] + v[bj][n][3] * v[bj][n][3]); }
                    float rn = 1.f;
                    if (gain) { ss += __shfl_xor(ss, 16); ss += __shfl_xor(ss, 32); rn = rsqrtf(ss * (1.f / 64.f) + RMS_EPS); }
                    bf16_t* dst = base + (((size_t)b * nh + idx) * SEQ + s) * 64 + 8 * fq;
#pragma unroll
                    for (int bj = 0; bj < 2; ++bj) *(u32x4*)(dst + 32 * bj) = pack8(v[bj][0] * gv[bj][0] * rn, v[bj][1] * gv[bj][1] * rn); }
        } else if (pn < 7) {
#pragma unroll
            for (int ai = 0; ai < 2; ++ai)
#pragma unroll
                for (int m = 0; m < 4; ++m) { const int row = row0 + ai * HALF + m * 16; const float rs = rs8[ai * 4 + m]; const int b = row / SEQ, s = row % SEQ;
#pragma unroll
                    for (int bj = 0; bj < 2; ++bj) { const int ch0 = 256 * (pn - 5) + 128 * bj + 32 * wc + 8 * fq, g = ch0 >> 4, ci0 = ch0 & 15;
                        *(u32x4*)(acat + ((size_t)g * 512 + b * 64 + (s >> 6)) * ACAT_LD + (s & 63) * 16 + ci0) = pack8(acc[ai][bj][m][0] * rs, acc[ai][bj][m][1] * rs); } }
        } else if (pn < 15) {
            unsigned char* dstb = (unsigned char*)(pn < 11 ? sgn : sgs) + 256 * (pn - (pn < 11 ? 7 : 11)) + 32 * wc + 8 * fq;
#pragma unroll
            for (int ai = 0; ai < 2; ++ai)
#pragma unroll
                for (int m = 0; m < 4; ++m) { const int row = row0 + ai * HALF + m * 16; const float rs = rs8[ai * 4 + m];
#pragma unroll
                    for (int bj = 0; bj < 2; ++bj) { f32x4 a, b2;
#pragma unroll
                        for (int j = 0; j < 4; ++j) { a[j] = fsigmoid(acc[ai][bj][m][0][j] * rs) * 255.f + 0.5f; b2[j] = fsigmoid(acc[ai][bj][m][1][j] * rs) * 255.f + 0.5f; }
                        u32x2 w; w.x = (unsigned)a[0] | ((unsigned)a[1] << 8) | ((unsigned)a[2] << 16) | ((unsigned)a[3] << 24); w.y = (unsigned)b2[0] | ((unsigned)b2[1] << 8) | ((unsigned)b2[2] << 16) | ((unsigned)b2[3] << 24);
                        *(u32x2*)(dstb + (size_t)row * DM + 128 * bj) = w; } }
        } else {
#pragma unroll
            for (int ai = 0; ai < 2; ++ai)
#pragma unroll
                for (int m = 0; m < 4; ++m) { const int row = row0 + ai * HALF + m * 16; const float rs = rs8[ai * 4 + m];
                    if (wc == 0 && fq < 3) {
#pragma unroll
                        for (int n = 0; n < 2; ++n) { f32x4 a;
#pragma unroll
                            for (int j = 0; j < 4; ++j) a[j] = fsigmoid(acc[ai][0][m][n][j] * rs);
                            *(f32x4*)(g3 + (size_t)row * 24 + 8 * fq + 4 * n) = a; } } }
        }
    }
};
struct EpiNsa {
    static constexpr bool PERM = true, AFTER_DRAIN = false, HAS_INIT = false;
    const bf16_t* sgn; bf16_t* m1;
    __device__ __forceinline__ void operator()(const f32x4 (&acc)[2][2][4][2], const Unit& u, int wr, int wc, int fr, int fq) const {
        const int row0 = u.pm * BM + wr * 64 + fr, col0 = u.pn * BM + wc * 32 + 8 * fq;
#pragma unroll
        for (int ai = 0; ai < 2; ++ai) {
            u32x2 g[4][2];
#pragma unroll
            for (int m = 0; m < 4; ++m)
#pragma unroll
                for (int bj = 0; bj < 2; ++bj) g[m][bj] = *(const u32x2*)((const unsigned char*)sgn + (size_t)(row0 + ai * HALF + m * 16) * DM + col0 + bj * HALF);
#pragma unroll
            for (int m = 0; m < 4; ++m)
#pragma unroll
                for (int bj = 0; bj < 2; ++bj) { const size_t ix = (size_t)(row0 + ai * HALF + m * 16) * DM + col0 + bj * HALF; f32x4 ga, gb; unpack8u(g[m][bj], ga, gb);
                    *(u32x4*)(m1 + ix) = pack8(ga * acc[ai][bj][m][0], gb * acc[ai][bj][m][1]); }
        }
    }
};
struct EpiGlu {
    static constexpr bool PERM = true, AFTER_DRAIN = false, HAS_INIT = false;
    const bf16_t* sgs; const bf16_t* m1; bf16_t* merged;
    __device__ __forceinline__ void operator()(const f32x4 (&acc)[2][2][4][2], const Unit& u, int wr, int wc, int fr, int fq) const {
        const int row0 = u.pm * BM + wr * 64 + fr, col0 = u.pn * HALF + wc * 32 + 8 * fq;
#pragma unroll
        for (int ai = 0; ai < 2; ++ai) {
            u32x2 gs[4]; u32x4 mm[4];
#pragma unroll
            for (int m = 0; m < 4; ++m) { const size_t ix = (size_t)(row0 + ai * HALF + m * 16) * DM + col0; gs[m] = *(const u32x2*)((const unsigned char*)sgs + ix); mm[m] = *(const u32x4*)(m1 + ix); }
#pragma unroll
            for (int m = 0; m < 4; ++m) { const size_t ix = (size_t)(row0 + ai * HALF + m * 16) * DM + col0;
                f32x4 ga, gb, ma, mb; unpack8u(gs[m], ga, gb); unpack8(mm[m], ma, mb);
                f32x4 oa, ob;
#pragma unroll
                for (int j = 0; j < 4; ++j) { oa[j] = ma[j] + ga[j] * acc[ai][0][m][0][j] * fsigmoid(acc[ai][1][m][0][j]); ob[j] = mb[j] + gb[j] * acc[ai][0][m][1][j] * fsigmoid(acc[ai][1][m][1][j]); }
                *(u32x4*)(merged + ix) = pack8(oa, ob); }
        }
    }
};
struct EpiCmp1 {
    static constexpr bool PERM = true, AFTER_DRAIN = false, HAS_INIT = false;
    bf16_t* hid; const float* biasp;
    __device__ __forceinline__ void operator()(const f32x4 (&acc)[2][2][4][2], const Unit& u, int wr, int wc, int fr, int fq) const {
        const int row0 = u.pm * BM + wr * 64 + fr, col0 = wc * 32 + 8 * fq;
        f32x4 bv[2][2];
#pragma unroll
        for (int bj = 0; bj < 2; ++bj)
#pragma unroll
            for (int n = 0; n < 2; ++n) { f32x4 s = {0.f, 0.f, 0.f, 0.f};
#pragma unroll
                for (int k = 0; k < 8; ++k) s += *(const f32x4*)(biasp + ((size_t)u.pg * 8 + k) * 256 + col0 + bj * HALF + 4 * n);
                bv[bj][n] = s; }
#pragma unroll
        for (int ai = 0; ai < 2; ++ai)
#pragma unroll
            for (int m = 0; m < 4; ++m) { const int row = row0 + ai * HALF + m * 16;
#pragma unroll
                for (int bj = 0; bj < 2; ++bj) { f32x4 a, b2;
#pragma unroll
                    for (int j = 0; j < 4; ++j) { a[j] = fgelu_tanh(acc[ai][bj][m][0][j] + bv[bj][0][j]); b2[j] = fgelu_tanh(acc[ai][bj][m][1][j] + bv[bj][1][j]); }
                    *(u32x4*)(hid + ((size_t)u.pg * 4096 + row) * 256 + col0 + bj * HALF) = pack8(a, b2); } }
    }
};
struct EpiSst {
    static constexpr bool PERM = false, AFTER_DRAIN = false, HAS_INIT = false;
    float* S;
    __device__ __forceinline__ void operator()(const f32x4 (&acc)[2][2][4][2], const Unit& u, int wr, int wc, int fr, int fq) const {
        const int row0 = u.pm * BM + wr * 64 + fr, col0 = wc * 32 + 4 * fq;
#pragma unroll
        for (int ai = 0; ai < 2; ++ai)
#pragma unroll
            for (int m = 0; m < 4; ++m) { float* rp = S + ((size_t)u.pg * 512 + row0 + ai * HALF + m * 16) * 128 + col0;
#pragma unroll
                for (int n = 0; n < 2; ++n) *(f32x4*)(rp + 16 * n) = acc[ai][0][m][n]; }
    }
};
struct EpiSsmOut {
    static constexpr bool PERM = true, AFTER_DRAIN = false, HAS_INIT = false;
    const bf16_t* acat; const float* dskip; bf16_t* geluy;
    __device__ __forceinline__ void operator()(const f32x4 (&acc)[2][2][4][2], const Unit& u, int wr, int wc, int fr, int fq) const {
        const int g = u.pg, row0 = u.pm * BM + wr * 64 + fr;
        f32x4 dv[2];
#pragma unroll
        for (int bj = 0; bj < 2; ++bj) { }
        const int co0 = 8 * (fq & 1);
        dv[0] = *(const f32x4*)(dskip + g * 16 + co0); dv[1] = *(const f32x4*)(dskip + g * 16 + co0 + 4);
#pragma unroll
        for (int ai = 0; ai < 2; ++ai) {
            u32x4 uu[4][2];
#pragma unroll
            for (int m = 0; m < 4; ++m)
#pragma unroll
                for (int bj = 0; bj < 2; ++bj) uu[m][bj] = *(const u32x4*)(acat + ((size_t)g * 512 + row0 + ai * HALF + m * 16) * ACAT_LD + u.pn * BM + bj * HALF + wc * 32 + 8 * fq);
#pragma unroll
            for (int m = 0; m < 4; ++m) { const int rr = row0 + ai * HALF + m * 16, b = rr >> 6, c = rr & 63;
#pragma unroll
                for (int bj = 0; bj < 2; ++bj) { const int col = u.pn * BM + bj * HALF + wc * 32 + 8 * fq, i = col >> 4;
                    f32x4 ua, ub; unpack8(uu[m][bj], ua, ub);
                    f32x4 ya = acc[ai][bj][m][0] + dv[0] * ua, yb = acc[ai][bj][m][1] + dv[1] * ub;
#pragma unroll
                    for (int j = 0; j < 4; ++j) { ya[j] = fgelu_tanh(ya[j]); yb[j] = fgelu_tanh(yb[j]); }
                    *(u32x4*)(geluy + ((size_t)b * SEQ + 64 * c + i) * 512 + 16 * g + co0) = pack8(ya, yb); } }
        }
    }
};
}

constexpr int NWAVES = 8;
constexpr int RING_OFF = 0, RING_BYTES = 131072;
constexpr int LDS_BYTES = 163840;
constexpr int LDSCTL_OFF = LDS_BYTES - 512, MISC_OFF = LDSCTL_OFF + 320;
constexpr int CW_TMO = 0, CW_CODE = 1, CW_TOEP = 64, CW_BAR = 4096;

#define GAS __attribute__((address_space(1)))
#define LAS __attribute__((address_space(3)))
typedef unsigned v4u __attribute__((ext_vector_type(4)));
typedef float f32x4 __attribute__((ext_vector_type(4)));
typedef GAS unsigned gu32;
#define RLX_AGENT __ATOMIC_RELAXED, __HIP_MEMORY_SCOPE_AGENT
#define LDS_WAIT() asm volatile("s_waitcnt lgkmcnt(0)" ::: "memory")
#define VM_WAIT() asm volatile("s_waitcnt vmcnt(0)" ::: "memory")

#define XB_TMO      128
#define XB_XCNT(j)  (256  + 64 * (j))
#define XB_XSUB(j)  (1280 + 64 * (j))
#define XB_XGEN(j)  (2304 + 64 * (j))
#define XB_TOP      3328
#define XB_TOPGEN   3392
#define XCD_BAR_WORDS 3456
#define XB_SPIN_CAP (1u << 18)
__device__ __forceinline__ unsigned xb_ld(unsigned* p)              { return __hip_atomic_load(p, __ATOMIC_RELAXED, __HIP_MEMORY_SCOPE_AGENT); }
__device__ __forceinline__ unsigned xb_add(unsigned* p, unsigned v) { return __hip_atomic_fetch_add(p, v, __ATOMIC_RELAXED, __HIP_MEMORY_SCOPE_AGENT); }
__device__ __forceinline__ unsigned xb_xcc_id() { return (unsigned)__builtin_amdgcn_s_getreg((3 << 11) | 20) & 0xFu; }
#define XB_SPIN(cond, bar) do { unsigned _sp = 0; while (cond) { __builtin_amdgcn_s_sleep(1); \
    if ((++_sp & 255u) == 0u) { if (xb_ld(&(bar)[XB_TMO])) break; if (_sp > XB_SPIN_CAP) { atomicAdd(&(bar)[XB_TMO], 1u); break; } } } } while (0)
struct XcdBarrier { unsigned* bar; unsigned x; volatile LAS unsigned* st; };
__device__ __forceinline__ XcdBarrier xcd_barrier_post(unsigned* bar, volatile LAS unsigned* st) {
    XcdBarrier b; b.bar = bar; b.x = xb_xcc_id(); b.st = st;
    if (threadIdx.x == 0) (void)xb_add(&bar[XB_XCNT(b.x)], 1u);
    return b;
}
__device__ __forceinline__ void xcd_barrier_complete(unsigned* bar, unsigned x, unsigned& nloc, unsigned& nx) {
    const unsigned G = gridDim.x * gridDim.y * gridDim.z;
    unsigned sum, cnt, mine, sp = 0u;
    for (;;) {
        sum = 0u; cnt = 0u; mine = 0u;
#pragma unroll
        for (unsigned j = 0; j < 16; ++j) { const unsigned c = xb_ld(&bar[XB_XCNT(j)]); sum += c; cnt += (c > 0u) ? 1u : 0u; mine = (j == x) ? c : mine; }
        if (sum == G) break;
        __builtin_amdgcn_s_sleep(1);
        if ((++sp & 255u) == 0u) { if (xb_ld(&bar[XB_TMO])) break; if (sp > XB_SPIN_CAP) { atomicAdd(&bar[XB_TMO], 1u); break; } }
    }
    nloc = mine > 0u ? mine : 1u; nx = cnt > 0u ? cnt : 1u;
}
__device__ __forceinline__ void xcd_barrier(const XcdBarrier& b) {
    asm volatile("s_waitcnt vmcnt(0)" ::: "memory");
    __syncthreads();
    if (threadIdx.x == 0) {
        unsigned* bar = b.bar;
        __builtin_amdgcn_s_waitcnt(0);
        unsigned nloc = b.st[0], nx = b.st[1];
        if (nloc == 0u) { xcd_barrier_complete(bar, b.x, nloc, nx); b.st[0] = nloc; b.st[1] = nx; }
        const unsigned old = xb_add(&bar[XB_XSUB(b.x)], 1u);
        const unsigned gen = old / nloc;
        if (old + 1u == (gen + 1u) * nloc) {
            __builtin_amdgcn_fence(__ATOMIC_RELEASE, "agent");
            asm volatile("s_waitcnt vmcnt(0)" ::: "memory");
            const unsigned og = xb_add(&bar[XB_TOP], 1u);
            const unsigned tg = og / nx;
            if (og + 1u == (tg + 1u) * nx) xb_add(&bar[XB_TOPGEN], 1u);
            else XB_SPIN(xb_ld(&bar[XB_TOPGEN]) == tg, bar);
            __builtin_amdgcn_fence(__ATOMIC_ACQUIRE, "agent");
            xb_add(&bar[XB_XGEN(b.x)], 1u);
            asm volatile("s_waitcnt vmcnt(0)" ::: "memory");
        } else {
            XB_SPIN(xb_ld(&bar[XB_XGEN(b.x)]) == gen, bar);
            __builtin_amdgcn_fence(__ATOMIC_ACQUIRE, "agent");
            asm volatile("s_waitcnt vmcnt(0)" ::: "memory");
        }
    }
    __syncthreads();
}

struct Args { const float* in[32]; float* out; unsigned char* ws; int ph_lo, ph_hi, fused, pad; };
struct Frame {
    LAS unsigned char* lds; volatile LAS unsigned* MISC; gu32* ctl;
    int tid, lane, wave, vcu, G;
};
enum Phase { PH_PRO = 0, PH_F1GU, PH_F1D, PH_WIN, PH_MIDA, PH_MIDB, PH_NSA, PH_GLU, PH_WOUT, PH_F2GU, PH_F2D, NPH };

template <class MAP>
__device__ __forceinline__ void transpose_item(const float* W, int ldw, bf16_t* WT, int ldt, int k0, int n0, const MAP& srccol, LAS float* scr, int lane, const float* rowscale = nullptr) {
    const int n4 = (lane & 7) * 4, sc = srccol(n0 + n4), kr = lane >> 3;
    f32x4 v[8];
#pragma unroll
    for (int i = 0; i < 8; ++i) v[i] = sc >= 0 ? *(const f32x4*)(W + (size_t)(k0 + kr + 8 * i) * ldw + sc) : (f32x4){0.f, 0.f, 0.f, 0.f};
    if (rowscale) {
#pragma unroll
        for (int i = 0; i < 8; ++i) v[i] = v[i] * rowscale[k0 + kr + 8 * i];
    }
#pragma unroll
    for (int i = 0; i < 8; ++i) { LAS float* d = scr + (kr + 8 * i) * 33 + n4; d[0] = v[i][0]; d[1] = v[i][1]; d[2] = v[i][2]; d[3] = v[i][3]; }
    LDS_WAIT(); asm volatile("" ::: "memory");
    const int c = lane & 7;
#pragma unroll
    for (int j = 0; j < 4; ++j) { const int n = (lane >> 3) + 8 * j; const LAS float* s = scr + (8 * c) * 33 + n;
        v4u o; o.x = pk2(s[0 * 33], s[1 * 33]); o.y = pk2(s[2 * 33], s[3 * 33]); o.z = pk2(s[4 * 33], s[5 * 33]); o.w = pk2(s[6 * 33], s[7 * 33]);
        *(GAS v4u*)(WT + (size_t)(n0 + n) * ldt + k0 + 8 * c) = o; }
    LDS_WAIT(); asm volatile("" ::: "memory");
}
__device__ __forceinline__ void prep_row2(const float* x0, const float* x1, const float* g, bf16_t* o0, bf16_t* o1, float* q0, float* q1, int lane) {
    const GAS f32x4* xa = (const GAS f32x4*)x0 + lane; const GAS f32x4* xb = (const GAS f32x4*)x1 + lane; (void)g;
    f32x4 va[4], vb[4];
#pragma unroll
    for (int j = 0; j < 4; ++j) { va[j] = xa[64 * j]; vb[j] = xb[64 * j]; }
    GAS unsigned long long* oa = (GAS unsigned long long*)o0 + lane; GAS unsigned long long* ob = (GAS unsigned long long*)o1 + lane;
    float sa = 0.f, sb = 0.f;
#pragma unroll
    for (int j = 0; j < 4; ++j) { const f32x4 a = va[j], b = vb[j];
        sa += (a.x * a.x + a.y * a.y) + (a.z * a.z + a.w * a.w); sb += (b.x * b.x + b.y * b.y) + (b.z * b.z + b.w * b.w);
        oa[64 * j] = (unsigned long long)pk2(a.x, a.y) | ((unsigned long long)pk2(a.z, a.w) << 32);
        ob[64 * j] = (unsigned long long)pk2(b.x, b.y) | ((unsigned long long)pk2(b.z, b.w) << 32); }
    sa = wave_sum(sa); sb = wave_sum(sb);
    if (lane < 16) { q0[lane] = (lane == 0) ? sa : 0.f; q1[lane] = (lane == 0) ? sb : 0.f; }
}
__device__ __forceinline__ void prep_row(const float* xrow, const float* g, bf16_t* orow, float* ssqrow, int lane) {
    const GAS f32x4* xr = (const GAS f32x4*)xrow + lane; const GAS f32x4* gr = (const GAS f32x4*)g + lane;
    GAS unsigned long long* o8 = (GAS unsigned long long*)orow + lane;
    float s = 0.f;
#pragma unroll
    for (int j = 0; j < 4; ++j) { const f32x4 v = xr[64 * j], gg = gr[64 * j]; s += (v.x * v.x + v.y * v.y) + (v.z * v.z + v.w * v.w);
        o8[64 * j] = (unsigned long long)pk2(v.x * gg.x, v.y * gg.y) | ((unsigned long long)pk2(v.z * gg.z, v.w * gg.w) << 32); }
    s = wave_sum(s);
    if (lane < 16) ssqrow[lane] = (lane == 0) ? s : 0.f;
}

struct Cplx { double r, i; };
__device__ __forceinline__ Cplx cmul(Cplx a, Cplx b) { return Cplx{a.r * b.r - a.i * b.i, a.r * b.i + a.i * b.r}; }
__device__ __forceinline__ Cplx apow(double lr, double li, double step, double e) { const double m = exp(lr * step * e), ang = li * step * e; return Cplx{m * cos(ang), m * sin(ang)}; }

__device__ __forceinline__ void ssm_weights_task(const Args& a, int g, int i, int lane, LAS float* scr) {
    unsigned char* ws = a.ws;
    const int p = lane;
    const double lr = a.in[18][g * 64 + p], li = a.in[19][g * 64 + p], step = exp((double)a.in[20][g]);
    const Cplx a1 = apow(lr, li, step, 1.0);
    const double den = lr * lr + li * li;
    const Cplx coef{((a1.r - 1.0) * lr + a1.i * li) / den, (a1.i * lr - (a1.r - 1.0) * li) / den};
    const Cplx ab = apow(lr, li, step, (double)(63 - i)), ac = apow(lr, li, step, (double)i), ad = apow(lr, li, step, (double)(i + 1));
    float zr[16], zi[16];
    bf16_t* w1s = (bf16_t*)(ws + WS_W1S) + ((size_t)g * 128) * 1024;
    {
        unsigned pr[8], pi[8];
#pragma unroll
        for (int c = 0; c < 16; ++c) { const Cplx bb = cmul(coef, Cplx{(double)a.in[21][(g * 64 + p) * 16 + c], (double)a.in[22][(g * 64 + p) * 16 + c]});
            const Cplx zb = cmul(ab, bb), zc = cmul(ac, bb); zr[c] = (float)zc.r; zi[c] = (float)zc.i;
            const unsigned br = f2bf((float)zb.r), bi = f2bf((float)zb.i);
            if (c & 1) { pr[c >> 1] |= br << 16; pi[c >> 1] |= bi << 16; } else { pr[c >> 1] = br; pi[c >> 1] = bi; } }
        v4u* dr = (v4u*)(w1s + (size_t)p * 1024 + i * 16); v4u* di = (v4u*)(w1s + (size_t)(64 + p) * 1024 + i * 16);
        dr[0] = (v4u){pr[0], pr[1], pr[2], pr[3]}; dr[1] = (v4u){pr[4], pr[5], pr[6], pr[7]};
        di[0] = (v4u){pi[0], pi[1], pi[2], pi[3]}; di[1] = (v4u){pi[4], pi[5], pi[6], pi[7]};
    }
#pragma unroll
    for (int c = 0; c < 16; ++c) { scr[p * 16 + c] = zr[c]; scr[1024 + p * 16 + c] = zi[c]; }
    LDS_WAIT(); asm volatile("" ::: "memory");
    {
        const int co = lane >> 2, c4 = (lane & 3) * 4;
        f32x4 acc = {0.f, 0.f, 0.f, 0.f};
        for (int pp = 0; pp < 64; ++pp) { const float cr = a.in[23][(g * 16 + co) * 64 + pp], cm = a.in[24][(g * 16 + co) * 64 + pp];
            const f32x4 r4 = *(const LAS f32x4*)(scr + pp * 16 + c4), i4 = *(const LAS f32x4*)(scr + 1024 + pp * 16 + c4);
            acc += r4 * cr - i4 * cm; }
        *(f32x4*)((float*)(ws + WS_KTAB) + (((size_t)g * 64 + i) * 16 + co) * 16 + c4) = acc;
    }
    LDS_WAIT(); asm volatile("" ::: "memory");
    bf16_t* wt = (bf16_t*)(ws + WS_WTOEP) + ((size_t)g * 1024 + i * 16) * ACAT_LD + 1024;
#pragma unroll 4
    for (int co = 0; co < 16; ++co) { const Cplx z = cmul(Cplx{(double)a.in[23][(g * 16 + co) * 64 + p], (double)a.in[24][(g * 16 + co) * 64 + p]}, ad);
        wt[(size_t)co * ACAT_LD + p] = f2bf((float)z.r); wt[(size_t)co * ACAT_LD + 64 + p] = f2bf((float)(-z.i)); }
}
__device__ __forceinline__ void toep_row(unsigned char* ws, int row, int lane) {
    const int g = row >> 10, i = (row >> 4) & 63, co = row & 15, ip = lane;
    bf16_t* dst = (bf16_t*)(ws + WS_WTOEP) + (size_t)row * ACAT_LD + ip * 16;
    v4u o0 = {0u, 0u, 0u, 0u}, o1 = {0u, 0u, 0u, 0u};
    if (ip <= i) { const f32x4* k = (const f32x4*)((const float*)(ws + WS_KTAB) + (((size_t)g * 64 + (i - ip)) * 16 + co) * 16);
        const f32x4 k0 = k[0], k1 = k[1], k2 = k[2], k3 = k[3];
        o0 = (v4u){pk2(k0[0], k0[1]), pk2(k0[2], k0[3]), pk2(k1[0], k1[1]), pk2(k1[2], k1[3])};
        o1 = (v4u){pk2(k2[0], k2[1]), pk2(k2[2], k2[3]), pk2(k3[0], k3[1]), pk2(k3[2], k3[3])}; }
    ((v4u*)dst)[0] = o0; ((v4u*)dst)[1] = o1;
}
__device__ __forceinline__ void ssm_carry_scan(const Args& a, int g, int pm, int tid) {
    if (tid >= 256) return;
    unsigned char* ws = a.ws;
    const int bl = tid >> 6, p = tid & 63, b = 4 * pm + bl;
    const double lr = a.in[18][g * 64 + p], li = a.in[19][g * 64 + p], step = exp((double)a.in[20][g]);
    const Cplx a64 = apow(lr, li, step, 64.0); const float ar = (float)a64.r, ai = (float)a64.i;
    const float* S = (const float*)(ws + WS_SST) + ((size_t)g * 512 + b * 64) * 128;
    bf16_t* X = (bf16_t*)(ws + WS_ACAT) + ((size_t)g * 512 + b * 64) * ACAT_LD + 1024;
    float xr = 0.f, xi = 0.f;
#pragma unroll 8
    for (int c = 0; c < 64; ++c) {
        X[(size_t)c * ACAT_LD + p] = f2bf(xr); X[(size_t)c * ACAT_LD + 64 + p] = f2bf(xi);
        const float sr = S[c * 128 + p], si = S[c * 128 + 64 + p];
        const float nr = ar * xr - ai * xi + sr, ni = ar * xi + ai * xr + si; xr = nr; xi = ni;
    }
}
namespace nsa {
typedef short bf16x8 __attribute__((ext_vector_type(8)));
typedef short s16x4 __attribute__((ext_vector_type(4)));
typedef float f32x16 __attribute__((ext_vector_type(16)));
typedef unsigned u32x4 __attribute__((ext_vector_type(4)));
typedef LAS const char* lds_cptr;
constexpr int SLOTB = 8192;
constexpr int L_K = 0, L_V = 2 * SLOTB, L_WSF = 4 * SLOTB, L_IMP = L_WSF + 8 * 256, L_SEL = L_IMP + 64 * 65 * 4, L_UNI = L_SEL + 64 * 8, L_TL = L_UNI + 64, L_OACC = L_TL + 512, L_QF = L_OACC + 8 * 8192, L_GT = L_QF + 8 * 4096, L_DUMP = L_GT + 8 * 3 * 64 * 4, L_END = L_DUMP + 1024;
static_assert(L_END <= LDSCTL_OFF && L_QF % 16 == 0, "attention LDS map");
__device__ __forceinline__ int crow(int r, int hi) { return (r & 3) + 8 * (r >> 2) + 4 * hi; }
#define NSA_MFMA(a, b, c) __builtin_amdgcn_mfma_f32_32x32x16_bf16(a, b, c, 0, 0, 0)
enum { M_NONE = 0, M_CAUSAL = 1, M_WINLO = 2, M_CMP = 3, M_SEL = 4, M_SELCAUSAL = 5 };

struct Ctx {
    LAS unsigned char* lds; int wid, lane, r32, hi, th, hh;
};
__device__ __forceinline__ void glds16(const void* gsrc, unsigned lds_dst) { unsigned keep;
    asm volatile("s_mov_b32 %0, m0\n\ts_mov_b32 m0, %2\n\ts_nop 0\n\tglobal_load_lds_dwordx4 %1, off\n\ts_mov_b32 m0, %0" : "=&s"(keep) : "v"(gsrc), "s"(lds_dst) : "memory"); }
__device__ __forceinline__ unsigned lds_addr(const Ctx& c, int off) { return (unsigned)__builtin_amdgcn_readfirstlane((int)(unsigned)(uintptr_t)c.lds + off); }
__device__ __forceinline__ int koff(int i) { return i < 2 ? L_K + i * SLOTB : L_IMP; }
__device__ __forceinline__ int voff(int i) { return i < 2 ? L_V + i * SLOTB : L_IMP + SLOTB; }
__device__ __forceinline__ void dma_kv(const Ctx& c, const bf16_t* Kt, const bf16_t* Vt, int s) {
    const int krow_ = c.wid * 8 + (c.lane >> 3);
    const bf16_t* ks = Kt + krow_ * 64 + ((c.lane & 7) ^ ((krow_ >> 1) & 7)) * 8;
    const bf16_t* vs = Vt + (16 * (c.wid & 3) + (c.lane >> 2)) * 64 + (c.wid >> 2) * 32 + (c.lane & 3) * 8;
    glds16(ks, lds_addr(c, koff(s) + c.wid * 1024));
    glds16(vs, lds_addr(c, voff(s) + c.wid * 1024));
}
__device__ __forceinline__ void dma_v(const Ctx& c, const bf16_t* Vt, int s) {
    const bf16_t* vs = Vt + (16 * (c.wid & 3) + (c.lane >> 2)) * 64 + (c.wid >> 2) * 32 + (c.lane & 3) * 8;
    glds16(vs, lds_addr(c, voff(s) + c.wid * 1024));
}
__device__ __forceinline__ void dma_k(const Ctx& c, const bf16_t* Kt, int s) {
    const int krow_ = c.wid * 8 + (c.lane >> 3);
    const bf16_t* ks = Kt + krow_ * 64 + ((c.lane & 7) ^ ((krow_ >> 1) & 7)) * 8;
    glds16(ks, lds_addr(c, koff(s) + c.wid * 1024));
}
__device__ __forceinline__ void prefetch_tile(const Ctx& c, const bf16_t* t) { glds16(t + c.wid * 512 + c.lane * 8, lds_addr(c, L_DUMP)); }
#define NSA_WAITBAR2() asm volatile("s_waitcnt vmcnt(2) lgkmcnt(0)\n\ts_barrier" ::: "memory")
#define NSA_WAITBAR() asm volatile("s_waitcnt vmcnt(0) lgkmcnt(0)\n\ts_barrier" ::: "memory")

__device__ __forceinline__ int kfrag_off(const Ctx& c, int d0) { return c.r32 * 128 + (((2 * d0 + c.hi) ^ ((c.r32 >> 1) & 7)) << 4); }
__device__ __forceinline__ void qkt(f32x16& p0, f32x16& p1, const Ctx& c, int s, const bf16x8 (&qr)[4]) {
    const lds_cptr kb = (lds_cptr)(c.lds + koff(s));
    p0 = f32x16{}; p1 = f32x16{};
#pragma unroll
    for (int d0 = 0; d0 < 4; ++d0) {
        const int ko = kfrag_off(c, d0);
        const bf16x8 b0 = *(const LAS bf16x8*)(kb + ko), b1 = *(const LAS bf16x8*)(kb + ko + 4096);
        p0 = NSA_MFMA(b0, qr[d0], p0); p1 = NSA_MFMA(b1, qr[d0], p1);
    }
}
__device__ __forceinline__ s16x4 vtr(lds_cptr p) { typedef short v4i16_t __attribute__((ext_vector_type(4))); return __builtin_bit_cast(s16x4, __builtin_amdgcn_ds_read_tr16_b64_v4i16((LAS v4i16_t*)p)); }
__device__ __forceinline__ void pv(f32x16 (&o)[2], const Ctx& c, int s, const bf16x8 (&pa)[4]) {
    const lds_cptr vp = (lds_cptr)(c.lds + voff(s)) + ((c.lane >> 4) & 1) * 32 + (c.lane & 3) * 8 + (4 * c.hi + ((c.lane & 15) >> 2)) * 64;
#pragma unroll
    for (int d0 = 0; d0 < 2; ++d0) {
        s16x4 lo[4], hh[4];
#pragma unroll
        for (int ks = 0; ks < 4; ++ks) { lo[ks] = vtr(vp + d0 * 4096 + ks * 1024); hh[ks] = vtr(vp + d0 * 4096 + ks * 1024 + 512); }
        __builtin_amdgcn_sched_barrier(0);
#pragma unroll
        for (int ks = 0; ks < 4; ++ks) { const bf16x8 vf = {lo[ks][0], lo[ks][1], lo[ks][2], lo[ks][3], hh[ks][0], hh[ks][1], hh[ks][2], hh[ks][3]}; o[d0] = NSA_MFMA(pa[ks], vf, o[d0]); }
        __builtin_amdgcn_sched_barrier(0);
    }
}
__device__ __forceinline__ float rowmax32(const f32x16& p0, const f32x16& p1) {
    float a = fmaxf(p0[0], p1[0]);
#pragma unroll
    for (int r = 1; r < 16; ++r) a = fmaxf(a, fmaxf(p0[r], p1[r]));
    return fmaxf(a, __shfl_xor(a, 32));
}
__device__ __forceinline__ unsigned cvtpk(float lo, float hi) { return pg8::cvt_pk_bf16(lo, hi); }
__device__ __forceinline__ void pack_p(bf16x8 (&pa)[4], const f32x16& p0, const f32x16& p1) {
    pa[0] = __builtin_bit_cast(bf16x8, (u32x4){cvtpk(p0[0], p0[1]), cvtpk(p0[2], p0[3]), cvtpk(p0[4], p0[5]), cvtpk(p0[6], p0[7])});
    pa[1] = __builtin_bit_cast(bf16x8, (u32x4){cvtpk(p0[8], p0[9]), cvtpk(p0[10], p0[11]), cvtpk(p0[12], p0[13]), cvtpk(p0[14], p0[15])});
    pa[2] = __builtin_bit_cast(bf16x8, (u32x4){cvtpk(p1[0], p1[1]), cvtpk(p1[2], p1[3]), cvtpk(p1[4], p1[5]), cvtpk(p1[6], p1[7])});
    pa[3] = __builtin_bit_cast(bf16x8, (u32x4){cvtpk(p1[8], p1[9]), cvtpk(p1[10], p1[11]), cvtpk(p1[12], p1[13]), cvtpk(p1[14], p1[15])});
}
template <int MODE>
__device__ __forceinline__ void apply_mask(f32x16& p0, f32x16& p1, int hi, int ql, int lim, bool rowsel) {
    if (MODE == M_NONE) return;
    const float NEG = -INFINITY;
    const int qh = ql - 4 * hi, lh = lim - 4 * hi;
#pragma unroll
    for (int r = 0; r < 16; ++r) {
        const int kc = (r & 3) + 8 * (r >> 2);
        bool v0 = true, v1 = true;
        if (MODE == M_CAUSAL || MODE == M_SELCAUSAL) { v0 = kc <= qh; v1 = kc + 32 <= qh; }
        if (MODE == M_WINLO) { v0 = kc > qh; v1 = kc + 32 > qh; }
        if (MODE == M_CMP) { v0 = kc <= lh; v1 = kc + 32 <= lh; }
        if (MODE == M_SEL || MODE == M_SELCAUSAL) { v0 = v0 && rowsel; v1 = v1 && rowsel; }
        if (!v0) p0[r] = NEG; if (!v1) p1[r] = NEG;
    }
}
struct Sm { float m, l; };
__device__ __forceinline__ float rowmax32_3(const f32x16& p0, const f32x16& p1) {
    float a = __builtin_fmaxf(__builtin_fmaxf(p0[0], p0[1]), p1[0]), b = __builtin_fmaxf(__builtin_fmaxf(p0[2], p0[3]), p1[1]);
    a = __builtin_fmaxf(__builtin_fmaxf(a, p1[2]), p1[3]);
#pragma unroll
    for (int r = 4; r < 16; r += 4) { a = __builtin_fmaxf(__builtin_fmaxf(a, p0[r]), p0[r + 1]); b = __builtin_fmaxf(__builtin_fmaxf(b, p0[r + 2]), p0[r + 3]);
        a = __builtin_fmaxf(__builtin_fmaxf(a, p1[r]), p1[r + 1]); b = __builtin_fmaxf(__builtin_fmaxf(b, p1[r + 2]), p1[r + 3]); }
    a = __builtin_fmaxf(a, b);
    return __builtin_fmaxf(a, __shfl_xor(a, 32));
}
constexpr float RESCALE_THR = 8.0f;
#define SGB(mask, n) __builtin_amdgcn_sched_group_barrier(mask, n, 0)
__device__ __forceinline__ void rescale_rows(Sm& st, f32x16 (&o)[2], f32x16& p0, f32x16& p1, const Ctx& c, float rm, bool first) {
    const float dl = first ? (rm > -INFINITY ? rm : 0.f) : __builtin_fmaxf(rm, 0.f), f = __builtin_amdgcn_exp2f(-dl);
    st.m += dl; st.l *= f;
#pragma unroll
    for (int r = 0; r < 16; ++r) { p0[r] -= dl; p1[r] -= dl; }
    LAS float* wsf = (LAS float*)(c.lds + L_WSF) + c.wid * 64;
    if (c.hi == 0) wsf[c.r32] = f;
    const LAS float* wsh = wsf + 4 * c.hi;
#pragma unroll
    for (int r = 0; r < 16; ++r) { const float fr_ = wsh[(r & 3) + 8 * (r >> 2)]; o[0][r] *= fr_; o[1][r] *= fr_; }
}
template <int DBG = 0>
__device__ __forceinline__ void exp_sum_pack(Sm& st, f32x16& p0, f32x16& p1, bf16x8 (&pa)[4]) {
    float sum = 0.f;
#pragma unroll
    for (int r = 0; r < 16; ++r) { if (!(DBG & 1)) { p0[r] = __builtin_amdgcn_exp2f(p0[r]); p1[r] = __builtin_amdgcn_exp2f(p1[r]); } sum += p0[r] + p1[r]; }
    st.l += sum;
    pack_p(pa, p0, p1);
}
__device__ __forceinline__ void read_kf(bf16x8 (&kf)[8], const Ctx& c, int ks) {
    const lds_cptr kb = (lds_cptr)(c.lds + koff(ks));
#pragma unroll
    for (int d0 = 0; d0 < 4; ++d0) { const int ko = kfrag_off(c, d0); kf[2 * d0] = *(const LAS bf16x8*)(kb + ko); kf[2 * d0 + 1] = *(const LAS bf16x8*)(kb + ko + 4096); }
}
__device__ __forceinline__ void read_vf(s16x4 (&vf)[16], const Ctx& c, int vs) {
    const lds_cptr vp = (lds_cptr)(c.lds + voff(vs)) + ((c.lane >> 4) & 1) * 32 + (c.lane & 3) * 8 + (4 * c.hi + ((c.lane & 15) >> 2)) * 64;
#pragma unroll
    for (int i = 0; i < 8; ++i) { vf[2 * i] = vtr(vp + (i >> 2) * 4096 + (i & 3) * 1024); vf[2 * i + 1] = vtr(vp + (i >> 2) * 4096 + (i & 3) * 1024 + 512); }
}
template <int DBG = 0>
__device__ __forceinline__ void block_b(f32x16& n0, f32x16& n1, const Ctx& c, const bf16x8 (&kf)[8], const bf16x8 (&qr)[4], s16x4 (&vf)[16], int vs, float cinit, Sm& st, f32x16& p0, f32x16& p1, bf16x8 (&pa)[4]) {
    read_vf(vf, c, vs);
    f32x16 cv;
#pragma unroll
    for (int r = 0; r < 16; ++r) cv[r] = cinit;
#pragma unroll
    for (int d0 = 0; d0 < 4; ++d0) { n0 = NSA_MFMA(kf[2 * d0], qr[d0], d0 == 0 ? cv : n0); n1 = NSA_MFMA(kf[2 * d0 + 1], qr[d0], d0 == 0 ? cv : n1); }
    exp_sum_pack<DBG>(st, p0, p1, pa);
}
template <bool HASN, int DBG = 0, bool NORESC = false>
__device__ __forceinline__ float block_c(f32x16 (&o)[2], const Ctx& c, const s16x4 (&vf)[16], const bf16x8 (&pa)[4], const f32x16& n0, const f32x16& n1, bf16x8 (&kf)[8], int ks2) {
    if (HASN) { if (ks2 >= 0) read_kf(kf, c, ks2); }
    float rm = -INFINITY;
#pragma unroll
    for (int i = 0; i < 8; ++i) { const bf16x8 v8 = {vf[2 * i][0], vf[2 * i][1], vf[2 * i][2], vf[2 * i][3], vf[2 * i + 1][0], vf[2 * i + 1][1], vf[2 * i + 1][2], vf[2 * i + 1][3]}; o[i >> 2] = NSA_MFMA(pa[i & 3], v8, o[i >> 2]); }
    if (HASN && !NORESC) rm = rowmax32_3(n0, n1);
    return rm;
}
#undef SGB
__device__ __forceinline__ void qk_first(f32x16& p0, f32x16& p1, const Ctx& c, int s, float cinit, int mode, int ql) {
    const lds_cptr kb = (lds_cptr)(c.lds + koff(s));
    const lds_cptr qb_ = (lds_cptr)(c.lds + L_QF + c.wid * 4096) + c.hi * 512 + c.r32 * 16;
    bf16x8 qr[4];
#pragma unroll
    for (int d0 = 0; d0 < 4; ++d0) qr[d0] = *(const LAS bf16x8*)(qb_ + d0 * 1024);
#pragma unroll
    for (int r = 0; r < 16; ++r) { p0[r] = cinit; p1[r] = cinit; }
#pragma unroll
    for (int d0 = 0; d0 < 4; ++d0) { const int ko = kfrag_off(c, d0); const bf16x8 b0 = *(const LAS bf16x8*)(kb + ko), b1 = *(const LAS bf16x8*)(kb + ko + 4096); p0 = NSA_MFMA(b0, qr[d0], p0); p1 = NSA_MFMA(b1, qr[d0], p1); }
    if (mode == M_CAUSAL) apply_mask<M_CAUSAL>(p0, p1, c.hi, ql, 0, true); else if (mode == M_WINLO) apply_mask<M_WINLO>(p0, p1, c.hi, ql, 0, true);
}
__device__ __forceinline__ void sm_stats(Sm& st, const Ctx& c, int s, const bf16x8 (&qr)[4], int lim) {
    f32x16 p0, p1; qkt(p0, p1, c, s, qr);
    apply_mask<M_CMP>(p0, p1, c.hi, 0, lim, true);
    const float rm = rowmax32(p0, p1), mn = fmaxf(st.m, rm), f = __builtin_amdgcn_exp2f(st.m - mn);
    st.m = mn;
    float sum = 0.f;
#pragma unroll
    for (int r = 0; r < 16; ++r) sum += __builtin_amdgcn_exp2f(p0[r] - mn) + __builtin_amdgcn_exp2f(p1[r] - mn);
    st.l = st.l * f + sum;
}
__device__ __forceinline__ void acc_scaled(const f32x16 (&o)[2], const Ctx& c, float fac_row) {
    LAS float* wsf = (LAS float*)(c.lds + L_WSF) + c.wid * 64;
    LAS float* oacc = (LAS float*)(c.lds + L_OACC) + c.wid * 2048;
    if (c.hi == 0) wsf[c.r32] = fac_row;
    const LAS float* wsh = wsf + 4 * c.hi; LAS float* oah = oacc + 4 * c.hi * 64 + c.r32;
#pragma unroll
    for (int r = 0; r < 16; ++r) { const int kc = (r & 3) + 8 * (r >> 2); const float fr_ = wsh[kc]; oah[kc * 64] += o[0][r] * fr_; oah[kc * 64 + 32] += o[1][r] * fr_; }
}

struct Tensors { const bf16_t *q, *kcmp, *vcmp, *ks, *vs, *kw, *vw; const float* g3; bf16_t* onsa; bf16_t* owin; bool bounded_slc, bounded_win; };
template <int DBG>
__device__ __forceinline__ void unit(const Tensors& T_, LAS unsigned char* lds, int b, int g, int qb, int flags) {
    int tid_ = threadIdx.x; asm volatile("" : "+v"(tid_));
    Ctx c; c.lds = lds; c.wid = __builtin_amdgcn_readfirstlane(tid_ >> 6); c.lane = tid_ & 63; c.r32 = c.lane & 31; c.hi = c.lane >> 5; c.th = c.wid & 1; c.hh = c.wid >> 1;
    const int tid = tid_, h = 4 * g + c.hh, t0 = qb * 64, ql = 32 * c.th + c.r32, tq = t0 + ql;
    const size_t tok = (size_t)b * SEQ + tq;
    const bf16_t* Qw = T_.q + (((size_t)b * NH + h) * SEQ + t0 + 32 * c.th) * 64;
    bf16x8 qr[4];
#pragma unroll
    for (int d0 = 0; d0 < 4; ++d0) qr[d0] = *(const bf16x8*)(Qw + (size_t)c.r32 * 64 + d0 * 16 + c.hi * 8);
    { LAS bf16x8* qf = (LAS bf16x8*)(lds + L_QF + c.wid * 4096 + c.hi * 512 + c.r32 * 16);
#pragma unroll
      for (int d0 = 0; d0 < 4; ++d0) qf[d0 * 64] = qr[d0]; }
    asm volatile("" :: "v"(qr[0]), "v"(qr[1]), "v"(qr[2]), "v"(qr[3]));
    const size_t bg = (size_t)b * NG + g;
    {
        if (flags & 1) { prefetch_tile(c, T_.kcmp + bg * 256 * 64); prefetch_tile(c, T_.vcmp + bg * 256 * 64);
            prefetch_tile(c, T_.ks + (bg * SEQ + (size_t)qb * 64) * 64); prefetch_tile(c, T_.vs + (bg * SEQ + (size_t)qb * 64) * 64); }
        if (flags & 2) { prefetch_tile(c, T_.kw + (bg * SEQ + (size_t)qb * 64) * 64); prefetch_tile(c, T_.vw + (bg * SEQ + (size_t)qb * 64) * 64);
            if (qb >= 8) { prefetch_tile(c, T_.kw + (bg * SEQ + (size_t)(qb - 8) * 64) * 64); prefetch_tile(c, T_.vw + (bg * SEQ + (size_t)(qb - 8) * 64) * 64); } }
        LAS float* gt = (LAS float*)(lds + L_GT) + c.wid * 192 + c.lane;
        gt[0] = T_.g3[tok * 24 + h]; gt[64] = T_.g3[tok * 24 + 8 + h]; gt[128] = T_.g3[tok * 24 + 16 + h];
    }
    { LAS f32x4* z = (LAS f32x4*)(lds + L_OACC) + c.wid * 512 + c.lane;
#pragma unroll
      for (int i = 0; i < 8; ++i) z[64 * i] = (f32x4){0.f, 0.f, 0.f, 0.f}; }

    if (flags & 1) {
        const bf16_t* KC = T_.kcmp + bg * 256 * 64; const bf16_t* VC = T_.vcmp + bg * 256 * 64;
        const int nct = ((t0 + 63 - 31) >> 4) / 64 + 1;
        const int cmax = (tq >= 31) ? ((tq - 31) >> 4) : -1;
        LAS unsigned* imp = (LAS unsigned*)(lds + L_IMP);
        for (int e = tid; e < 64 * 65; e += 512) imp[e] = 0u;
        Sm st{-1e30f, 0.f};
        dma_k(c, KC, 0);
        for (int n = 0; n < nct; ++n) {
            NSA_WAITBAR();
            if (n + 1 < nct) dma_k(c, KC + (size_t)(n + 1) * 4096, (n + 1) & 1);
            sm_stats(st, c, n & 1, qr, cmax - 64 * n);
        }
        const float lt = st.l + __shfl_xor(st.l, 32), inv = lt > 0.f ? 1.f / lt : 0.f;
        __syncthreads();
        f32x16 o[2]; o[0] = f32x16{}; o[1] = f32x16{};
        dma_kv(c, KC, VC, 0);
        for (int n = 0; n < nct; ++n) {
            NSA_WAITBAR();
            if (n + 1 < nct) dma_kv(c, KC + (size_t)(n + 1) * 4096, VC + (size_t)(n + 1) * 4096, (n + 1) & 1);
            f32x16 p0, p1; qkt(p0, p1, c, n & 1, qr);
            apply_mask<M_CMP>(p0, p1, c.hi, 0, cmax - 64 * n, true);
#pragma unroll
            for (int r = 0; r < 16; ++r) { p0[r] = __builtin_amdgcn_exp2f(p0[r] - st.m) * inv; p1[r] = __builtin_amdgcn_exp2f(p1[r] - st.m) * inv; }
#pragma unroll
            for (int rq = 0; rq < 4; ++rq) {
                const float s0 = (p0[4 * rq] + p0[4 * rq + 1]) + (p0[4 * rq + 2] + p0[4 * rq + 3]), s1 = (p1[4 * rq] + p1[4 * rq + 1]) + (p1[4 * rq + 2] + p1[4 * rq + 3]);
                const int j0 = 16 * n + 2 * rq + c.hi, j1 = j0 + 8;
                LAS unsigned* impr = imp + ql * 65 + 16 * n + c.hi;
                __hip_atomic_fetch_add(&impr[2 * rq], (unsigned)(s0 * 16777216.f + 0.5f), __ATOMIC_RELAXED, __HIP_MEMORY_SCOPE_WORKGROUP);
                __hip_atomic_fetch_add(&impr[2 * rq + 8], (unsigned)(s1 * 16777216.f + 0.5f), __ATOMIC_RELAXED, __HIP_MEMORY_SCOPE_WORKGROUP);
                if (j0 + 1 < 64) __hip_atomic_fetch_add(&impr[2 * rq + 1], (unsigned)(p0[4 * rq + 3] * 16777216.f + 0.5f), __ATOMIC_RELAXED, __HIP_MEMORY_SCOPE_WORKGROUP);
                if (j1 + 1 < 64) __hip_atomic_fetch_add(&impr[2 * rq + 9], (unsigned)(p1[4 * rq + 3] * 16777216.f + 0.5f), __ATOMIC_RELAXED, __HIP_MEMORY_SCOPE_WORKGROUP);
            }
            bf16x8 pa[4]; pack_p(pa, p0, p1);
            pv(o, c, n & 1, pa);
        }
        acc_scaled(o, c, ((LAS float*)(lds + L_GT))[c.wid * 192 + c.lane]);
        __syncthreads();
        {
            int t2_ = tid; asm volatile("" : "+v"(t2_));
            const int tk = t2_ >> 3, jb = (t2_ & 7) * 8;
            unsigned sown[8]; int rank[8];
#pragma unroll
            for (int k = 0; k < 8; ++k) { const int j = jb + k; sown[k] = imp[tk * 65 + j] + ((j == 0 || j == qb || j == qb - 1) ? 0x40000000u : 0u); rank[k] = 0; }
            for (int jp = 0; jp <= qb; ++jp) { const unsigned sp = imp[tk * 65 + jp] + ((jp == 0 || jp == qb || jp == qb - 1) ? 0x40000000u : 0u);
#pragma unroll
                for (int k = 0; k < 8; ++k) rank[k] += (sp > sown[k] || (sp == sown[k] && jp < jb + k)) ? 1 : 0; }
            unsigned bits = 0u;
#pragma unroll
            for (int k = 0; k < 8; ++k) if (jb + k <= qb && rank[k] < 16) bits |= 1u << k;
            ((LAS unsigned char*)(lds + L_SEL))[tk * 8 + (t2_ & 7)] = (unsigned char)bits;
        }
        __syncthreads();
        if (tid < 64) {
            const unsigned long long mine = ((LAS unsigned long long*)(lds + L_SEL))[tid];
            unsigned lo = (unsigned)mine, hi2 = (unsigned)(mine >> 32);
#pragma unroll
            for (int o_ = 1; o_ < 64; o_ <<= 1) { lo |= __shfl_xor(lo, o_); hi2 |= __shfl_xor(hi2, o_); }
            if (tid == 0) { ((LAS unsigned*)(lds + L_UNI))[0] = lo; ((LAS unsigned*)(lds + L_UNI))[1] = hi2; }
        }
        __syncthreads();
    }
    for (int sidx = (flags & 1) ? 0 : 1; sidx < ((flags & 2) ? 2 : 1); ++sidx) {
        unsigned long long tm;
        if (sidx == 0) { const unsigned ul = (unsigned)__builtin_amdgcn_readfirstlane((int)((LAS unsigned*)(lds + L_UNI))[0]), uh = (unsigned)__builtin_amdgcn_readfirstlane((int)((LAS unsigned*)(lds + L_UNI))[1]);
            tm = ((((unsigned long long)uh << 32) | ul) & ((2ull << qb) - 1ull)) | (1ull << qb); }
        else { const int jlo = qb - 7 < 0 ? 0 : qb - 7; tm = ((2ull << qb) - 1ull) & ~((1ull << jlo) - 1ull); }
        if (DBG & 32) tm = 1ull << qb;
        const int NT = __builtin_popcountll(tm);
        unsigned long long selm = ~0ull;
        if (sidx == 0) selm = ((LAS unsigned long long*)(lds + L_SEL))[ql];
        const bool bounded = sidx ? T_.bounded_win : T_.bounded_slc;
        const bf16_t* KB = (sidx ? T_.kw : T_.ks) + bg * SEQ * 64; const bf16_t* VB = (sidx ? T_.vw : T_.vs) + bg * SEQ * 64;
#define TM_TOP(m) (63 - __builtin_clzll(m))
#define TL_RS(j) ((bool)((selm >> (j)) & 1ull))
        Sm st{0.f, 0.f}; f32x16 o[2]; o[0] = f32x16{}; o[1] = f32x16{};
        f32x16 sA0, sA1, sB0, sB1;
        bool first = true;
        if (sidx == 1 && qb >= 8 && !(DBG & 64)) {
            dma_kv(c, KB + (size_t)(qb - 8) * 4096, VB + (size_t)(qb - 8) * 4096, 0);
            NSA_WAITBAR();
            qk_first(sA0, sA1, c, 0, 0.f, M_WINLO, ql);
            const float rm = rowmax32_3(sA0, sA1);
            if (!bounded && __builtin_expect(__any(rm > RESCALE_THR || (rm < -RESCALE_THR && rm > -INFINITY)), 0)) rescale_rows(st, o, sA0, sA1, c, rm, true);
            bf16x8 pa_[4]; exp_sum_pack(st, sA0, sA1, pa_);
            { s16x4 vf0[16]; bf16x8 kfd[8]; read_vf(vf0, c, 0); (void)block_c<false>(o, c, vf0, pa_, sA0, sA1, kfd, -1); }
            first = false;
            asm volatile("s_waitcnt lgkmcnt(0)\n\ts_barrier" ::: "memory");
        }
        unsigned long long tw = tm;
        int jc0 = TM_TOP(tw); tw &= ~(1ull << jc0);
        int jc1 = tw ? TM_TOP(tw) : -1; if (jc1 >= 0) tw &= ~(1ull << jc1);
        int jc2 = tw ? TM_TOP(tw) : -1; if (jc2 >= 0) tw &= ~(1ull << jc2);
        int jc3 = tw ? TM_TOP(tw) : -1; if (jc3 >= 0) tw &= ~(1ull << jc3);
        int jc4 = tw ? TM_TOP(tw) : -1; if (jc4 >= 0) tw &= ~(1ull << jc4);
        dma_k(c, KB + (size_t)jc0 * 4096, 0);
        if (jc1 >= 0) dma_k(c, KB + (size_t)jc1 * 4096, 1);
        dma_v(c, VB + (size_t)jc0 * 4096, 0);
        if (jc2 >= 0) dma_k(c, KB + (size_t)jc2 * 4096, 2);
        NSA_WAITBAR();
        qk_first(sA0, sA1, c, 0, TL_RS(jc0) ? -st.m : -INFINITY, M_CAUSAL, ql);
        float rmc = rowmax32_3(sA0, sA1);
        bf16x8 kf[8];
        if (jc1 >= 0) read_kf(kf, c, 1);
        asm volatile("s_waitcnt lgkmcnt(0)\n\ts_barrier" ::: "memory");
        if (jc3 >= 0) dma_k(c, KB + (size_t)jc3 * 4096, 0);
        if (jc1 >= 0) dma_v(c, VB + (size_t)jc1 * 4096, 1);
        bf16x8 qs[4];
        { const lds_cptr qb_ = (lds_cptr)(lds + L_QF + c.wid * 4096) + c.hi * 512 + c.r32 * 16;
#pragma unroll
          for (int d0 = 0; d0 < 4; ++d0) qs[d0] = *(const LAS bf16x8*)(qb_ + d0 * 1024); }
        int r0 = 0, r1 = 1, r2 = 2;
        s16x4 vf[16];
#define NSA_STEP(n, C0, C1, N0, N1, NR) do { \
            if (jc3 >= 0 && (n) > 0) NSA_WAITBAR2(); else NSA_WAITBAR(); \
            if (jc4 >= 0) dma_k(c, KB + (size_t)jc4 * 4096, r1); \
            if (jc2 >= 0) dma_v(c, VB + (size_t)jc2 * 4096, r2); \
            if (!(NR)) { if (__builtin_expect(__any(rmc > RESCALE_THR || (first && rmc < -RESCALE_THR && rmc > -INFINITY)), 0)) rescale_rows(st, o, C0, C1, c, rmc, first); } \
            first = false; \
            bf16x8 pa_[4]; \
            block_b<DBG>(N0, N1, c, kf, qs, vf, r0, TL_RS(jc1) ? -st.m : -INFINITY, st, C0, C1, pa_); \
            rmc = block_c<true, DBG, NR>(o, c, vf, pa_, N0, N1, kf, jc2 >= 0 ? r2 : -1); \
            { const int t_ = r0; r0 = r1; r1 = r2; r2 = t_; } \
            jc0 = jc1; jc1 = jc2; jc2 = jc3; jc3 = jc4; jc4 = tw ? TM_TOP(tw) : -1; if (jc4 >= 0) tw &= ~(1ull << jc4); \
        } while (0)
        int n = 0;
        bool inA = true;
        if (bounded) {
            rmc = 0.f;
            while (jc1 >= 0) {
                NSA_STEP(n, sA0, sA1, sB0, sB1, true); ++n; inA = false;
                if (jc1 >= 0) { NSA_STEP(n, sB0, sB1, sA0, sA1, true); ++n; inA = true; }
            }
        } else {
            while (jc1 >= 0) {
                NSA_STEP(n, sA0, sA1, sB0, sB1, false); ++n; inA = false;
                if (jc1 >= 0) { NSA_STEP(n, sB0, sB1, sA0, sA1, false); ++n; inA = true; }
            }
        }
        if (!inA) { sA0 = sB0; sA1 = sB1; }
        {
            NSA_WAITBAR();
            if (__builtin_expect(__any(rmc > RESCALE_THR || (first && rmc < -RESCALE_THR && rmc > -INFINITY)), 0)) rescale_rows(st, o, sA0, sA1, c, rmc, first);
            bf16x8 pa_[4]; exp_sum_pack(st, sA0, sA1, pa_);
            read_vf(vf, c, r0);
            (void)block_c<false>(o, c, vf, pa_, sA0, sA1, kf, -1);
            const float lt = st.l + __shfl_xor(st.l, 32);
            acc_scaled(o, c, lt > 0.f ? ((LAS float*)(lds + L_GT))[c.wid * 192 + (sidx ? 128 : 64) + c.lane] / lt : 0.f);
        }
#undef NSA_STEP
#undef TM_TOP
#undef TL_RS
        asm volatile("s_waitcnt lgkmcnt(0)\n\ts_barrier" ::: "memory");
    }
    {
        const LAS float* oacc = (const LAS float*)(lds + L_OACC) + c.wid * 2048;
        const bool to_owin = !(flags & 1);
        bf16_t* dstb = (to_owin ? T_.owin : T_.onsa) + ((size_t)b * SEQ + t0 + 32 * c.th) * 512 + h * 64;
        asm volatile("s_waitcnt lgkmcnt(0)" ::: "memory");
#pragma unroll
        for (int i = 0; i < 4; ++i) { const int row = i * 8 + (c.lane >> 3), ch = c.lane & 7;
            f32x4 a = *(const LAS f32x4*)(oacc + row * 64 + ch * 8), b2 = *(const LAS f32x4*)(oacc + row * 64 + ch * 8 + 4);
            if (!(flags & 2)) { f32x4 wa, wb; epi::unpack8(*(const u32x4*)(T_.owin + ((size_t)b * SEQ + t0 + 32 * c.th + row) * 512 + h * 64 + ch * 8), wa, wb); a += wa; b2 += wb; }
            *(u32x4*)(dstb + (size_t)row * 512 + ch * 8) = epi::pack8(a, b2); }
    }
    __syncthreads();
}
#undef NSA_MFMA
#undef NSA_WAITBAR
}

enum { MAP_ID = 0, MAP_GU = 1, MAP_WIN = 2, MAP_GLU = 3 };
__device__ __forceinline__ int map_col(int mapid, int n) {
    if (mapid == MAP_ID) return n;
    if (mapid == MAP_GU) return ((n >> 8) << 7) + (n & 127);
    if (mapid == MAP_GLU) return (((n >> 7) & 1) << 10) + ((n >> 8) << 7) + (n & 127);
    const int pn = n >> 8, r = n & 255;
    if (pn < 5) { const int bj = r >> 7, wc = (r >> 5) & 3, i = r & 31; return 64 * (4 * pn + wc) + 32 * bj + i; }
    if (pn < 7) return 1304 + 256 * (pn - 5) + r;
    if (pn < 11) return 1816 + 256 * (pn - 7) + r;
    if (pn < 15) return 2840 + 256 * (pn - 11) + r;
    return r < 24 ? 1280 + r : -1;
}
struct TDesc { const float* W; const float* W2; int K, ldw, Nt, mapid; size_t off; const float* gain; };
__device__ __forceinline__ TDesc tdesc(const Args& a, int id) {
    switch (id) {
    case 0: return TDesc{a.in[2], a.in[3], DM, FF, 2 * FF, MAP_GU, WS_W1GU, a.in[1]};
    case 1: return TDesc{a.in[29], a.in[30], DM, FF, 2 * FF, MAP_GU, WS_W2GU, a.in[28]};
    case 2: return TDesc{a.in[4], nullptr, FF, DM, DM, MAP_ID, WS_W1D, nullptr};
    case 3: return TDesc{a.in[31], nullptr, FF, DM, DM, MAP_ID, WS_W2D, nullptr};
    case 4: return TDesc{a.in[6], nullptr, DM, INW, 4096, MAP_WIN, WS_WIN, a.in[5]};
    case 5: return TDesc{a.in[17], nullptr, 512, DM, DM, MAP_ID, WS_WNSA, nullptr};
    case 6: return TDesc{a.in[26], nullptr, 512, 2048, 2048, MAP_GLU, WS_WGLU, nullptr};
    case 7: return TDesc{a.in[27], nullptr, DM, DM, DM, MAP_ID, WS_WOUT, nullptr};
    case 8: return TDesc{a.in[13], nullptr, 2048, 256, 256, MAP_ID, WS_WC1K, nullptr};
    default: return TDesc{a.in[15], nullptr, 2048, 256, 256, MAP_ID, WS_WC1V, nullptr};
    }
}
constexpr int N_TMAT = 10;
__device__ __forceinline__ bool tmat_early(int id) { return id == 0 || id == 2 || id == 4 || id == 8 || id == 9; }
__device__ __forceinline__ int tmat_items(const TDesc& d) { return (d.K / 64) * (d.Nt / 32); }
__device__ __forceinline__ void tmat_item(const Args& a, const TDesc& d, int r, LAS float* scr, int lane) {
    const int nblk = d.Nt / 32, kb = r / nblk, nb = r % nblk, n0 = 32 * nb;
    const float* W = (d.mapid == MAP_GU && ((n0 >> 7) & 1)) ? d.W2 : d.W;
    const int mapid = d.mapid;
    transpose_item(W, d.ldw, (bf16_t*)(a.ws + d.off), d.K, 64 * kb, n0, [mapid](int n) { return map_col(mapid, n); }, scr, lane, d.gain);
}
constexpr int LATE_ITEMS = (DM / 64) * (2 * FF / 32) + (FF / 64) * (DM / 32) + (512 / 64) * (DM / 32) + (512 / 64) * (2048 / 32) + (DM / 64) * (DM / 32);
__device__ __forceinline__ void late_item(const Args& a, int v, LAS float* scr, int lane) {
    const int ids[5] = {1, 3, 5, 6, 7};
    int base = 0;
#pragma unroll
    for (int q = 0; q < 5; ++q) { const TDesc d = tdesc(a, ids[q]); const int n = tmat_items(d); if (v < base + n) { tmat_item(a, d, v - base, scr, lane); return; } base += n; }
}
__device__ __forceinline__ void p0_prologue(Frame& F, const Args& a) {
    LAS float* scr = (LAS float*)(F.lds + RING_OFF + F.wave * 16384);
    const int gw = F.vcu * NWAVES + F.wave, NGW = F.G * NWAVES;
    unsigned char* ws = a.ws;
    { bf16_t* xn = (bf16_t*)(ws + WS_XN); float* ssq = (float*)(ws + WS_SSQ);
      const int per_x = F.G / 8, xcd = F.vcu / per_x, wl = (F.vcu % per_x) * NWAVES + F.wave, nwl = per_x * NWAVES, rows_x = T / 8;
      for (int r = wl; r < rows_x / 2; r += nwl) { const int m = xcd * rows_x + r, m1 = m + rows_x / 2;
          prep_row2(a.in[0] + (size_t)m * DM, a.in[0] + (size_t)m1 * DM, a.in[1], xn + (size_t)m * DM, xn + (size_t)m1 * DM, ssq + (size_t)m * 16, ssq + (size_t)m1 * 16, F.lane); } }
    int base = 0;
    for (int id = 0; id < N_TMAT; ++id) {
        if (!tmat_early(id)) continue;
        const TDesc d = tdesc(a, id);
        const int nitems = tmat_items(d);
        int first = gw - (base % NGW); if (first < 0) first += NGW;
        for (int r = first; r < nitems; r += NGW) tmat_item(a, d, r, scr, F.lane);
        base += nitems;
    }
    for (int wt = gw; wt < SSM_G * 64; wt += NGW) ssm_weights_task(a, wt >> 6, wt & 63, F.lane, scr);
    for (int wt = gw; wt < 64; wt += NGW) { const int kv = wt >> 5, kc = (wt >> 2) & 7, n = (wt & 3) * 64 + F.lane;
        const float* pos = a.in[kv ? 12 : 11]; const float* w1 = a.in[kv ? 15 : 13]; float acc = 0.f;
        for (int k = kc * 256; k < kc * 256 + 256; ++k) acc += pos[k] * w1[(size_t)k * 256 + n];
        ((float*)(ws + WS_MISC))[(kv * 8 + kc) * 256 + n] = acc; }
}

typedef short bf16x8_t __attribute__((ext_vector_type(8)));
typedef float f32x16_t __attribute__((ext_vector_type(16)));
__device__ __forceinline__ void cmp_l2_wave(const bf16_t* hidrows, const float* w2, const float* knorm, bf16_t* outrows, int mrow0, int lane) {
    const int r32 = lane & 31, hi = lane >> 5;
    f32x16_t acc0 = {}, acc1 = {};
    for (int k4 = 0; k4 < 16; k4 += 4) {
        bf16x8_t af[4]; float wv[4][16];
#pragma unroll
        for (int q = 0; q < 4; ++q) { const int ks = k4 + q; af[q] = *(const bf16x8_t*)(hidrows + (size_t)r32 * 256 + 16 * ks + 8 * hi);
#pragma unroll
            for (int j = 0; j < 4; ++j) { const float* wp = w2 + (size_t)(16 * ks + 8 * hi + 2 * j) * 64 + r32; wv[q][4 * j] = wp[0]; wv[q][4 * j + 1] = wp[64]; wv[q][4 * j + 2] = wp[32]; wv[q][4 * j + 3] = wp[64 + 32]; } }
#pragma unroll
        for (int q = 0; q < 4; ++q) {
            const bf16x8_t bf0 = __builtin_bit_cast(bf16x8_t, (v4u){pk2(wv[q][0], wv[q][1]), pk2(wv[q][4], wv[q][5]), pk2(wv[q][8], wv[q][9]), pk2(wv[q][12], wv[q][13])});
            const bf16x8_t bf1 = __builtin_bit_cast(bf16x8_t, (v4u){pk2(wv[q][2], wv[q][3]), pk2(wv[q][6], wv[q][7]), pk2(wv[q][10], wv[q][11]), pk2(wv[q][14], wv[q][15])});
            acc0 = __builtin_amdgcn_mfma_f32_32x32x16_bf16(af[q], bf0, acc0, 0, 0, 0);
            acc1 = __builtin_amdgcn_mfma_f32_32x32x16_bf16(af[q], bf1, acc1, 0, 0, 0);
        }
    }
    const float g0 = knorm ? knorm[r32] : 1.f, g1 = knorm ? knorm[32 + r32] : 1.f;
#pragma unroll
    for (int r = 0; r < 16; ++r) {
        const int row = (r & 3) + 8 * (r >> 2) + 4 * hi;
        float v0 = acc0[r], v1 = acc1[r];
        if (knorm) { float ss = v0 * v0 + v1 * v1;
            ss += __shfl_xor(ss, 1); ss += __shfl_xor(ss, 2); ss += __shfl_xor(ss, 4); ss += __shfl_xor(ss, 8); ss += __shfl_xor(ss, 16);
            const float rn = rsqrtf(ss * (1.f / 64.f) + RMS_EPS); v0 *= rn * g0; v1 *= rn * g1; }
        if (((mrow0 + row) & 255) == 255) { v0 = 0.f; v1 = 0.f; }
        outrows[(size_t)row * 64 + r32] = f2bf(v0); outrows[(size_t)row * 64 + 32 + r32] = f2bf(v1);
    }
}

__global__ void __launch_bounds__(NWAVES * 64, 2) mega(Args args) {
    extern __shared__ __attribute__((aligned(16))) unsigned char lds[];
    Frame F;
    F.lds = (LAS unsigned char*)lds;
    F.MISC = (volatile LAS unsigned*)(F.lds + MISC_OFF);
    F.tid = threadIdx.x; F.lane = F.tid & 63; F.wave = __builtin_amdgcn_readfirstlane(F.tid >> 6);
    F.G = gridDim.x; { const int bx = blockIdx.x; F.vcu = (F.G % 8 == 0) ? (bx % 8) * (F.G / 8) + bx / 8 : bx; }
    unsigned char* ws = args.ws;
    F.ctl = (gu32*)(ws + WS_CTL);
    for (int u = F.tid; u < (LDS_BYTES - LDSCTL_OFF) / 4; u += NWAVES * 64) ((LAS unsigned*)(F.lds + LDSCTL_OFF))[u] = 0u;
    __syncthreads();
    XcdBarrier bar; bar.bar = (unsigned*)(F.ctl + CW_BAR); bar.x = 0; bar.st = nullptr;
    if (args.fused) bar = xcd_barrier_post((unsigned*)(F.ctl + CW_BAR), F.MISC + 8);
    const int lo = args.ph_lo, hi = args.ph_hi;
#define SELF_HANDOFF() do { asm volatile("s_waitcnt vmcnt(0)" ::: "memory"); __syncthreads(); } while (0)
#define IN(k) (lo <= (k) && (k) < hi)
#define SEAM(k) do { if (IN(k) && IN((k) + 1)) xcd_barrier(bar); } while (0)
    float* out = args.out;
    bf16_t* xn = (bf16_t*)(ws + WS_XN); float* ssq = (float*)(ws + WS_SSQ); bf16_t* act = (bf16_t*)(ws + WS_ACT);

    if (IN(PH_PRO)) { p0_prologue(F, args); } SEAM(PH_PRO);

    if (IN(PH_F1GU)) {
        pg8::Gemm g{xn, (const bf16_t*)(ws + WS_W1GU), DM, DM, DM, 0, 0}; pg8::StaticOrder S; S.init(T, 2 * FF, F.G, (int)blockIdx.x);
        epi::EpiSwiGLU E{act, ssq, (LAS float*)(F.lds + RING_BYTES), -1};
        pg8::gemm_phase<epi::EpiSwiGLU, pg8::StaticOrder, PG8_ALIGN, PG8_SP2>(F.lds + RING_OFF, g, S, E);
    } SEAM(PH_F1GU);

    if (IN(PH_F1D)) {
        pg8::Gemm g{act, (const bf16_t*)(ws + WS_W1D), FF, FF, FF, 0, 0}; pg8::StaticOrder S; S.init(T, DM, F.G, (int)blockIdx.x);
        epi::EpiResid<true, false> E{nullptr, xn, nullptr, 0.5f, xn, ssq};
        pg8::gemm_phase<epi::EpiResid<true, false>, pg8::StaticOrder, PG8_ALIGN, PG8_SP2>(F.lds + RING_OFF, g, S, E);
    } SEAM(PH_F1D);

    if (IN(PH_WIN)) {
        pg8::Gemm g{xn, (const bf16_t*)(ws + WS_WIN), DM, DM, DM, 0, 0}; pg8::StaticOrder S; S.init(T, 4096, F.G, (int)blockIdx.x);
        epi::EpiWin E; E.ssq = ssq; E.q = (bf16_t*)(ws + WS_Q); E.ks = (bf16_t*)(ws + WS_KS); E.vs = (bf16_t*)(ws + WS_VS); E.kw = (bf16_t*)(ws + WS_KW); E.vw = (bf16_t*)(ws + WS_VW);
        E.kcr = (bf16_t*)(ws + WS_KCR); E.vcr = (bf16_t*)(ws + WS_VCR); E.acat = (bf16_t*)(ws + WS_ACAT); E.sgn = (bf16_t*)(ws + WS_SGN); E.sgs = (bf16_t*)(ws + WS_SGS); E.g3 = (float*)(ws + WS_G3);
        E.q_norm = args.in[7]; E.k_norm_slc = args.in[9]; E.k_norm_win = args.in[10]; E.rs_tab = (LAS float*)(F.lds + RING_BYTES); E.cached_pm = -1;
        pg8::gemm_phase<epi::EpiWin, pg8::StaticOrder, PG8_ALIGN, PG8_SP2>(F.lds + RING_OFF, g, S, E);
    } SEAM(PH_WIN);

    if (IN(PH_MIDA)) {
        const int vcu = F.vcu;
        {
            const int cu = (vcu & 7) == 0 ? (vcu >> 3) : -1;
            pg8::Gemm g{(const bf16_t*)(ws + WS_KCR), (const bf16_t*)(ws + WS_WC1K), 1024, 2048, 2048, WS_VCR - WS_KCR, WS_WC1V - WS_WC1K};
            pg8::GroupOrder S; S.init(16, 1, 2, F.G, cu);
            epi::EpiCmp1 E{(bf16_t*)(ws + WS_HID), (const float*)(ws + WS_MISC)};
            pg8::gemm_phase<epi::EpiCmp1, pg8::GroupOrder, false, PG8_SP2>(F.lds + RING_OFF, g, S, E);
            if (cu >= 0) {
                SELF_HANDOFF();
                const int pg = cu >> 4, pm = cu & 15, r0 = pm * 256 + F.wave * 32;
                cmp_l2_wave((const bf16_t*)(ws + WS_HID) + ((size_t)pg * 4096 + r0) * 256, args.in[pg ? 16 : 14], pg ? nullptr : args.in[8],
                            (bf16_t*)(ws + (pg ? WS_VCMP : WS_KCMP)) + (size_t)r0 * 64, r0, F.lane);
            }
        }
        {
            const int cu = (vcu & 3) == 1 ? (vcu >> 2) : -1;
            pg8::Gemm g{(const bf16_t*)(ws + WS_ACAT), (const bf16_t*)(ws + WS_W1S), ACAT_LD, 1024, 1024, (size_t)512 * ACAT_LD * 2, (size_t)128 * 1024 * 2};
            pg8::GroupOrder S; S.init(2, 1, SSM_G, F.G, cu);
            epi::EpiSst E{(float*)(ws + WS_SST)};
            pg8::gemm_phase<epi::EpiSst, pg8::GroupOrder, false, PG8_SP2>(F.lds + RING_OFF, g, S, E);
            if (cu >= 0) {
                SELF_HANDOFF();
                ssm_carry_scan(args, cu >> 1, cu & 1, F.tid);
            }
        }
        {
            unsigned* ctr = (unsigned*)(F.ctl + CW_TOEP);
            LAS float* scr = (LAS float*)(F.lds + RING_OFF + F.wave * 16384);
            for (;;) { int v = 0; if (F.lane == 0) v = (int)__hip_atomic_fetch_add(ctr, 1u, RLX_AGENT); v = __builtin_amdgcn_readfirstlane(v);
                if (v >= LATE_ITEMS + SSM_G * 128) break;
                if (v < LATE_ITEMS) late_item(args, v, scr, F.lane);
                else { const int r0 = (v - LATE_ITEMS) * 8; for (int r = 0; r < 8; ++r) toep_row(ws, r0 + r, F.lane); } }
        }
    } SEAM(PH_MIDA);

    if (IN(PH_MIDB)) {
        if (args.pad & 4) {
            pg8::GroupOrder S; S.init(2, 4, SSM_G, F.G, F.vcu);
            pg8::Unit u0;
            (void)u0;
            pg8::Gemm g{(const bf16_t*)(ws + WS_ACAT), (const bf16_t*)(ws + WS_WTOEP), ACAT_LD, ACAT_LD, ACAT_LD, (size_t)512 * ACAT_LD * 2, (size_t)1024 * ACAT_LD * 2};
            epi::EpiSsmOut E{(const bf16_t*)(ws + WS_ACAT), args.in[25], ((bf16_t*)out + (size_t)T * 512)};
            pg8::gemm_phase<epi::EpiSsmOut, pg8::GroupOrder, false, PG8_SP2>(F.lds + RING_OFF, g, S, E);
        }
        if (args.pad & 3) {
            nsa::Tensors AT{(const bf16_t*)(ws + WS_Q), (const bf16_t*)(ws + WS_KCMP), (const bf16_t*)(ws + WS_VCMP), (const bf16_t*)(ws + WS_KS), (const bf16_t*)(ws + WS_VS),
                            (const bf16_t*)(ws + WS_KW), (const bf16_t*)(ws + WS_VW), (const float*)(ws + WS_G3), ((bf16_t*)out), (bf16_t*)(ws + WS_OWIN), false, false};
            {
                const float gq = wave_max(fabsf(args.in[7][F.lane])), gks = wave_max(fabsf(args.in[9][F.lane])), gkw = wave_max(fabsf(args.in[10][F.lane]));
                AT.bounded_slc = C2 * 64.f * gq * gks < 24.f; AT.bounded_win = C2 * 64.f * gq * gkw < 24.f;
            }
            const int bgi = F.vcu >> 4, sidx = F.vcu & 15;
            for (int i = 0; i < 4; ++i) { const int qb = (i == 0) ? sidx : (i == 1) ? 31 - sidx : (i == 2) ? 32 + sidx : 63 - sidx;

#if defined(PROBE_ATT)
                if (args.pad & 16) nsa::unit<PROBE_ATT>(AT, F.lds + RING_OFF, bgi >> 1, bgi & 1, qb, args.pad & 3); else
#endif
                nsa::unit<0>(AT, F.lds + RING_OFF, bgi >> 1, bgi & 1, qb, args.pad & 3); }
        }
    } SEAM(PH_MIDB);

    if (IN(PH_NSA)) {
        pg8::StaticOrder S; S.init(T, DM, F.G, (int)blockIdx.x);
        { pg8::Gemm g{((const bf16_t*)out), (const bf16_t*)(ws + WS_WNSA), 512, 512, 512, 0, 0};
          epi::EpiNsa E{(const bf16_t*)(ws + WS_SGN), (bf16_t*)(ws + WS_M1)};
          pg8::gemm_phase<epi::EpiNsa, pg8::StaticOrder, PG8_ALIGN, PG8_SP2>(F.lds + RING_OFF, g, S, E); }
        SELF_HANDOFF();
        { pg8::Gemm g{((const bf16_t*)out + (size_t)T * 512), (const bf16_t*)(ws + WS_WGLU), 512, 512, 512, 0, 0}; pg8::SplitOrder L{S};
          epi::EpiGlu E{(const bf16_t*)(ws + WS_SGS), (const bf16_t*)(ws + WS_M1), (bf16_t*)(ws + WS_MERGED)};
          pg8::gemm_phase<epi::EpiGlu, pg8::SplitOrder, PG8_ALIGN, PG8_SP2>(F.lds + RING_OFF, g, L, E); }
    } SEAM(PH_NSA);

    if (IN(PH_WOUT)) {
        pg8::Gemm g{(const bf16_t*)(ws + WS_MERGED), (const bf16_t*)(ws + WS_WOUT), DM, DM, DM, 0, 0}; pg8::StaticOrder S; S.init(T, DM, F.G, (int)blockIdx.x);
        epi::EpiResid<true, false> E{nullptr, xn, nullptr, 1.0f, xn, ssq};
        pg8::gemm_phase<epi::EpiResid<true, false>, pg8::StaticOrder, PG8_ALIGN, PG8_SP2>(F.lds + RING_OFF, g, S, E);
    } SEAM(PH_WOUT);

    if (IN(PH_F2GU)) {
        pg8::Gemm g{xn, (const bf16_t*)(ws + WS_W2GU), DM, DM, DM, 0, 0}; pg8::StaticOrder S; S.init(T, 2 * FF, F.G, (int)blockIdx.x);
        epi::EpiSwiGLU E{act, ssq, (LAS float*)(F.lds + RING_BYTES), -1};
        pg8::gemm_phase<epi::EpiSwiGLU, pg8::StaticOrder, PG8_ALIGN, PG8_SP2>(F.lds + RING_OFF, g, S, E);
    } SEAM(PH_F2GU);

    if (IN(PH_F2D)) {
        pg8::Gemm g{act, (const bf16_t*)(ws + WS_W2D), FF, FF, FF, 0, 0}; pg8::StaticOrder S; S.init(T, DM, F.G, (int)blockIdx.x);
        epi::EpiResid<true, true> E{nullptr, xn, out, 0.5f, nullptr, nullptr};
        pg8::gemm_phase<epi::EpiResid<true, true>, pg8::StaticOrder, PG8_ALIGN, PG8_SP2>(F.lds + RING_OFF, g, S, E);
    }
#undef IN
#undef SEAM
}

template <int NB, class AL, class BL, class EPI>
__device__ __forceinline__ void tgemm(int m0, int n0, int K, const AL& al, const BL& bl, const EPI& epi) {
    __shared__ float As[16][64 + 4];
    __shared__ float Bs[NB][16][64 + 4];
    __shared__ float Cs[NB][64][65];
    const int tid = threadIdx.x, ty = tid >> 4, tx = tid & 15;
    float acc[NB][4][4];
#pragma unroll
    for (int b = 0; b < NB; ++b)
#pragma unroll
        for (int i = 0; i < 4; ++i)
#pragma unroll
            for (int j = 0; j < 4; ++j) acc[b][i][j] = 0.f;
    for (int k0 = 0; k0 < K; k0 += 16) {
        {
            const int m = tid >> 2, kk = (tid & 3) * 4;
#pragma unroll
            for (int i = 0; i < 4; ++i) As[kk + i][m] = al(m0 + m, k0 + kk + i);
        }
        {
            const int kk = tid >> 4, nn = (tid & 15) * 4;
#pragma unroll
            for (int b = 0; b < NB; ++b)
#pragma unroll
                for (int j = 0; j < 4; ++j) Bs[b][kk][nn + j] = bl(b, k0 + kk, n0 + nn + j);
        }
        __syncthreads();
#pragma unroll
        for (int kk = 0; kk < 16; ++kk) {
            float a[4];
#pragma unroll
            for (int i = 0; i < 4; ++i) a[i] = As[kk][ty * 4 + i];
#pragma unroll
            for (int b = 0; b < NB; ++b) {
                float bv[4];
#pragma unroll
                for (int j = 0; j < 4; ++j) bv[j] = Bs[b][kk][tx * 4 + j];
#pragma unroll
                for (int i = 0; i < 4; ++i)
#pragma unroll
                    for (int j = 0; j < 4; ++j) acc[b][i][j] += a[i] * bv[j];
            }
        }
        __syncthreads();
    }
#pragma unroll
    for (int b = 0; b < NB; ++b)
#pragma unroll
        for (int i = 0; i < 4; ++i)
#pragma unroll
            for (int j = 0; j < 4; ++j) Cs[b][ty * 4 + i][tx * 4 + j] = acc[b][i][j];
    __syncthreads();
    epi(Cs, m0, n0);
}

__device__ __forceinline__ float row_rstd(const float* ssq, int t) {
    float s = 0.f;
#pragma unroll
    for (int i = 0; i < 16; ++i) s += ssq[(size_t)t * 16 + i];
    return rsqrtf(s * (1.f / DM) + RMS_EPS);
}

__global__ void __launch_bounds__(256) k_prep_rows(const float* x, const float* g, bf16_t* xn, float* ssq) {
    const int row = blockIdx.x * 4 + (threadIdx.x >> 6), lane = threadIdx.x & 63;
    const float* xr = x + (size_t)row * DM;
    float s = 0.f;
    for (int c = lane; c < DM; c += 64) { const float v = xr[c]; s += v * v; xn[(size_t)row * DM + c] = f2bf(v * g[c]); }
    s = wave_sum(s);
    if (lane < 16) ssq[(size_t)row * 16 + lane] = (lane == 0) ? s : 0.f;
}
__global__ void __launch_bounds__(256) k_row_ssq(const float* x, float* ssq) {
    const int row = blockIdx.x * 4 + (threadIdx.x >> 6), lane = threadIdx.x & 63;
    const float* xr = x + (size_t)row * DM;
    float s = 0.f;
    for (int c = lane; c < DM; c += 64) { const float v = xr[c]; s += v * v; }
    s = wave_sum(s);
    if (lane < 16) ssq[(size_t)row * 16 + lane] = (lane == 0) ? s : 0.f;
}

__global__ void __launch_bounds__(256) k_ffn_gu(const bf16_t* xn, const float* ssq, const float* wg, const float* wu, bf16_t* act) {
    const int m0 = blockIdx.y * 64, n0 = blockIdx.x * 64;
    auto al = [&](int m, int k) { return bf2f(xn[(size_t)m * DM + k]); };
    auto bl = [&](int b, int k, int n) { return (b == 0 ? wg : wu)[(size_t)k * FF + n]; };
    auto epi = [&](float (*Cs)[64][65], int m0_, int n0_) {
        const int tid = threadIdx.x;
        for (int e = tid; e < 64 * 64; e += 256) {
            const int r = e >> 6, c = e & 63, t = m0_ + r;
            const float rs = row_rstd(ssq, t);
            const float gv = Cs[0][r][c] * rs, uv = Cs[1][r][c] * rs;
            act[(size_t)t * FF + n0_ + c] = f2bf(gv * sigmoidf_(gv) * uv);
        }
    };
    tgemm<2>(m0, n0, DM, al, bl, epi);
}
__global__ void __launch_bounds__(256) k_ffn_down(const bf16_t* act, const float* wd, const float* xin, float* out, const float* gnext, bf16_t* xn) {
    const int m0 = blockIdx.y * 64, n0 = blockIdx.x * 64;
    auto al = [&](int m, int k) { return bf2f(act[(size_t)m * FF + k]); };
    auto bl = [&](int b, int k, int n) { return wd[(size_t)k * DM + n]; };
    auto epi = [&](float (*Cs)[64][65], int m0_, int n0_) {
        for (int e = threadIdx.x; e < 64 * 64; e += 256) {
            const int r = e >> 6, c = e & 63, t = m0_ + r, n = n0_ + c;
            const float o = xin[(size_t)t * DM + n] + 0.5f * Cs[0][r][c];
            out[(size_t)t * DM + n] = o;
            if (xn) xn[(size_t)t * DM + n] = f2bf(o * gnext[n]);
        }
    };
    tgemm<1>(m0, n0, FF, al, bl, epi);
}

__device__ __forceinline__ int win_origcol(int v) {
    if (v < 1280) return v;
    if (v < 1792) return 1304 + (v - 1280);
    if (v < 2816) return 1816 + (v - 1792);
    if (v < 3840) return 2840 + (v - 2816);
    if (v < 3864) return 1280 + (v - 3840);
    return -1;
}
struct WinOut {
    bf16_t *q, *ks, *vs, *kw, *vw, *kcr, *vcr, *acat, *sgn, *sgs; float* g3;
    const float *q_norm, *k_norm_slc, *k_norm_win;
};
__global__ void __launch_bounds__(256) k_win_proj(const bf16_t* xn, const float* ssq, const float* win, WinOut o, int skip_lo, int skip_hi) {
    const int m0 = blockIdx.y * 64, nt = blockIdx.x, n0 = nt * 64;
    if (nt > 60) return;
    if (nt >= skip_lo && nt < skip_hi) return;
    auto al = [&](int m, int k) { return bf2f(xn[(size_t)m * DM + k]); };
    auto bl = [&](int b, int k, int n) { const int oc = win_origcol(n); return oc >= 0 ? win[(size_t)k * INW + oc] : 0.f; };
    auto epi = [&](float (*Cs)[64][65], int m0_, int n0_) {
        const int tid = threadIdx.x;
        if (tid >= 64) return;
        const int r = tid, t = m0_ + r, b = t / SEQ, s = t % SEQ;
        const float rs = row_rstd(ssq, t);
        float v[64];
#pragma unroll
        for (int c = 0; c < 64; ++c) v[c] = Cs[0][r][c] * rs;
        if (nt < 8 || nt == 12 || nt == 13 || nt == 16 || nt == 17) {
            float ss = 0.f;
#pragma unroll
            for (int c = 0; c < 64; ++c) ss += v[c] * v[c];
            const float rn = rsqrtf(ss * (1.f / 64.f) + RMS_EPS);
            if (nt < 8) { bf16_t* dst = o.q + (((size_t)b * NH + nt) * SEQ + s) * 64;
#pragma unroll
                for (int c = 0; c < 64; ++c) dst[c] = f2bf(v[c] * rn * o.q_norm[c] * C2); }
            else { const bool isS = nt < 16; const int g = isS ? nt - 12 : nt - 16; bf16_t* dst = (isS ? o.ks : o.kw) + (((size_t)b * NG + g) * SEQ + s) * 64; const float* gn = isS ? o.k_norm_slc : o.k_norm_win;
#pragma unroll
                for (int c = 0; c < 64; ++c) dst[c] = f2bf(v[c] * rn * gn[c]); }
        } else if (nt < 20) {
            bf16_t* base; int g;
            if (nt < 10) { base = o.kcr; g = nt - 8; } else if (nt < 12) { base = o.vcr; g = nt - 10; } else if (nt < 16) { base = o.vs; g = nt - 14; } else { base = o.vw; g = nt - 18; }
            bf16_t* dst = base + (((size_t)b * NG + g) * SEQ + s) * 64;
#pragma unroll
            for (int c = 0; c < 64; ++c) dst[c] = f2bf(v[c]);
        } else if (nt < 28) {
#pragma unroll
            for (int c = 0; c < 64; ++c) { const int ch = 64 * (nt - 20) + c, g = ch >> 4, ci = ch & 15;
                o.acat[((size_t)g * 512 + b * 64 + (s >> 6)) * ACAT_LD + (s & 63) * 16 + ci] = f2bf(v[c]); }
        } else if (nt < 60) {
            const bool isN = nt < 44; bf16_t* dst = (isN ? o.sgn : o.sgs) + (size_t)t * DM + (isN ? nt - 28 : nt - 44) * 64;
#pragma unroll
            for (int c = 0; c < 64; ++c) dst[c] = f2bf(sigmoidf_(v[c]));
        } else {
#pragma unroll
            for (int c = 0; c < 24; ++c) o.g3[(size_t)t * 24 + c] = sigmoidf_(v[c]);
        }
    };
    tgemm<1>(m0, n0, DM, al, bl, epi);
}

__global__ void __launch_bounds__(256) k_cmp_l1(const bf16_t* kcr, const bf16_t* vcr, const float* posk, const float* posv, const float* w1k, const float* w1v, bf16_t* hid) {
    const int kv = blockIdx.z, m0 = blockIdx.y * 64, n0 = blockIdx.x * 64;
    const bf16_t* src = kv ? vcr : kcr; const float* pos = kv ? posv : posk; const float* w1 = kv ? w1v : w1k;
    auto al = [&](int m, int k) { const int bg = m >> 8, c = m & 255, s = k >> 6, d = k & 63, tok = 16 * c + s;
        if (tok >= SEQ) return 0.f; return bf2f(src[((size_t)bg * SEQ + tok) * 64 + d]) + pos[k]; };
    auto bl = [&](int b, int k, int n) { return w1[(size_t)k * 256 + n]; };
    auto epi = [&](float (*Cs)[64][65], int m0_, int n0_) {
        for (int e = threadIdx.x; e < 64 * 64; e += 256) { const int r = e >> 6, c = e & 63;
            hid[((size_t)kv * 4096 + m0_ + r) * 256 + n0_ + c] = f2bf(gelu_tanh(Cs[0][r][c])); }
    };
    tgemm<1>(m0, n0, 2048, al, bl, epi);
}
__global__ void __launch_bounds__(256) k_cmp_l2(const bf16_t* hid, const float* w2k, const float* w2v, const float* knorm, bf16_t* kcmp, bf16_t* vcmp) {
    const int gw = blockIdx.x * 4 + (threadIdx.x >> 6), lane = threadIdx.x & 63;
    const int kv = gw >> 12, m = gw & 4095;
    const float* w2 = kv ? w2v : w2k; const bf16_t* h = hid + ((size_t)kv * 4096 + m) * 256;
    float acc = 0.f;
    for (int k = 0; k < 256; ++k) acc += bf2f(h[k]) * w2[k * 64 + lane];
    if (!kv) { const float ss = wave_sum(acc * acc); acc = acc * rsqrtf(ss * (1.f / 64.f) + RMS_EPS) * knorm[lane]; }
    if ((m & 255) == 255) acc = 0.f;
    (kv ? vcmp : kcmp)[(size_t)m * 64 + lane] = f2bf(acc);
}

constexpr int SSMP_AB = 0, SSMP_BB = SSM_G * SSM_P * 2;
__global__ void k_ssm_params(const float* lre, const float* lim, const float* lstep, const float* bre, const float* bim, float* sp) {
    const int g = blockIdx.x, p = threadIdx.x;
    const double lr = lre[g * 64 + p], li = lim[g * 64 + p], step = exp((double)lstep[g]);
    const double mag = exp(lr * step), ar = mag * cos(li * step), ai = mag * sin(li * step);
    const double den = lr * lr + li * li, cr = ((ar - 1.0) * lr + ai * li) / den, ci = (ai * lr - (ar - 1.0) * li) / den;
    sp[SSMP_AB + (g * 64 + p) * 2 + 0] = (float)ar; sp[SSMP_AB + (g * 64 + p) * 2 + 1] = (float)ai;
    for (int c = 0; c < 16; ++c) { const double br = bre[(g * 64 + p) * 16 + c], bi = bim[(g * 64 + p) * 16 + c];
        sp[SSMP_BB + ((g * 64 + p) * 16 + c) * 2 + 0] = (float)(cr * br - ci * bi); sp[SSMP_BB + ((g * 64 + p) * 16 + c) * 2 + 1] = (float)(cr * bi + ci * br); }
}
__global__ void __launch_bounds__(64) k_ssm_scan(const bf16_t* acat, const float* sp, const float* cre, const float* cim, const float* dsk, bf16_t* geluy) {
    __shared__ float Cre[16][65], Cim[16][65], U[64][16], XR[64], XI[64];
    const int b = blockIdx.x / SSM_G, g = blockIdx.x % SSM_G, p = threadIdx.x;
    for (int e = p; e < 16 * 64; e += 64) { Cre[e >> 6][e & 63] = cre[(g * 16 + (e >> 6)) * 64 + (e & 63)]; Cim[e >> 6][e & 63] = cim[(g * 16 + (e >> 6)) * 64 + (e & 63)]; }
    const float ar = sp[SSMP_AB + (g * 64 + p) * 2], ai = sp[SSMP_AB + (g * 64 + p) * 2 + 1];
    float br[16], bi[16];
#pragma unroll
    for (int c = 0; c < 16; ++c) { br[c] = sp[SSMP_BB + ((g * 64 + p) * 16 + c) * 2]; bi[c] = sp[SSMP_BB + ((g * 64 + p) * 16 + c) * 2 + 1]; }
    const int co = p & 15, qd = p >> 4; const float dv = dsk[g * 16 + co];
    float xr = 0.f, xi = 0.f;
    for (int ch = 0; ch < 64; ++ch) {
        __syncthreads();
        const bf16_t* urow = acat + ((size_t)g * 512 + b * 64 + ch) * ACAT_LD;
        for (int e = p; e < 1024; e += 64) U[e >> 4][e & 15] = bf2f(urow[e]);
        __syncthreads();
        for (int i = 0; i < 64; ++i) {
            float ur = 0.f, ui = 0.f;
#pragma unroll
            for (int c = 0; c < 16; ++c) { ur += br[c] * U[i][c]; ui += bi[c] * U[i][c]; }
            const float nr = ar * xr - ai * xi + ur, ni = ar * xi + ai * xr + ui; xr = nr; xi = ni;
            XR[p] = xr; XI[p] = xi;
            __syncthreads();
            float y = 0.f;
#pragma unroll
            for (int pp = 0; pp < 16; ++pp) { const int P_ = qd * 16 + pp; y += Cre[co][P_] * XR[P_] - Cim[co][P_] * XI[P_]; }
            y += __shfl_xor(y, 16); y += __shfl_xor(y, 32);
            if (qd == 0) { y += dv * U[i][co]; geluy[((size_t)b * SEQ + ch * 64 + i) * 512 + g * 16 + co] = f2bf(gelu_tanh(y)); }
            __syncthreads();
        }
    }
}

__global__ void __launch_bounds__(256) k_win_attn(const bf16_t* q, const bf16_t* kw, const bf16_t* vw, const float* g3, bf16_t* owin) {
    const int gw = blockIdx.x * 4 + (threadIdx.x >> 6), lane = threadIdx.x & 63;
    const int t = gw >> 3, h = gw & 7, b = t / SEQ, s = t % SEQ, g = h >> 2;
    const float qv = bf2f(q[(((size_t)b * NH + h) * SEQ + s) * 64 + lane]);
    const bf16_t* K = kw + ((size_t)b * NG + g) * SEQ * 64; const bf16_t* V = vw + ((size_t)b * NG + g) * SEQ * 64;
    float m = -1e30f, l = 0.f, acc = 0.f;
    const int k0 = s - 511 < 0 ? 0 : s - 511;
    for (int k = k0; k <= s; ++k) {
        const float sc = wave_sum(qv * bf2f(K[(size_t)k * 64 + lane]));
        const float mn = fmaxf(m, sc), f = exp2f(m - mn), p = exp2f(sc - mn);
        l = l * f + p; acc = acc * f + p * bf2f(V[(size_t)k * 64 + lane]); m = mn;
    }
    owin[(size_t)t * 512 + h * 64 + lane] = f2bf(g3[(size_t)t * 24 + 16 + h] * acc / l);
}

__global__ void __launch_bounds__(256) k_cmp_slc_attn(const bf16_t* q, const bf16_t* kcmp, const bf16_t* vcmp, const bf16_t* ks, const bf16_t* vs, const float* g3, const bf16_t* owin, bf16_t* onsa) {
    __shared__ float Ps[4][4][256];
    __shared__ float Sc[4][1024];
    const int w = threadIdx.x >> 6, lane = threadIdx.x & 63;
    const int gw = blockIdx.x * 4 + w, t = gw >> 1, g = gw & 1, b = t / SEQ, s = t % SEQ, qblk = s >> 6;
    const bf16_t* KC = kcmp + ((size_t)b * NG + g) * 256 * 64; const bf16_t* VC = vcmp + ((size_t)b * NG + g) * 256 * 64;
    const bf16_t* KS = ks + ((size_t)b * NG + g) * SEQ * 64; const bf16_t* VS = vs + ((size_t)b * NG + g) * SEQ * 64;
    const int ncv = (s >= 31) ? ((s - 31) >> 4) + 1 : 0;
    __shared__ float Ocmp[4][4][64];
    for (int r = 0; r < 4; ++r) {
        const bf16_t* qp = q + (((size_t)b * NH + g * 4 + r) * SEQ + s) * 64;
        float sc[4]; float mx = -1e30f;
#pragma unroll
        for (int j = 0; j < 4; ++j) { const int c = lane + 64 * j; float a = -1e30f;
            if (c < ncv) { a = 0.f; for (int d = 0; d < 64; ++d) a += bf2f(qp[d]) * bf2f(KC[(size_t)c * 64 + d]); }
            sc[j] = a; mx = fmaxf(mx, a); }
        mx = wave_max(mx); float den = 0.f;
#pragma unroll
        for (int j = 0; j < 4; ++j) { const int c = lane + 64 * j; sc[j] = (c < ncv) ? exp2f(sc[j] - mx) : 0.f; den += sc[j]; }
        den = wave_sum(den); const float inv = den > 0.f ? 1.f / den : 1.f;
#pragma unroll
        for (int j = 0; j < 4; ++j) Ps[w][r][lane + 64 * j] = sc[j] * inv;
        __syncthreads();
        float a = 0.f;
        for (int c = 0; c < ncv; ++c) a += Ps[w][r][c] * bf2f(VC[(size_t)c * 64 + lane]);
        Ocmp[w][r][lane] = a;
    }
    __syncthreads();
    float imp = 0.f;
    for (int r = 0; r < 4; ++r) for (int c = 4 * lane - 1; c <= 4 * lane + 3; ++c) if (c >= 0 && c < NCMP) imp += Ps[w][r][c];
    const bool force = (lane == 0) || (lane == qblk) || (lane == qblk - 1);
    const float score = (lane <= qblk) ? imp + (force ? 1000.f : 0.f) : -1e30f;
    int rank = 0;
    for (int j = 0; j < 64; ++j) { const float o = __shfl(score, j); rank += (o > score || (o == score && j < lane)) ? 1 : 0; }
    const unsigned long long selmask = __ballot(rank < 16 && lane <= qblk);
    for (int r = 0; r < 4; ++r) {
        const bf16_t* qp = q + (((size_t)b * NH + g * 4 + r) * SEQ + s) * 64;
        int nb = 0; float mx = -1e30f;
        for (int j = 0; j < 64; ++j) if ((selmask >> j) & 1ull) {
            const int key = 64 * j + lane; float a = -1e30f;
            if (key <= s) { a = 0.f; for (int d = 0; d < 64; ++d) a += bf2f(qp[d]) * bf2f(KS[(size_t)key * 64 + d]); }
            Sc[w][nb * 64 + lane] = a; mx = fmaxf(mx, a); ++nb;
        }
        mx = wave_max(mx); float den = 0.f;
        for (int i = 0; i < nb; ++i) { const float a = Sc[w][i * 64 + lane]; const float p = (a > -1e29f) ? exp2f(a - mx) : 0.f; Sc[w][i * 64 + lane] = p; den += p; }
        den = wave_sum(den); const float inv = den > 0.f ? 1.f / den : 1.f;
        __syncthreads();
        float a = 0.f; nb = 0;
        for (int j = 0; j < 64; ++j) if ((selmask >> j) & 1ull) {
            for (int kk = 0; kk < 64; ++kk) { const float p = Sc[w][nb * 64 + kk]; if (p != 0.f) a += p * bf2f(VS[(size_t)(64 * j + kk) * 64 + lane]); }
            ++nb;
        }
        const int h = g * 4 + r;
        const float o = g3[(size_t)t * 24 + h] * Ocmp[w][r][lane] + g3[(size_t)t * 24 + 8 + h] * (a * inv) + bf2f(owin[(size_t)t * 512 + h * 64 + lane]);
        onsa[(size_t)t * 512 + h * 64 + lane] = f2bf(o);
        __syncthreads();
    }
}

__global__ void __launch_bounds__(256) k_nsa_proj(const bf16_t* onsa, const float* w, const bf16_t* sgn, bf16_t* m1) {
    const int m0 = blockIdx.y * 64, n0 = blockIdx.x * 64;
    auto al = [&](int m, int k) { return bf2f(onsa[(size_t)m * 512 + k]); };
    auto bl = [&](int b, int k, int n) { return w[(size_t)k * DM + n]; };
    auto epi = [&](float (*Cs)[64][65], int m0_, int n0_) {
        for (int e = threadIdx.x; e < 64 * 64; e += 256) { const int r = e >> 6, c = e & 63; const size_t ix = (size_t)(m0_ + r) * DM + n0_ + c;
            m1[ix] = f2bf(bf2f(sgn[ix]) * Cs[0][r][c]); }
    };
    tgemm<1>(m0, n0, 512, al, bl, epi);
}
__global__ void __launch_bounds__(256) k_glu(const bf16_t* geluy, const float* w, const bf16_t* sgs, const bf16_t* m1, bf16_t* merged) {
    const int m0 = blockIdx.y * 64, n0 = blockIdx.x * 64;
    auto al = [&](int m, int k) { return bf2f(geluy[(size_t)m * 512 + k]); };
    auto bl = [&](int b, int k, int n) { return w[(size_t)k * 2048 + b * 1024 + n]; };
    auto epi = [&](float (*Cs)[64][65], int m0_, int n0_) {
        for (int e = threadIdx.x; e < 64 * 64; e += 256) { const int r = e >> 6, c = e & 63; const size_t ix = (size_t)(m0_ + r) * DM + n0_ + c;
            merged[ix] = f2bf(bf2f(m1[ix]) + bf2f(sgs[ix]) * Cs[0][r][c] * sigmoidf_(Cs[1][r][c])); }
    };
    tgemm<2>(m0, n0, 512, al, bl, epi);
}
__global__ void __launch_bounds__(256) k_wout(const bf16_t* merged, const float* w, float* out, const float* gnext, bf16_t* xn) {
    const int m0 = blockIdx.y * 64, n0 = blockIdx.x * 64;
    auto al = [&](int m, int k) { return bf2f(merged[(size_t)m * DM + k]); };
    auto bl = [&](int b, int k, int n) { return w[(size_t)k * DM + n]; };
    auto epi = [&](float (*Cs)[64][65], int m0_, int n0_) {
        for (int e = threadIdx.x; e < 64 * 64; e += 256) { const int r = e >> 6, c = e & 63; const size_t ix = (size_t)(m0_ + r) * DM + n0_ + c;
            const float o = out[ix] + Cs[0][r][c]; out[ix] = o; xn[ix] = f2bf(o * gnext[n0_ + c]); }
    };
    tgemm<1>(m0, n0, DM, al, bl, epi);
}

static void launch_mega(const Args& a0, int lo, int hi, int fused, int grid, hipStream_t stream, int aflags = 7) {
    Args a = a0; a.ph_lo = lo; a.ph_hi = hi; a.fused = fused; a.pad = aflags;
    hipLaunchKernelGGL(mega, dim3(grid), dim3(NWAVES * 64), LDS_BYTES, stream, a);
}
extern "C" void kernel_launch(void* const* d_in, const int* in_sizes, int n_in, void* d_out, int out_size, void* d_ws, size_t ws_size, hipStream_t stream) {
    static int grid = 0;
    if (grid == 0) {
        if (n_in != 32 || out_size != T * DM || ws_size < WS_END) { fprintf(stderr, "kernel_launch: unexpected shapes n_in %d out %d ws %zu\n", n_in, out_size, ws_size); grid = -1; return; }
        int dev = 0, cus = 0;
        if (hipGetDevice(&dev) != hipSuccess || hipDeviceGetAttribute(&cus, hipDeviceAttributeMultiprocessorCount, dev) != hipSuccess) { grid = -1; return; }
        if (hipFuncSetAttribute((const void*)mega, hipFuncAttributeMaxDynamicSharedMemorySize, LDS_BYTES) != hipSuccess) { fprintf(stderr, "kernel_launch: hipFuncSetAttribute failed\n"); grid = -1; return; }
        if (cus < 256) { fprintf(stderr, "kernel_launch: this kernel's unit maps need 256 co-resident workgroups (one per CU); the device has %d CUs\n", cus); grid = -1; return; }
        grid = 256;
    }
    if (grid < 0) return;
    const float* in[32]; for (int i = 0; i < 32; ++i) in[i] = (const float*)d_in[i];
    unsigned char* ws = (unsigned char*)d_ws; float* out = (float*)d_out;
    (void)hipMemsetAsync(ws + WS_CTL, 0, CTL_ZERO_BYTES, stream);
    Args a{}; for (int i = 0; i < 32; ++i) a.in[i] = in[i]; a.out = out; a.ws = ws;
    float* ssq = (float*)(ws + WS_SSQ); float* g3 = (float*)(ws + WS_G3); bf16_t* hid = (bf16_t*)(ws + WS_HID);
    bf16_t* kcmp = (bf16_t*)(ws + WS_KCMP); bf16_t* vcmp = (bf16_t*)(ws + WS_VCMP); float* ssmp = (float*)(ws + WS_SSMP);
    bf16_t* xn = (bf16_t*)(ws + WS_XN);
    WinOut wo; wo.q = (bf16_t*)(ws + WS_Q); wo.ks = (bf16_t*)(ws + WS_KS); wo.vs = (bf16_t*)(ws + WS_VS); wo.kw = (bf16_t*)(ws + WS_KW); wo.vw = (bf16_t*)(ws + WS_VW);
    wo.kcr = (bf16_t*)(ws + WS_KCR); wo.vcr = (bf16_t*)(ws + WS_VCR); wo.acat = (bf16_t*)(ws + WS_ACAT); wo.sgn = (bf16_t*)(ws + WS_SGN); wo.sgs = (bf16_t*)(ws + WS_SGS); wo.g3 = g3;
    wo.q_norm = in[7]; wo.k_norm_slc = in[9]; wo.k_norm_win = in[10];
    bf16_t* owin = (bf16_t*)(ws + WS_OWIN); bf16_t* onsa = (bf16_t*)(ws + WS_ONSA); bf16_t* geluy = (bf16_t*)(ws + WS_GELUY);
    bf16_t* m1 = (bf16_t*)(ws + WS_M1); bf16_t* merged = (bf16_t*)(ws + WS_MERGED);

#if defined(PROBE_ATT)
    for (int ph = 0; ph < NPH; ++ph) { launch_mega(a, ph, ph + 1, 0, grid, stream); if (ph == PH_MIDB) for (int r_ = 0; r_ < 4; ++r_) launch_mega(a, ph, ph + 1, 0, grid, stream, 2 | 16); }
#elif defined(PROBE_MIDB)
    for (int ph = 0; ph < NPH; ++ph) {
        if (ph == PH_MIDB && PROBE_MIDB == 4) launch_mega(a, ph, ph + 1, 0, grid, stream, 2);
        launch_mega(a, ph, ph + 1, 0, grid, stream);
        if (ph == PH_MIDB) launch_mega(a, ph, ph + 1, 0, grid, stream, PROBE_MIDB == 1 ? 4 : PROBE_MIDB == 2 ? 3 : PROBE_MIDB == 3 ? 2 : PROBE_MIDB == 5 ? 7 : 1);
    }
#elif defined(PROBE_F1D)
    for (int ph = 0; ph < NPH; ++ph) { launch_mega(a, ph, ph + 1, 0, grid, stream); if (ph == PH_F1D) launch_mega(a, ph, ph + 1, 0, grid, stream, 7 | 8); }
#elif defined(REP_PHASE)
    for (int ph = 0; ph < NPH; ++ph) for (int r = 0; r < (ph == REP_PHASE ? 2 : 1); ++r) launch_mega(a, ph, ph + 1, 0, grid, stream);
#elif defined(MK_PER_PHASE)
    for (int ph = 0; ph < NPH; ++ph) launch_mega(a, ph, ph + 1, 0, grid, stream);
#else
    launch_mega(a, 0, NPH, 1, grid, stream);
#endif
}
```

```cpp
#include <hip/hip_runtime.h>
#include <cstdint>
#include <cstdio>

typedef unsigned short bf16_t;
constexpr int BATCH = 8, SEQ = 4096, DM = 1024, T = BATCH * SEQ;
constexpr int FF = 2816, NH = 8, NG = 2, HD = 64;
constexpr int INW = 3864, NCMP = 255;
constexpr int SSM_G = 32, SSM_C = 16, SSM_P = 64;
constexpr float RMS_EPS = 1e-6f;
constexpr float C2 = 0.125f * 1.4426950408889634f;

__device__ __forceinline__ float bf2f(bf16_t v) { return __uint_as_float(((unsigned)v) << 16); }
__device__ __forceinline__ bf16_t f2bf(float f) { unsigned u = __float_as_uint(f); return (bf16_t)((u + 0x7fffu + ((u >> 16) & 1u)) >> 16); }
__device__ __forceinline__ unsigned pk2(float lo, float hi) { return (unsigned)f2bf(lo) | ((unsigned)f2bf(hi) << 16); }
__device__ __forceinline__ float sigmoidf_(float x) { return 1.f / (1.f + __expf(-x)); }
__device__ __forceinline__ float gelu_tanh(float x) { const float u = 0.7978845608028654f * (x + 0.044715f * x * x * x); return 0.5f * x * (1.f + tanhf(u)); }
__device__ __forceinline__ float fsigmoid(float x) { return __builtin_amdgcn_rcpf(1.f + __builtin_amdgcn_exp2f(-1.4426950408889634f * x)); }
__device__ __forceinline__ float fgelu_tanh(float x) { const float u = 0.7978845608028654f * (x + 0.044715f * x * x * x); return x * fsigmoid(2.f * u); }
typedef float f32x2_t __attribute__((ext_vector_type(2)));
__device__ __forceinline__ f32x2_t sig2_pre(f32x2_t t) { f32x2_t e = {__builtin_amdgcn_exp2f(t.x), __builtin_amdgcn_exp2f(t.y)}; e = e + 1.f; return (f32x2_t){__builtin_amdgcn_rcpf(e.x), __builtin_amdgcn_rcpf(e.y)}; }
__device__ __forceinline__ f32x2_t fsigmoid2(f32x2_t x) { return sig2_pre(x * -1.4426950408889634f); }
__device__ __forceinline__ f32x2_t fgelu_tanh2(f32x2_t x) { const float c1 = -2.f * 0.7978845608028654f * 1.4426950408889634f, c2 = c1 * 0.044715f; return x * sig2_pre(x * (x * x * c2 + c1)); }
__device__ __forceinline__ float wave_sum(float v) {
#pragma unroll
    for (int o = 1; o < 64; o <<= 1) v += __shfl_xor(v, o);
    return v;
}
__device__ __forceinline__ float wave_max(float v) {
#pragma unroll
    for (int o = 1; o < 64; o <<= 1) v = fmaxf(v, __shfl_xor(v, o));
    return v;
}

constexpr size_t MiB = 1u << 20;
constexpr size_t WS_CTL = 0, CTL_ZERO_BYTES = 32 * 1024;
constexpr size_t WS_W1GU = 1 * MiB;
constexpr size_t WS_W1D = 12 * MiB;
constexpr size_t WS_WIN = 18 * MiB;
constexpr size_t WS_WC1K = 26 * MiB;
constexpr size_t WS_WC1V = 27 * MiB;
constexpr size_t WS_MISC = 28 * MiB;
constexpr size_t WS_WNSA = 153 * MiB;
constexpr size_t WS_WGLU = 155 * MiB;
constexpr size_t WS_WOUT = 32 * MiB;
constexpr size_t WS_W2GU = 34 * MiB;
constexpr size_t WS_W2D = 45 * MiB;
constexpr size_t WS_W1S = 51 * MiB;
constexpr size_t WS_WTOEP = 60 * MiB;
constexpr size_t WS_KTAB = 132 * MiB;
constexpr size_t WS_SSQ = 134 * MiB;
constexpr size_t WS_G3 = 136 * MiB;
constexpr size_t WS_HID = 139 * MiB;
constexpr size_t WS_KCMP = 143 * MiB;
constexpr size_t WS_VCMP = 143 * MiB + 512 * 1024;
constexpr size_t WS_SSMP = 144 * MiB;
constexpr size_t WS_SST = 145 * MiB;
constexpr size_t WS_XN = 161 * MiB;
constexpr size_t WS_BIG = 225 * MiB;
constexpr size_t WS_ACT = WS_BIG;
constexpr size_t WS_SGN = WS_BIG;
constexpr size_t WS_SGS = WS_BIG + 64 * MiB;
constexpr size_t WS_Q = WS_BIG + 128 * MiB;
constexpr size_t WS_KS = WS_BIG + 160 * MiB;
constexpr size_t WS_VS = WS_BIG + 168 * MiB;
constexpr size_t WS_KW = WS_BIG + 176 * MiB;
constexpr size_t WS_VW = WS_BIG + 184 * MiB;
constexpr size_t WS_KCR = WS_BIG + 192 * MiB;
constexpr size_t WS_VCR = WS_BIG + 201 * MiB;
constexpr size_t WS_ACAT = WS_BIG + 210 * MiB;
constexpr size_t WS_OWIN = WS_BIG + 246 * MiB;
constexpr size_t WS_CPART = WS_OWIN;
constexpr size_t WS_M1 = WS_BIG + 128 * MiB;
constexpr size_t WS_MERGED = WS_BIG + 192 * MiB;
constexpr size_t WS_ONSA = WS_XN;
constexpr size_t WS_GELUY = WS_XN + 32 * MiB;
constexpr size_t WS_END = 512 * MiB;
constexpr int ACAT_LD = 1152;
constexpr int K5_LD = 512 + 64;
constexpr int ACT_LD = FF + 64;

namespace pg8 {
#define PG8_LAS __attribute__((address_space(3)))
typedef short bf16x8 __attribute__((ext_vector_type(8)));
typedef float f32x4 __attribute__((ext_vector_type(4)));
typedef float f32x2 __attribute__((ext_vector_type(2)));
typedef unsigned u32x4 __attribute__((ext_vector_type(4)));
typedef unsigned u32x2 __attribute__((ext_vector_type(2)));
constexpr int BM = 256, BK = 64, HALF = 128, HTB = HALF * BK * 2  , STAGE_BYTES = 8 * HTB, NXCD = 8, WGM = 8;

__host__ __device__ __forceinline__ int lds_byte(int r, int c) { const int st = (r >> 4) * 2 + (c >> 5), rr = r & 15, cc = c & 31, ob = rr * 64 + cc * 2; return st * 1024 + (ob ^ (((ob >> 9) & 1) << 5)); }
__host__ __device__ __forceinline__ void stage_rc(int b, int& R, int& C) { const int st = b / 1024, sb = b % 1024, swz = sb ^ (((sb >> 9) & 1) << 5); R = (st >> 1) * 16 + swz / 64; C = (st & 1) * 32 + (swz % 64) / 2; }
__host__ __device__ __forceinline__ int perm32(int rho) { const int n = rho >> 4, i = rho & 15; return 8 * (i >> 2) + 4 * n + (i & 3); }

struct Unit { int pm, pn, pg; };
struct Gemm { const bf16_t* A; const bf16_t* Bt; int lda, ldb, K; size_t gsA, gsB; };

struct StaticOrder {
    int nM, nN, nwg, G, c;
    __host__ __device__ __forceinline__ void init(int M, int N, int G_, int c_) { nM = M / BM; nN = N / BM; nwg = nM * nN; G = G_; c = c_; }
    __host__ __device__ __forceinline__ bool next(int i, Unit& u) const {
        const long L = (long)i * G + c; if (L >= nwg) return false;
        int wgid = (int)L; { const int q = nwg / NXCD, r = nwg % NXCD, xcd = wgid % NXCD, off = wgid / NXCD; wgid = (xcd < r ? xcd * (q + 1) : r * (q + 1) + (xcd - r) * q) + off; }
        const int nig = WGM * nN, gid = wgid / nig, fm = gid * WGM, gsz = (nM - fm) < WGM ? (nM - fm) : WGM;
        u.pm = fm + ((wgid % nig) % gsz); u.pn = (wgid % nig) / gsz; u.pg = 0; return true;
    }
};
struct GroupOrder {
    int nM, nN, ng, G, c;
    __host__ __device__ __forceinline__ void init(int nM_, int nN_, int ng_, int G_, int c_) { nM = nM_; nN = nN_; ng = ng_; G = G_; c = c_; }
    __host__ __device__ __forceinline__ bool next(int i, Unit& u) const {
        if (c < 0) return false;
        const long L = (long)i * G + c; if (L >= (long)ng * nM * nN) return false;
        const int per = nM * nN, r = (int)(L % per); u.pg = (int)(L / per); u.pm = r % nM; u.pn = r / nM; return true;
    }
};

struct SplitOrder {
    StaticOrder S;
    __host__ __device__ __forceinline__ bool next(int i, Unit& u) const { Unit t; if (!S.next(i >> 1, t)) return false; u.pm = t.pm; u.pn = 2 * t.pn + (i & 1); u.pg = 0; return true; }
};
typedef __bf16 bf16x2_t __attribute__((ext_vector_type(2)));
__device__ __forceinline__ unsigned cvt_pk_bf16(float lo, float hi) { f32x2 v = {lo, hi}; bf16x2_t b = __builtin_convertvector(v, bf16x2_t); return __builtin_bit_cast(unsigned, b); }

template <class Epi, class Sched, bool ALIGN_EPI = false, bool SP2 = false>
__device__ __forceinline__ void gemm_phase(PG8_LAS unsigned char* lds, const Gemm g, const Sched& S, const Epi& E) {
    const int tid = threadIdx.x, wid = __builtin_amdgcn_readfirstlane(tid >> 6), lane = tid & 63, wr = wid >> 2, wc = wid & 3, fr = lane & 15, fq = lane >> 4;
    const int K = g.K, nt = K / BK;
    unsigned voffA[2], voffB[2];
#pragma unroll
    for (int i = 0; i < 2; ++i) { int R, C; stage_rc(tid * 16 + i * 8192, R, C); const int Rb = Epi::PERM ? ((R & ~31) + perm32(R & 31)) : R;
        voffA[i] = (unsigned)(R * g.lda + C) * 2u; voffB[i] = (unsigned)(Rb * g.ldb + C) * 2u; }
    const size_t kstep = (size_t)(BK * 2);
    const size_t hstepA = (size_t)HALF * g.lda * 2, hstepB = (size_t)HALF * g.ldb * 2;
    const size_t tstepA = 2 * hstepA, tstepB = 2 * hstepB;
    const unsigned ldsw = (unsigned)wid * 1024u;
    const int aoff = lds_byte(wr * 64 + fr, fq * 8), boff = lds_byte(wc * 32 + fr, fq * 8);
#define PG8_SA(b, h) (((b) * 2 + (h)) * HTB)
#define PG8_SB(b, h) ((4 + (b) * 2 + (h)) * HTB)
#define PG8_STAGE(bufoff, gbase, voff) do { _Pragma("unroll") for (int _i = 0; _i < 2; ++_i) \
        __builtin_amdgcn_global_load_lds((const unsigned*)((const char*)(gbase) + (voff)[_i]), (PG8_LAS unsigned*)(lds + (bufoff) + ldsw + _i * 8192), 16, 0, 0); } while (0)
#define PG8_LDA(dst, b, h) do { _Pragma("unroll") for (int m = 0; m < 4; ++m) _Pragma("unroll") for (int k = 0; k < 2; ++k) dst[m][k] = *(const PG8_LAS bf16x8*)(lds + PG8_SA(b, h) + aoff + m * 2048 + k * 1024); } while (0)
#define PG8_LDB(dst, b, h) do { _Pragma("unroll") for (int n = 0; n < 2; ++n) _Pragma("unroll") for (int k = 0; k < 2; ++k) dst[n][k] = *(const PG8_LAS bf16x8*)(lds + PG8_SB(b, h) + boff + n * 2048 + k * 1024); } while (0)
#define PG8_MMA(ai, bj, At, Bt) do { __builtin_amdgcn_s_setprio(1); _Pragma("unroll") for (int m = 0; m < 4; ++m) _Pragma("unroll") for (int n = 0; n < 2; ++n) _Pragma("unroll") for (int k = 0; k < 2; ++k) \
        acc[ai][bj][m][n] = __builtin_amdgcn_mfma_f32_16x16x32_bf16(Bt[n][k], At[m][k], acc[ai][bj][m][n], 0, 0, 0); __builtin_amdgcn_s_setprio(0); } while (0)
#define PG8_WAIT_V(n) asm volatile("s_waitcnt vmcnt(" #n ")" ::: "memory")
#define PG8_WAIT_L(n) asm volatile("s_waitcnt lgkmcnt(" #n ")" ::: "memory")
#define PG8_BAR __builtin_amdgcn_s_barrier()
#define PG8_SCHED __builtin_amdgcn_sched_barrier(0)
    Unit cur, nxt; int ui = 0;
    if (!S.next(0, cur)) return;
    f32x4 acc[2][2][4][2];
    if constexpr (Epi::HAS_INIT) E.init(acc, cur, wr, wc, fr, fq);
    else {
#pragma unroll
    for (int a = 0; a < 2; ++a)
#pragma unroll
        for (int b = 0; b < 2; ++b)
#pragma unroll
            for (int m = 0; m < 4; ++m)
#pragma unroll
                for (int n = 0; n < 2; ++n) acc[a][b][m][n] = (f32x4){0.f, 0.f, 0.f, 0.f};
    }
    bf16x8 At[4][2], B0[2][2], B1[2][2];
    const char* cA = (const char*)g.A + (size_t)cur.pg * g.gsA + (size_t)cur.pm * tstepA; const char* cB = (const char*)g.Bt + (size_t)cur.pg * g.gsB + (size_t)cur.pn * tstepB;
    if constexpr (SP2) {
        PG8_STAGE(PG8_SB(0, 0), cB, voffB); PG8_STAGE(PG8_SB(0, 1), cB + hstepB, voffB); PG8_STAGE(PG8_SA(0, 0), cA, voffA); PG8_STAGE(PG8_SA(0, 1), cA + hstepA, voffA);
        if (wr == 1) PG8_BAR;
        PG8_WAIT_V(2); PG8_BAR;
        PG8_STAGE(PG8_SB(1, 0), cB + kstep, voffB); PG8_STAGE(PG8_SA(1, 0), cA + kstep, voffA); PG8_STAGE(PG8_SB(1, 1), cB + hstepB + kstep, voffB);
        PG8_WAIT_V(6); PG8_BAR;
    } else {
        PG8_STAGE(PG8_SB(0, 0), cB, voffB); PG8_STAGE(PG8_SA(0, 0), cA, voffA); PG8_STAGE(PG8_SB(0, 1), cB + hstepB, voffB); PG8_STAGE(PG8_SA(0, 1), cA + hstepA, voffA);
        if (wr == 1) PG8_BAR;
        PG8_WAIT_V(4); PG8_BAR;
        PG8_STAGE(PG8_SB(1, 0), cB + kstep, voffB); PG8_STAGE(PG8_SA(1, 0), cA + kstep, voffA); PG8_STAGE(PG8_SB(1, 1), cB + hstepB + kstep, voffB);
        PG8_WAIT_V(6); PG8_BAR;
    }
    for (;;) {
        const bool has_next = S.next(ui + 1, nxt);
        const char* nA = has_next ? (const char*)g.A + (size_t)nxt.pg * g.gsA + (size_t)nxt.pm * tstepA : cA; const char* nB = has_next ? (const char*)g.Bt + (size_t)nxt.pg * g.gsB + (size_t)nxt.pn * tstepB : cB;
        for (int t = 0; t < nt; t += 2) {
            const bool last = (t == nt - 2);
            const char* a1 = cA + (size_t)(t + 1) * kstep;
            const char* a2 = last ? nA : cA + (size_t)(t + 2) * kstep; const char* b2 = last ? nB : cB + (size_t)(t + 2) * kstep;
            const char* a3 = a2 + kstep; const char* b3 = b2 + kstep;
            if constexpr (SP2) {
            PG8_LDB(B0, 0, 0); PG8_LDB(B1, 0, 1); PG8_SCHED; PG8_LDA(At, 0, 0); PG8_STAGE(PG8_SA(1, 1), a1 + hstepA, voffA);
            PG8_WAIT_V(8); PG8_WAIT_L(0); PG8_BAR; PG8_MMA(0, 0, At, B0); PG8_MMA(0, 1, At, B1); PG8_BAR; PG8_SCHED;
            PG8_LDA(At, 0, 1); PG8_STAGE(PG8_SB(0, 0), b2, voffB); PG8_STAGE(PG8_SB(0, 1), b2 + hstepB, voffB); PG8_STAGE(PG8_SA(0, 0), a2, voffA);
            PG8_WAIT_V(8); PG8_WAIT_L(0); PG8_BAR; PG8_MMA(1, 0, At, B0); PG8_MMA(1, 1, At, B1); PG8_BAR; PG8_SCHED;
            PG8_LDB(B0, 1, 0); PG8_LDB(B1, 1, 1); PG8_SCHED; PG8_LDA(At, 1, 0); PG8_STAGE(PG8_SA(0, 1), a2 + hstepA, voffA);
            PG8_WAIT_V(8); PG8_WAIT_L(0); PG8_BAR; PG8_MMA(0, 0, At, B0); PG8_MMA(0, 1, At, B1); PG8_BAR; PG8_SCHED;
            PG8_LDA(At, 1, 1); PG8_STAGE(PG8_SB(1, 0), b3, voffB); PG8_STAGE(PG8_SB(1, 1), b3 + hstepB, voffB); PG8_STAGE(PG8_SA(1, 0), a3, voffA);
            PG8_WAIT_V(8); PG8_WAIT_L(0); PG8_BAR; PG8_MMA(1, 0, At, B0); PG8_MMA(1, 1, At, B1); PG8_BAR; PG8_SCHED;
            } else {
            PG8_LDB(B0, 0, 0); PG8_SCHED; PG8_LDA(At, 0, 0); PG8_STAGE(PG8_SA(1, 1), a1 + hstepA, voffA);
            PG8_WAIT_L(8); PG8_BAR; PG8_WAIT_L(0); PG8_MMA(0, 0, At, B0); PG8_BAR; PG8_SCHED;
            PG8_LDB(B1, 0, 1); PG8_STAGE(PG8_SB(0, 0), b2, voffB);
            PG8_BAR; PG8_WAIT_L(0); PG8_MMA(0, 1, At, B1); PG8_BAR;
            PG8_LDA(At, 0, 1); PG8_STAGE(PG8_SA(0, 0), a2, voffA);
            PG8_BAR; PG8_WAIT_L(0); PG8_MMA(1, 0, At, B0); PG8_BAR; PG8_SCHED;
            PG8_STAGE(PG8_SB(0, 1), b2 + hstepB, voffB);
            PG8_WAIT_V(6); PG8_BAR; PG8_MMA(1, 1, At, B1); PG8_BAR;
            PG8_LDB(B0, 1, 0); PG8_SCHED; PG8_LDA(At, 1, 0); PG8_STAGE(PG8_SA(0, 1), a2 + hstepA, voffA);
            PG8_WAIT_L(8); PG8_BAR; PG8_WAIT_L(0); PG8_MMA(0, 0, At, B0); PG8_BAR; PG8_SCHED;
            PG8_LDB(B1, 1, 1); PG8_STAGE(PG8_SB(1, 0), b3, voffB);
            PG8_BAR; PG8_WAIT_L(0); PG8_MMA(0, 1, At, B1); PG8_BAR;
            PG8_LDA(At, 1, 1); PG8_STAGE(PG8_SA(1, 0), a3, voffA);
            PG8_BAR; PG8_WAIT_L(0); PG8_MMA(1, 0, At, B0); PG8_BAR; PG8_SCHED;
            PG8_STAGE(PG8_SB(1, 1), b3 + hstepB, voffB);
            PG8_WAIT_V(6); PG8_BAR; PG8_MMA(1, 1, At, B1); PG8_BAR;
            }
        }
        if constexpr (ALIGN_EPI) { if (wr == 0) PG8_BAR; }
        if constexpr (!Epi::AFTER_DRAIN) { E(acc, cur, wr, wc, fr, fq); }
        if (!has_next) break;
        if constexpr (Epi::HAS_INIT) E.init(acc, nxt, wr, wc, fr, fq);
        else {
#pragma unroll
        for (int a = 0; a < 2; ++a)
#pragma unroll
            for (int b = 0; b < 2; ++b)
#pragma unroll
                for (int m = 0; m < 4; ++m)
#pragma unroll
                    for (int n = 0; n < 2; ++n) acc[a][b][m][n] = (f32x4){0.f, 0.f, 0.f, 0.f};
        }
        cur = nxt; cA = nA; cB = nB; ++ui;
        if constexpr (ALIGN_EPI) { if (wr == 1) PG8_BAR; }
    }
    PG8_WAIT_V(0);
    if constexpr (!ALIGN_EPI) { if (wr == 0) PG8_BAR; }
    PG8_BAR;
    if constexpr (Epi::AFTER_DRAIN) { E.fused(acc, cur, wr, wc, fr, fq, lds, wid, lane); }
#undef PG8_SA
#undef PG8_SB
#undef PG8_STAGE
#undef PG8_LDA
#undef PG8_LDB
#undef PG8_MMA
#undef PG8_WAIT_V
#undef PG8_WAIT_L
#undef PG8_BAR
#undef PG8_SCHED
}
}
#define PG8_SP2 true
#define PG8_ALIGN true

namespace epi {
using pg8::f32x4; using pg8::u32x4; using pg8::u32x2; using pg8::Unit; using pg8::cvt_pk_bf16;
constexpr int HALF = 128, BM = 256;

__device__ __forceinline__ float rstd_row(const float* ssq, int row, int fq) {
    const f32x4 p = *(const f32x4*)(ssq + (size_t)row * 16 + 4 * fq);
    float s = (p[0] + p[1]) + (p[2] + p[3]);
    s += __shfl_xor(s, 16); s += __shfl_xor(s, 32);
    return rsqrtf(s * (1.f / DM) + RMS_EPS);
}
__device__ __forceinline__ void rstd8(const float* ssq, int row0, int fq, float (&rs)[8]) {
    f32x4 p[8];
#pragma unroll
    for (int i = 0; i < 8; ++i) p[i] = *(const f32x4*)(ssq + (size_t)(row0 + (i >> 2) * HALF + (i & 3) * 16) * 16 + 4 * fq);
#pragma unroll
    for (int i = 0; i < 8; ++i) { float s = (p[i][0] + p[i][1]) + (p[i][2] + p[i][3]); s += __shfl_xor(s, 16); s += __shfl_xor(s, 32); rs[i] = rsqrtf(s * (1.f / DM) + RMS_EPS); }
}
__device__ __forceinline__ void rstd8_cached(const float* ssq, int pm, int& cached_pm, PG8_LAS float* tab, int row0, int wr, int wc, int fr, int fq, float (&rs)[8]) {
    PG8_LAS f32x4* mine = (PG8_LAS f32x4*)(tab + (((wr * 4 + wc) * 64 + fq * 16 + fr) * 8));
    if (pm != cached_pm) { rstd8(ssq, row0, fq, rs); mine[0] = (f32x4){rs[0], rs[1], rs[2], rs[3]}; mine[1] = (f32x4){rs[4], rs[5], rs[6], rs[7]}; cached_pm = pm; }
    else { const f32x4 a = mine[0], b = mine[1]; rs[0] = a[0]; rs[1] = a[1]; rs[2] = a[2]; rs[3] = a[3]; rs[4] = b[0]; rs[5] = b[1]; rs[6] = b[2]; rs[7] = b[3]; }
}
__device__ __forceinline__ u32x4 pack8(const f32x4& a, const f32x4& b) { u32x4 w; w.x = cvt_pk_bf16(a[0], a[1]); w.y = cvt_pk_bf16(a[2], a[3]); w.z = cvt_pk_bf16(b[0], b[1]); w.w = cvt_pk_bf16(b[2], b[3]); return w; }

struct EpiSwiGLU {
    static constexpr bool PERM = true, AFTER_DRAIN = false, HAS_INIT = false;
    bf16_t* act; const float* ssq; PG8_LAS float* rs_tab; mutable int cached_pm;
    __device__ __forceinline__ void operator()(const f32x4 (&acc)[2][2][4][2], const Unit& u, int wr, int wc, int fr, int fq) const {
        const int row0 = u.pm * BM + wr * 64 + fr, col0 = u.pn * HALF + wc * 32 + 8 * fq;
        float rs8[8]; rstd8_cached(ssq, u.pm, cached_pm, rs_tab, row0, wr, wc, fr, fq, rs8);
#pragma unroll
        for (int ai = 0; ai < 2; ++ai)
#pragma unroll
            for (int m = 0; m < 4; ++m) { const int row = row0 + ai * HALF + m * 16; const float rs = rs8[ai * 4 + m];
                f32x4 o[2]; const float nrs = -1.4426950408889634f * rs, rs2 = rs * rs;
#pragma unroll
                for (int n = 0; n < 2; ++n)
#pragma unroll
                    for (int j = 0; j < 4; j += 2) { const f32x2_t g2 = {acc[ai][0][m][n][j], acc[ai][0][m][n][j + 1]}, u2 = {acc[ai][1][m][n][j], acc[ai][1][m][n][j + 1]};
                        const f32x2_t r2 = (g2 * u2) * (sig2_pre(g2 * nrs) * rs2); o[n][j] = r2.x; o[n][j + 1] = r2.y; }
                *(u32x4*)(act + (size_t)row * ACT_LD + col0) = pack8(o[0], o[1]); }
    }
};

__device__ __forceinline__ void unpack8(const u32x4& w, f32x4& a, f32x4& b) {
    a[0] = __uint_as_float(w.x << 16); a[1] = __uint_as_float(w.x & 0xffff0000u); a[2] = __uint_as_float(w.y << 16); a[3] = __uint_as_float(w.y & 0xffff0000u);
    b[0] = __uint_as_float(w.z << 16); b[1] = __uint_as_float(w.z & 0xffff0000u); b[2] = __uint_as_float(w.w << 16); b[3] = __uint_as_float(w.w & 0xffff0000u);
}
template <bool IN_BF16, bool OUT_F32>
struct EpiResid {
    static constexpr bool PERM = true, AFTER_DRAIN = false, HAS_INIT = true;
    const float* xin; const bf16_t* xb_in; float* out; float alpha; bf16_t* xb_out; float* ssq;
    __device__ __forceinline__ void init(f32x4 (&acc)[2][2][4][2], const Unit& u, int wr, int wc, int fr, int fq) const {
        const int row0 = u.pm * BM + wr * 64 + fr, col0 = u.pn * BM + wc * 32 + 8 * fq; const float ia = 1.f / alpha;
        if constexpr (IN_BF16) {
            u32x4 t[2][4][2];
#pragma unroll
            for (int ai = 0; ai < 2; ++ai)
#pragma unroll
                for (int m = 0; m < 4; ++m)
#pragma unroll
                    for (int bj = 0; bj < 2; ++bj) t[ai][m][bj] = *(const u32x4*)(xb_in + (size_t)(row0 + ai * HALF + m * 16) * DM + col0 + bj * HALF);
#pragma unroll
            for (int ai = 0; ai < 2; ++ai)
#pragma unroll
                for (int m = 0; m < 4; ++m)
#pragma unroll
                    for (int bj = 0; bj < 2; ++bj) { f32x4 a, b; unpack8(t[ai][m][bj], a, b); acc[ai][bj][m][0] = a * ia; acc[ai][bj][m][1] = b * ia; }
        } else {
#pragma unroll
            for (int ai = 0; ai < 2; ++ai)
#pragma unroll
                for (int m = 0; m < 4; ++m)
#pragma unroll
                    for (int bj = 0; bj < 2; ++bj) { const size_t ix = (size_t)(row0 + ai * HALF + m * 16) * DM + col0 + bj * HALF;
                        acc[ai][bj][m][0] = *(const f32x4*)(xin + ix); acc[ai][bj][m][1] = *(const f32x4*)(xin + ix + 4); }
#pragma unroll
            for (int ai = 0; ai < 2; ++ai)
#pragma unroll
                for (int m = 0; m < 4; ++m)
#pragma unroll
                    for (int bj = 0; bj < 2; ++bj) { acc[ai][bj][m][0] *= ia; acc[ai][bj][m][1] *= ia; }
        }
    }
    __device__ __forceinline__ void operator()(const f32x4 (&acc)[2][2][4][2], const Unit& u, int wr, int wc, int fr, int fq) const {
        const int row0 = u.pm * BM + wr * 64 + fr, col0 = u.pn * BM + wc * 32 + 8 * fq;
#pragma unroll
        for (int ai = 0; ai < 2; ++ai)
#pragma unroll
            for (int m = 0; m < 4; ++m) { const int row = row0 + ai * HALF + m * 16; float ss = 0.f;
#pragma unroll
                for (int bj = 0; bj < 2; ++bj) { const size_t ix = (size_t)row * DM + col0 + bj * HALF;
                    const f32x4 o0 = acc[ai][bj][m][0] * alpha, o1 = acc[ai][bj][m][1] * alpha;
                    if constexpr (OUT_F32) { *(f32x4*)(out + ix) = o0; *(f32x4*)(out + ix + 4) = o1; }
                    else { *(u32x4*)(xb_out + ix) = pack8(o0, o1);
                        ss += (o0[0] * o0[0] + o0[1] * o0[1]) + (o0[2] * o0[2] + o0[3] * o0[3]) + (o1[0] * o1[0] + o1[1] * o1[1]) + (o1[2] * o1[2] + o1[3] * o1[3]); } }
                if constexpr (!OUT_F32) { ss += __shfl_xor(ss, 16); ss += __shfl_xor(ss, 32); if (fq == 0) ssq[(size_t)row * 16 + u.pn * 4 + wc] = ss; } }
    }
};

__device__ __forceinline__ void unpack8u(const u32x2& w, f32x4& a, f32x4& b) {
    const float k = 1.f / 255.f;
    a[0] = (float)(w.x & 255u) * k; a[1] = (float)((w.x >> 8) & 255u) * k; a[2] = (float)((w.x >> 16) & 255u) * k; a[3] = (float)(w.x >> 24) * k;
    b[0] = (float)(w.y & 255u) * k; b[1] = (float)((w.y >> 8) & 255u) * k; b[2] = (float)((w.y >> 16) & 255u) * k; b[3] = (float)(w.y >> 24) * k;
}
struct EpiWin {
    static constexpr bool PERM = true, AFTER_DRAIN = false, HAS_INIT = false;
    const float* ssq; bf16_t *q, *ks, *vs, *kw, *vw, *kcr, *vcr, *acat, *sgn, *sgs; float* g3; PG8_LAS float* gains  ; PG8_LAS float* rs_tab; mutable int cached_pm;
    __device__ __forceinline__ void operator()(const f32x4 (&acc)[2][2][4][2], const Unit& u, int wr, int wc, int fr, int fq) const {
        const int row0 = u.pm * BM + wr * 64 + fr, pn = u.pn;
        float rs8[8]; rstd8_cached(ssq, u.pm, cached_pm, rs_tab, row0, wr, wc, fr, fq, rs8);
        if (pn < 5) {
            const int slot = 4 * pn + wc;
            bf16_t* base; int nh, idx; PG8_LAS const float* gain = nullptr; float scale = 1.f;
            if (slot < 8) { base = q; nh = NH; idx = slot; gain = gains; scale = C2; }
            else if (slot < 10) { base = kcr; nh = NG; idx = slot - 8; }
            else if (slot < 12) { base = vcr; nh = NG; idx = slot - 10; }
            else if (slot < 14) { base = ks; nh = NG; idx = slot - 12; gain = gains + 64; }
            else if (slot < 16) { base = vs; nh = NG; idx = slot - 14; }
            else if (slot < 18) { base = kw; nh = NG; idx = slot - 16; gain = gains + 128; }
            else { base = vw; nh = NG; idx = slot - 18; }
            f32x4 gv[2][2];
#pragma unroll
            for (int bj = 0; bj < 2; ++bj)
#pragma unroll
                for (int n = 0; n < 2; ++n) gv[bj][n] = gain ? *(PG8_LAS const f32x4*)(gain + 32 * bj + 8 * fq + 4 * n) * scale : (f32x4){1.f, 1.f, 1.f, 1.f};
#pragma unroll
            for (int ai = 0; ai < 2; ++ai)
#pragma unroll
                for (int m = 0; m < 4; ++m) { const int row = row0 + ai * HALF + m * 16; const float rs = rs8[ai * 4 + m]; const int b = row / SEQ, s = row % SEQ;
                    f32x4 v[2][2]; float ss = 0.f;
#pragma unroll
                    for (int bj = 0; bj < 2; ++bj)
#pragma unroll
                        for (int n = 0; n < 2; ++n) { v[bj][n] = acc[ai][bj][m][n] * rs; ss += (v[bj][n][0] * v[bj][n][0] + v[bj][n][1] * v[bj][n][1]) + (v[bj][n][2] * v[bj][n][2] + v[bj][n][3] * v[bj][n][3]); }
                    float rn = 1.f;
                    if (gain) { ss += __shfl_xor(ss, 16); ss += __shfl_xor(ss, 32); rn = rsqrtf(ss * (1.f / 64.f) + RMS_EPS); }
                    bf16_t* dst = base + (((size_t)b * nh + idx) * SEQ + s) * 64 + 8 * fq;
#pragma unroll
                    for (int bj = 0; bj < 2; ++bj) *(u32x4*)(dst + 32 * bj) = pack8(v[bj][0] * gv[bj][0] * rn, v[bj][1] * gv[bj][1] * rn); }
        } else if (pn < 7) {
#pragma unroll
            for (int ai = 0; ai < 2; ++ai)
#pragma unroll
                for (int m = 0; m < 4; ++m) { const int row = row0 + ai * HALF + m * 16; const float rs = rs8[ai * 4 + m]; const int b = row / SEQ, s = row % SEQ;
#pragma unroll
                    for (int bj = 0; bj < 2; ++bj) { const int ch0 = 256 * (pn - 5) + 128 * bj + 32 * wc + 8 * fq, g = ch0 >> 4, ci0 = ch0 & 15;
                        *(u32x4*)(acat + ((size_t)g * 512 + b * 64 + (s >> 6)) * ACAT_LD + (s & 63) * 16 + ci0) = pack8(acc[ai][bj][m][0] * rs, acc[ai][bj][m][1] * rs); } }
        } else if (pn < 15) {
            unsigned char* dstb = (unsigned char*)(pn < 11 ? sgn : sgs) + 256 * (pn - (pn < 11 ? 7 : 11)) + 32 * wc + 8 * fq;
#pragma unroll
            for (int ai = 0; ai < 2; ++ai)
#pragma unroll
                for (int m = 0; m < 4; ++m) { const int row = row0 + ai * HALF + m * 16; const float rs = rs8[ai * 4 + m];
#pragma unroll
                    for (int bj = 0; bj < 2; ++bj) { f32x4 a, b2; const float nrs = -1.4426950408889634f * rs;
#pragma unroll
                        for (int j = 0; j < 4; j += 2) { const f32x2_t x0 = {acc[ai][bj][m][0][j], acc[ai][bj][m][0][j + 1]}, x1 = {acc[ai][bj][m][1][j], acc[ai][bj][m][1][j + 1]};
                            const f32x2_t s0 = sig2_pre(x0 * nrs) * 255.f + 0.5f, s1 = sig2_pre(x1 * nrs) * 255.f + 0.5f; a[j] = s0.x; a[j + 1] = s0.y; b2[j] = s1.x; b2[j + 1] = s1.y; }
                        u32x2 w; w.x = (unsigned)a[0] | ((unsigned)a[1] << 8) | ((unsigned)a[2] << 16) | ((unsigned)a[3] << 24); w.y = (unsigned)b2[0] | ((unsigned)b2[1] << 8) | ((unsigned)b2[2] << 16) | ((unsigned)b2[3] << 24);
                        *(u32x2*)(dstb + (size_t)row * DM + 128 * bj) = w; } }
        } else {
#pragma unroll
            for (int ai = 0; ai < 2; ++ai)
#pragma unroll
                for (int m = 0; m < 4; ++m) { const int row = row0 + ai * HALF + m * 16; const float rs = rs8[ai * 4 + m];
                    if (wc == 0 && fq < 3) {
#pragma unroll
                        for (int n = 0; n < 2; ++n) { f32x4 a;
#pragma unroll
                            for (int j = 0; j < 4; ++j) a[j] = fsigmoid(acc[ai][0][m][n][j] * rs);
                            *(f32x4*)(g3 + (size_t)row * 24 + 8 * fq + 4 * n) = a; } } }
        }
    }
};
struct EpiNsa {
    static constexpr bool PERM = true, AFTER_DRAIN = false, HAS_INIT = false;
    const bf16_t* sgn; bf16_t* m1;
    __device__ __forceinline__ void operator()(const f32x4 (&acc)[2][2][4][2], const Unit& u, int wr, int wc, int fr, int fq) const {
        const int row0 = u.pm * BM + wr * 64 + fr, col0 = u.pn * BM + wc * 32 + 8 * fq;
        u32x2 g[2][4][2];
#pragma unroll
        for (int ai = 0; ai < 2; ++ai)
#pragma unroll
            for (int m = 0; m < 4; ++m)
#pragma unroll
                for (int bj = 0; bj < 2; ++bj) g[ai][m][bj] = *(const u32x2*)((const unsigned char*)sgn + (size_t)(row0 + ai * HALF + m * 16) * DM + col0 + bj * HALF);
#pragma unroll
        for (int ai = 0; ai < 2; ++ai) {
#pragma unroll
            for (int m = 0; m < 4; ++m)
#pragma unroll
                for (int bj = 0; bj < 2; ++bj) { const size_t ix = (size_t)(row0 + ai * HALF + m * 16) * DM + col0 + bj * HALF; f32x4 ga, gb; unpack8u(g[ai][m][bj], ga, gb);
                    *(u32x4*)(m1 + ix) = pack8(ga * acc[ai][bj][m][0], gb * acc[ai][bj][m][1]); }
        }
    }
};
struct EpiGlu {
    static constexpr bool PERM = true, AFTER_DRAIN = false, HAS_INIT = false;
    const bf16_t* sgs; const bf16_t* m1; bf16_t* merged;
    __device__ __forceinline__ void operator()(const f32x4 (&acc)[2][2][4][2], const Unit& u, int wr, int wc, int fr, int fq) const {
        const int row0 = u.pm * BM + wr * 64 + fr, col0 = u.pn * HALF + wc * 32 + 8 * fq;
        u32x2 gs[2][4]; u32x4 mm[2][4];
#pragma unroll
        for (int ai = 0; ai < 2; ++ai)
#pragma unroll
            for (int m = 0; m < 4; ++m) { const size_t ix = (size_t)(row0 + ai * HALF + m * 16) * DM + col0; gs[ai][m] = *(const u32x2*)((const unsigned char*)sgs + ix); mm[ai][m] = *(const u32x4*)(m1 + ix); }
        f32x4 pv[2][4][2];
#pragma unroll
        for (int ai = 0; ai < 2; ++ai)
#pragma unroll
            for (int m = 0; m < 4; ++m)
#pragma unroll
                for (int n = 0; n < 2; ++n)
#pragma unroll
                    for (int j = 0; j < 4; j += 2) { const f32x2_t s2 = fsigmoid2((f32x2_t){acc[ai][1][m][n][j], acc[ai][1][m][n][j + 1]}) * (f32x2_t){acc[ai][0][m][n][j], acc[ai][0][m][n][j + 1]};
                        pv[ai][m][n][j] = s2.x; pv[ai][m][n][j + 1] = s2.y; }
        __builtin_amdgcn_sched_barrier(0);
#pragma unroll
        for (int ai = 0; ai < 2; ++ai) {
#pragma unroll
            for (int m = 0; m < 4; ++m) { const size_t ix = (size_t)(row0 + ai * HALF + m * 16) * DM + col0;
                f32x4 ga, gb, ma, mb; unpack8u(gs[ai][m], ga, gb); unpack8(mm[ai][m], ma, mb);
                *(u32x4*)(merged + ix) = pack8(ma + ga * pv[ai][m][0], mb + gb * pv[ai][m][1]); }
        }
    }
};
struct EpiCmp1S {
    static constexpr bool PERM = true, AFTER_DRAIN = false, HAS_INIT = false;
    bf16_t* hid; const float* biasp; float* part; unsigned* cnt; int ks;
    __device__ __forceinline__ void operator()(const f32x4 (&acc)[2][2][4][2], const Unit& u, int wr, int wc, int fr, int fq) const {
        const int unit = u.pg * 16 + u.pm, thr = ((wr * 4 + wc) * 4 + fq) * 16 + fr;
        if (ks != 0) {
            float* dst = part + (((size_t)(unit * 3 + ks - 1) * 32) * 512 + thr) * 4;
#pragma unroll
            for (int ai = 0; ai < 2; ++ai)
#pragma unroll
                for (int bj = 0; bj < 2; ++bj)
#pragma unroll
                    for (int m = 0; m < 4; ++m)
#pragma unroll
                        for (int n = 0; n < 2; ++n) { const int slot = ((ai * 2 + bj) * 4 + m) * 2 + n;
                            asm volatile("global_store_dwordx4 %0, %1, off sc0 sc1" :: "v"(dst + (size_t)slot * 2048), "v"(acc[ai][bj][m][n]) : "memory"); }
            return;
        }
        {
            while (__hip_atomic_load(cnt + 16 * unit, __ATOMIC_ACQUIRE, __HIP_MEMORY_SCOPE_AGENT) < 3u) __builtin_amdgcn_s_sleep(8);
        }
        const int row0 = u.pm * BM + wr * 64 + fr, col0 = wc * 32 + 8 * fq;
        f32x4 bv[2][2];
#pragma unroll
        for (int bj = 0; bj < 2; ++bj)
#pragma unroll
            for (int n = 0; n < 2; ++n) { f32x4 s = {0.f, 0.f, 0.f, 0.f};
#pragma unroll
                for (int k = 0; k < 8; ++k) s += *(const f32x4*)(biasp + ((size_t)u.pg * 8 + k) * 256 + col0 + bj * HALF + 4 * n);
                bv[bj][n] = s; }
        const float* src = part + (((size_t)(unit * 3) * 32) * 512 + thr) * 4;
#pragma unroll
        for (int ai = 0; ai < 2; ++ai)
#pragma unroll
            for (int m = 0; m < 4; ++m) { const int row = row0 + ai * HALF + m * 16;
                f32x4 pp[2][2][3];
#pragma unroll
                for (int bj = 0; bj < 2; ++bj)
#pragma unroll
                    for (int n = 0; n < 2; ++n)
#pragma unroll
                        for (int q = 0; q < 3; ++q) pp[bj][n][q] = *(const f32x4*)(src + ((size_t)q * 32 + ((ai * 2 + bj) * 4 + m) * 2 + n) * 2048);
#pragma unroll
                for (int bj = 0; bj < 2; ++bj) { f32x4 a, b2;
                    const f32x4 va = ((acc[ai][bj][m][0] + pp[bj][0][0]) + (pp[bj][0][1] + pp[bj][0][2])) + bv[bj][0], vb = ((acc[ai][bj][m][1] + pp[bj][1][0]) + (pp[bj][1][1] + pp[bj][1][2])) + bv[bj][1];
#pragma unroll
                    for (int j = 0; j < 4; j += 2) { const f32x2_t a2 = fgelu_tanh2((f32x2_t){va[j], va[j + 1]}), c2 = fgelu_tanh2((f32x2_t){vb[j], vb[j + 1]}); a[j] = a2.x; a[j + 1] = a2.y; b2[j] = c2.x; b2[j + 1] = c2.y; }
                    *(u32x4*)(hid + ((size_t)u.pg * 4096 + row) * 256 + col0 + bj * HALF) = pack8(a, b2); } }
    }
};
struct EpiSst {
    static constexpr bool PERM = false, AFTER_DRAIN = false, HAS_INIT = false;
    float* S;
    __device__ __forceinline__ void operator()(const f32x4 (&acc)[2][2][4][2], const Unit& u, int wr, int wc, int fr, int fq) const {
        const int row0 = u.pm * BM + wr * 64 + fr, col0 = wc * 32 + 4 * fq;
#pragma unroll
        for (int ai = 0; ai < 2; ++ai)
#pragma unroll
            for (int m = 0; m < 4; ++m) { float* rp = S + ((size_t)u.pg * 512 + row0 + ai * HALF + m * 16) * 128 + col0;
#pragma unroll
                for (int n = 0; n < 2; ++n) *(f32x4*)(rp + 16 * n) = acc[ai][0][m][n]; }
    }
};
struct EpiSsmOut {
    static constexpr bool PERM = true, AFTER_DRAIN = false, HAS_INIT = false;
    const bf16_t* acat; const float* dskip; bf16_t* geluy;
    __device__ __forceinline__ void operator()(const f32x4 (&acc)[2][2][4][2], const Unit& u, int wr, int wc, int fr, int fq) const {
        const int g = u.pg, row0 = u.pm * BM + wr * 64 + fr;
        f32x4 dv[2];
#pragma unroll
        for (int bj = 0; bj < 2; ++bj) { }
        const int co0 = 8 * (fq & 1);
        dv[0] = *(const f32x4*)(dskip + g * 16 + co0); dv[1] = *(const f32x4*)(dskip + g * 16 + co0 + 4);
        u32x4 uu[2][4][2];
#pragma unroll
        for (int ai = 0; ai < 2; ++ai)
#pragma unroll
            for (int m = 0; m < 4; ++m)
#pragma unroll
                for (int bj = 0; bj < 2; ++bj) uu[ai][m][bj] = *(const u32x4*)(acat + ((size_t)g * 512 + row0 + ai * HALF + m * 16) * ACAT_LD + u.pn * BM + bj * HALF + wc * 32 + 8 * fq);
#pragma unroll
        for (int ai = 0; ai < 2; ++ai) {
#pragma unroll
            for (int m = 0; m < 4; ++m) { const int rr = row0 + ai * HALF + m * 16, b = rr >> 6, c = rr & 63;
#pragma unroll
                for (int bj = 0; bj < 2; ++bj) { const int col = u.pn * BM + bj * HALF + wc * 32 + 8 * fq, i = col >> 4;
                    f32x4 ua, ub; unpack8(uu[ai][m][bj], ua, ub);
                    f32x4 ya = acc[ai][bj][m][0] + dv[0] * ua, yb = acc[ai][bj][m][1] + dv[1] * ub;
#pragma unroll
                    for (int j = 0; j < 4; j += 2) { const f32x2_t a2 = fgelu_tanh2((f32x2_t){ya[j], ya[j + 1]}), b2 = fgelu_tanh2((f32x2_t){yb[j], yb[j + 1]}); ya[j] = a2.x; ya[j + 1] = a2.y; yb[j] = b2.x; yb[j + 1] = b2.y; }
                    *(u32x4*)(geluy + ((size_t)b * SEQ + 64 * c + i) * K5_LD + 16 * g + co0) = pack8(ya, yb); } }
        }
    }
};
}

constexpr int NWAVES = 8;
constexpr int RING_OFF = 0, RING_BYTES = 131072;
constexpr int LDS_BYTES = 163840;
constexpr int LDSCTL_OFF = LDS_BYTES - 512, MISC_OFF = LDSCTL_OFF + 320;
constexpr int CW_TMO = 0, CW_CODE = 1, CW_TOEP = 64, CW_CMP = 1024  , CW_BAR = 4096;

#define GAS __attribute__((address_space(1)))
#define LAS __attribute__((address_space(3)))
typedef unsigned v4u __attribute__((ext_vector_type(4)));
typedef float f32x4 __attribute__((ext_vector_type(4)));
typedef GAS unsigned gu32;
#define RLX_AGENT __ATOMIC_RELAXED, __HIP_MEMORY_SCOPE_AGENT
#define LDS_WAIT() asm volatile("s_waitcnt lgkmcnt(0)" ::: "memory")
#define VM_WAIT() asm volatile("s_waitcnt vmcnt(0)" ::: "memory")

#define XB_TMO      128
#define XB_XCNT(j)  (256  + 64 * (j))
#define XB_XSUB(j)  (1280 + 64 * (j))
#define XB_XGEN(j)  (2304 + 64 * (j))
#define XB_TOP      3328
#define XB_TOPGEN   3392
#define XCD_BAR_WORDS 3456
#define XB_SPIN_CAP (1u << 18)
__device__ __forceinline__ unsigned xb_ld(unsigned* p)              { return __hip_atomic_load(p, __ATOMIC_RELAXED, __HIP_MEMORY_SCOPE_AGENT); }
__device__ __forceinline__ unsigned xb_add(unsigned* p, unsigned v) { return __hip_atomic_fetch_add(p, v, __ATOMIC_RELAXED, __HIP_MEMORY_SCOPE_AGENT); }
__device__ __forceinline__ unsigned xb_xcc_id() { return (unsigned)__builtin_amdgcn_s_getreg((3 << 11) | 20) & 0xFu; }
#define XB_SPIN(cond, bar) do { unsigned _sp = 0; while (cond) { __builtin_amdgcn_s_sleep(1); \
    if ((++_sp & 255u) == 0u) { if (xb_ld(&(bar)[XB_TMO])) break; if (_sp > XB_SPIN_CAP) { atomicAdd(&(bar)[XB_TMO], 1u); break; } } } } while (0)
struct XcdBarrier { unsigned* bar; unsigned x; volatile LAS unsigned* st; };
__device__ __forceinline__ XcdBarrier xcd_barrier_post(unsigned* bar, volatile LAS unsigned* st) {
    XcdBarrier b; b.bar = bar; b.x = xb_xcc_id(); b.st = st;
    if (threadIdx.x == 0) (void)xb_add(&bar[XB_XCNT(b.x)], 1u);
    return b;
}
__device__ __forceinline__ void xcd_barrier_complete(unsigned* bar, unsigned x, unsigned& nloc, unsigned& nx) {
    const unsigned G = gridDim.x * gridDim.y * gridDim.z;
    unsigned sum, cnt, mine, sp = 0u;
    for (;;) {
        sum = 0u; cnt = 0u; mine = 0u;
#pragma unroll
        for (unsigned j = 0; j < 16; ++j) { const unsigned c = xb_ld(&bar[XB_XCNT(j)]); sum += c; cnt += (c > 0u) ? 1u : 0u; mine = (j == x) ? c : mine; }
        if (sum == G) break;
        __builtin_amdgcn_s_sleep(1);
        if ((++sp & 255u) == 0u) { if (xb_ld(&bar[XB_TMO])) break; if (sp > XB_SPIN_CAP) { atomicAdd(&bar[XB_TMO], 1u); break; } }
    }
    nloc = mine > 0u ? mine : 1u; nx = cnt > 0u ? cnt : 1u;
}
__device__ __forceinline__ void xcd_barrier(const XcdBarrier& b) {
    asm volatile("s_waitcnt vmcnt(0)" ::: "memory");
    __syncthreads();
    if (threadIdx.x == 0) {
        unsigned* bar = b.bar;
        __builtin_amdgcn_s_waitcnt(0);
        unsigned nloc = b.st[0], nx = b.st[1];
        if (nloc == 0u) { xcd_barrier_complete(bar, b.x, nloc, nx); b.st[0] = nloc; b.st[1] = nx; }
        const unsigned old = xb_add(&bar[XB_XSUB(b.x)], 1u);
        const unsigned gen = old / nloc;
        if (old + 1u == (gen + 1u) * nloc) {
            __builtin_amdgcn_fence(__ATOMIC_RELEASE, "agent");
            asm volatile("s_waitcnt vmcnt(0)" ::: "memory");
            const unsigned og = xb_add(&bar[XB_TOP], 1u);
            const unsigned tg = og / nx;
            if (og + 1u == (tg + 1u) * nx) xb_add(&bar[XB_TOPGEN], 1u);
            else XB_SPIN(xb_ld(&bar[XB_TOPGEN]) == tg, bar);
            __builtin_amdgcn_fence(__ATOMIC_ACQUIRE, "agent");
            xb_add(&bar[XB_XGEN(b.x)], 1u);
            asm volatile("s_waitcnt vmcnt(0)" ::: "memory");
        } else {
            XB_SPIN(xb_ld(&bar[XB_XGEN(b.x)]) == gen, bar);
            __builtin_amdgcn_fence(__ATOMIC_ACQUIRE, "agent");
            asm volatile("s_waitcnt vmcnt(0)" ::: "memory");
        }
    }
    __syncthreads();
}

struct Args { const float* in[32]; float* out; unsigned char* ws; int ph_lo, ph_hi, fused, pad; };
struct Frame {
    LAS unsigned char* lds; volatile LAS unsigned* MISC; gu32* ctl;
    int tid, lane, wave, vcu, G;
};
enum Phase { PH_PRO = 0, PH_F1GU, PH_F1D, PH_WIN, PH_MIDA, PH_MIDB, PH_NSA, PH_GLU, PH_WOUT, PH_F2GU, PH_F2D, NPH };

template <class MAP>
__device__ __forceinline__ void transpose_load(const float* W, int ldw, int k0, int n0, const MAP& srccol, int lane, const float* rowscale, f32x4 (&v)[8]) {
    const int n4 = (lane & 7) * 4, sc = srccol(n0 + n4), kr = lane >> 3;
#pragma unroll
    for (int i = 0; i < 8; ++i) v[i] = sc >= 0 ? *(const f32x4*)(W + (size_t)(k0 + kr + 8 * i) * ldw + sc) : (f32x4){0.f, 0.f, 0.f, 0.f};
    if (rowscale) {
#pragma unroll
        for (int i = 0; i < 8; ++i) v[i] = v[i] * rowscale[k0 + kr + 8 * i];
    }
}
__device__ __forceinline__ void transpose_store(const f32x4 (&v)[8], bf16_t* WT, int ldt, int k0, int n0, LAS float* scr, int lane) {
    const int n4 = (lane & 7) * 4, kr = lane >> 3;
#pragma unroll
    for (int i = 0; i < 8; ++i) { LAS float* d = scr + (kr + 8 * i) * 33 + n4; d[0] = v[i][0]; d[1] = v[i][1]; d[2] = v[i][2]; d[3] = v[i][3]; }
    LDS_WAIT(); asm volatile("" ::: "memory");
    const int c = lane & 7;
#pragma unroll
    for (int j = 0; j < 4; ++j) { const int n = (lane >> 3) + 8 * j; const LAS float* s = scr + (8 * c) * 33 + n;
        v4u o; o.x = pk2(s[0 * 33], s[1 * 33]); o.y = pk2(s[2 * 33], s[3 * 33]); o.z = pk2(s[4 * 33], s[5 * 33]); o.w = pk2(s[6 * 33], s[7 * 33]);
        *(GAS v4u*)(WT + (size_t)(n0 + n) * ldt + k0 + 8 * c) = o; }
    LDS_WAIT(); asm volatile("" ::: "memory");
}
template <class MAP>
__device__ __forceinline__ void transpose_item(const float* W, int ldw, bf16_t* WT, int ldt, int k0, int n0, const MAP& srccol, LAS float* scr, int lane, const float* rowscale = nullptr) {
    f32x4 v[8];
    transpose_load(W, ldw, k0, n0, srccol, lane, rowscale, v);
    transpose_store(v, WT, ldt, k0, n0, scr, lane);
}
__device__ __forceinline__ void prep_row2(const float* x0, const float* x1, const float* g, bf16_t* o0, bf16_t* o1, float* q0, float* q1, int lane) {
    const GAS f32x4* xa = (const GAS f32x4*)x0 + lane; const GAS f32x4* xb = (const GAS f32x4*)x1 + lane; (void)g;
    f32x4 va[4], vb[4];
#pragma unroll
    for (int j = 0; j < 4; ++j) { va[j] = xa[64 * j]; vb[j] = xb[64 * j]; }
    GAS unsigned long long* oa = (GAS unsigned long long*)o0 + lane; GAS unsigned long long* ob = (GAS unsigned long long*)o1 + lane;
    float sa = 0.f, sb = 0.f;
#pragma unroll
    for (int j = 0; j < 4; ++j) { const f32x4 a = va[j], b = vb[j];
        sa += (a.x * a.x + a.y * a.y) + (a.z * a.z + a.w * a.w); sb += (b.x * b.x + b.y * b.y) + (b.z * b.z + b.w * b.w);
        oa[64 * j] = (unsigned long long)pk2(a.x, a.y) | ((unsigned long long)pk2(a.z, a.w) << 32);
        ob[64 * j] = (unsigned long long)pk2(b.x, b.y) | ((unsigned long long)pk2(b.z, b.w) << 32); }
    sa = wave_sum(sa); sb = wave_sum(sb);
    if (lane < 16) { q0[lane] = (lane == 0) ? sa : 0.f; q1[lane] = (lane == 0) ? sb : 0.f; }
}
__device__ __forceinline__ void prep_row(const float* xrow, const float* g, bf16_t* orow, float* ssqrow, int lane) {
    const GAS f32x4* xr = (const GAS f32x4*)xrow + lane; const GAS f32x4* gr = (const GAS f32x4*)g + lane;
    GAS unsigned long long* o8 = (GAS unsigned long long*)orow + lane;
    float s = 0.f;
#pragma unroll
    for (int j = 0; j < 4; ++j) { const f32x4 v = xr[64 * j], gg = gr[64 * j]; s += (v.x * v.x + v.y * v.y) + (v.z * v.z + v.w * v.w);
        o8[64 * j] = (unsigned long long)pk2(v.x * gg.x, v.y * gg.y) | ((unsigned long long)pk2(v.z * gg.z, v.w * gg.w) << 32); }
    s = wave_sum(s);
    if (lane < 16) ssqrow[lane] = (lane == 0) ? s : 0.f;
}

struct Cplx { double r, i; };
__device__ __forceinline__ Cplx cmul(Cplx a, Cplx b) { return Cplx{a.r * b.r - a.i * b.i, a.r * b.i + a.i * b.r}; }
__device__ __forceinline__ Cplx apow(double lr, double li, double step, double e) { const double m = exp(lr * step * e), ang = li * step * e; return Cplx{m * cos(ang), m * sin(ang)}; }

struct CplxF { float r, i; };
__device__ __forceinline__ CplxF cmulf(CplxF a, CplxF b) { return CplxF{a.r * b.r - a.i * b.i, a.r * b.i + a.i * b.r}; }
__device__ __forceinline__ CplxF apowf(double lr, double li, double step, double e) { const float m = expf((float)(lr * step * e)), ang = (float)(li * step * e); float sn, cs; sincosf(ang, &sn, &cs); return CplxF{m * cs, m * sn}; }
__device__ __forceinline__ void ssm_weights_task(const Args& a, int g, int i, int lane, LAS float* scr) {
    unsigned char* ws = a.ws;
    const int p = lane;
    const double lr = a.in[18][g * 64 + p], li = a.in[19][g * 64 + p], step = exp((double)a.in[20][g]);
    const Cplx a1 = apow(lr, li, step, 1.0);
    const double den = lr * lr + li * li;
    const Cplx coef{((a1.r - 1.0) * lr + a1.i * li) / den, (a1.i * lr - (a1.r - 1.0) * li) / den};
    const CplxF ab = apowf(lr, li, step, (double)(63 - i)), ac = apowf(lr, li, step, (double)i), ad = apowf(lr, li, step, (double)(i + 1));
    const CplxF coeff{(float)coef.r, (float)coef.i};
    float zr[16], zi[16];
    bf16_t* w1s = (bf16_t*)(ws + WS_W1S) + ((size_t)g * 128) * 1024;
    {
        unsigned pr[8], pi[8];
#pragma unroll
        for (int c = 0; c < 16; ++c) { const CplxF bb = cmulf(coeff, CplxF{a.in[21][(g * 64 + p) * 16 + c], a.in[22][(g * 64 + p) * 16 + c]});
            const CplxF zb = cmulf(ab, bb), zc = cmulf(ac, bb); zr[c] = zc.r; zi[c] = zc.i;
            const unsigned br = f2bf(zb.r), bi = f2bf(zb.i);
            if (c & 1) { pr[c >> 1] |= br << 16; pi[c >> 1] |= bi << 16; } else { pr[c >> 1] = br; pi[c >> 1] = bi; } }
        v4u* dr = (v4u*)(w1s + (size_t)p * 1024 + i * 16); v4u* di = (v4u*)(w1s + (size_t)(64 + p) * 1024 + i * 16);
        dr[0] = (v4u){pr[0], pr[1], pr[2], pr[3]}; dr[1] = (v4u){pr[4], pr[5], pr[6], pr[7]};
        di[0] = (v4u){pi[0], pi[1], pi[2], pi[3]}; di[1] = (v4u){pi[4], pi[5], pi[6], pi[7]};
    }
#pragma unroll
    for (int c = 0; c < 16; ++c) { scr[p * 16 + c] = zr[c]; scr[1024 + p * 16 + c] = zi[c]; }
    LDS_WAIT(); asm volatile("" ::: "memory");
    {
        const int co = lane >> 2, c4 = (lane & 3) * 4;
        f32x4 acc = {0.f, 0.f, 0.f, 0.f};
        const f32x4* crp = (const f32x4*)(a.in[23] + (g * 16 + co) * 64); const f32x4* cmp4 = (const f32x4*)(a.in[24] + (g * 16 + co) * 64);
        f32x4 cr4[16], cm4[16];
#pragma unroll
        for (int q = 0; q < 16; ++q) { cr4[q] = crp[q]; cm4[q] = cmp4[q]; }
#pragma unroll
        for (int q = 0; q < 16; ++q)
#pragma unroll
            for (int j = 0; j < 4; ++j) { const int pp = 4 * q + j;
                const f32x4 r4 = *(const LAS f32x4*)(scr + pp * 16 + c4), i4 = *(const LAS f32x4*)(scr + 1024 + pp * 16 + c4);
                acc += r4 * cr4[q][j] - i4 * cm4[q][j]; }
        *(f32x4*)((float*)(ws + WS_KTAB) + (((size_t)g * 64 + i) * 16 + co) * 16 + c4) = acc;
    }
    LDS_WAIT(); asm volatile("" ::: "memory");
    bf16_t* wt = (bf16_t*)(ws + WS_WTOEP) + ((size_t)g * 1024 + i * 16) * ACAT_LD + 1024;
#pragma unroll 4
    for (int co = 0; co < 16; ++co) { const CplxF z = cmulf(CplxF{a.in[23][(g * 16 + co) * 64 + p], a.in[24][(g * 16 + co) * 64 + p]}, ad);
        wt[(size_t)co * ACAT_LD + p] = f2bf(z.r); wt[(size_t)co * ACAT_LD + 64 + p] = f2bf(-z.i); }
}
__device__ __forceinline__ void toep_row(unsigned char* ws, int row, int lane) {
    const int g = row >> 10, i = (row >> 4) & 63, co = row & 15, ip = lane;
    bf16_t* dst = (bf16_t*)(ws + WS_WTOEP) + (size_t)row * ACAT_LD + ip * 16;
    v4u o0 = {0u, 0u, 0u, 0u}, o1 = {0u, 0u, 0u, 0u};
    if (ip <= i) { const f32x4* k = (const f32x4*)((const float*)(ws + WS_KTAB) + (((size_t)g * 64 + (i - ip)) * 16 + co) * 16);
        const f32x4 k0 = k[0], k1 = k[1], k2 = k[2], k3 = k[3];
        o0 = (v4u){pk2(k0[0], k0[1]), pk2(k0[2], k0[3]), pk2(k1[0], k1[1]), pk2(k1[2], k1[3])};
        o1 = (v4u){pk2(k2[0], k2[1]), pk2(k2[2], k2[3]), pk2(k3[0], k3[1]), pk2(k3[2], k3[3])}; }
    ((v4u*)dst)[0] = o0; ((v4u*)dst)[1] = o1;
}
__device__ __forceinline__ void toep_rows4(unsigned char* ws, int row0, int lane) {
    const int g = row0 >> 10, i = (row0 >> 4) & 63, co0 = row0 & 15, ip = lane;
    bf16_t* dst = (bf16_t*)(ws + WS_WTOEP) + (size_t)row0 * ACAT_LD + ip * 16;
    f32x4 k[4][4];
#pragma unroll
    for (int r = 0; r < 4; ++r)
#pragma unroll
        for (int q = 0; q < 4; ++q) k[r][q] = (f32x4){0.f, 0.f, 0.f, 0.f};
    if (ip <= i) { const f32x4* kp = (const f32x4*)((const float*)(ws + WS_KTAB) + (((size_t)g * 64 + (i - ip)) * 16 + co0) * 16);
#pragma unroll
        for (int r = 0; r < 4; ++r)
#pragma unroll
            for (int q = 0; q < 4; ++q) k[r][q] = kp[r * 4 + q]; }
#pragma unroll
    for (int r = 0; r < 4; ++r) {
        ((v4u*)(dst + (size_t)r * ACAT_LD))[0] = (v4u){pk2(k[r][0][0], k[r][0][1]), pk2(k[r][0][2], k[r][0][3]), pk2(k[r][1][0], k[r][1][1]), pk2(k[r][1][2], k[r][1][3])};
        ((v4u*)(dst + (size_t)r * ACAT_LD))[1] = (v4u){pk2(k[r][2][0], k[r][2][1]), pk2(k[r][2][2], k[r][2][3]), pk2(k[r][3][0], k[r][3][1]), pk2(k[r][3][2], k[r][3][3])}; }
}
__device__ __forceinline__ void ssm_carry_scan(const Args& a, int g, int pm, int tid) {
    if (tid >= 256) return;
    unsigned char* ws = a.ws;
    const int bl = tid >> 6, p = tid & 63, b = 4 * pm + bl;
    const double lr = a.in[18][g * 64 + p], li = a.in[19][g * 64 + p], step = exp((double)a.in[20][g]);
    const Cplx a64 = apow(lr, li, step, 64.0); const float ar = (float)a64.r, ai = (float)a64.i;
    const float* S = (const float*)(ws + WS_SST) + ((size_t)g * 512 + b * 64) * 128;
    bf16_t* X = (bf16_t*)(ws + WS_ACAT) + ((size_t)g * 512 + b * 64) * ACAT_LD + 1024;
    float xr = 0.f, xi = 0.f;
#pragma unroll 8
    for (int c = 0; c < 64; ++c) {
        X[(size_t)c * ACAT_LD + p] = f2bf(xr); X[(size_t)c * ACAT_LD + 64 + p] = f2bf(xi);
        const float sr = S[c * 128 + p], si = S[c * 128 + 64 + p];
        const float nr = ar * xr - ai * xi + sr, ni = ar * xi + ai * xr + si; xr = nr; xi = ni;
    }
}
namespace nsa {
typedef short bf16x8 __attribute__((ext_vector_type(8)));
typedef short s16x4 __attribute__((ext_vector_type(4)));
typedef float f32x16 __attribute__((ext_vector_type(16)));
typedef unsigned u32x4 __attribute__((ext_vector_type(4)));
typedef LAS const char* lds_cptr;
constexpr int SLOTB = 8192;
constexpr int L_K = 0, L_V = 2 * SLOTB, L_WSF = 4 * SLOTB, L_IMP = L_WSF + 8 * 256, L_SEL = L_IMP + 64 * 65 * 4, L_UNI = L_SEL + 64 * 8, L_TL = L_UNI + 64, L_OACC = L_TL + 512, L_QF = L_OACC + 8 * 8192, L_GT = L_QF + 8 * 4096, L_DUMP = L_GT + 8 * 3 * 64 * 4, L_END = L_DUMP + 1024;
static_assert(L_END <= LDSCTL_OFF && L_QF % 16 == 0, "attention LDS map");
__device__ __forceinline__ int crow(int r, int hi) { return (r & 3) + 8 * (r >> 2) + 4 * hi; }
#define NSA_MFMA(a, b, c) __builtin_amdgcn_mfma_f32_32x32x16_bf16(a, b, c, 0, 0, 0)
enum { M_NONE = 0, M_CAUSAL = 1, M_WINLO = 2, M_CMP = 3, M_SEL = 4, M_SELCAUSAL = 5 };

struct Ctx {
    LAS unsigned char* lds; int wid, lane, r32, hi, th, hh;
};
__device__ __forceinline__ void glds16(const void* gsrc, unsigned lds_dst) { unsigned keep;
    asm volatile("s_mov_b32 %0, m0\n\ts_mov_b32 m0, %2\n\ts_nop 0\n\tglobal_load_lds_dwordx4 %1, off\n\ts_mov_b32 m0, %0" : "=&s"(keep) : "v"(gsrc), "s"(lds_dst) : "memory"); }
__device__ __forceinline__ unsigned lds_addr(const Ctx& c, int off) { return (unsigned)__builtin_amdgcn_readfirstlane((int)(unsigned)(uintptr_t)c.lds + off); }
__device__ __forceinline__ int koff(int i) { return i < 2 ? L_K + i * SLOTB : L_IMP; }
__device__ __forceinline__ int voff(int i) { return i < 2 ? L_V + i * SLOTB : L_IMP + SLOTB; }
__device__ __forceinline__ void dma_kv(const Ctx& c, const bf16_t* Kt, const bf16_t* Vt, int s) {
    const int krow_ = c.wid * 8 + (c.lane >> 3);
    const bf16_t* ks = Kt + krow_ * 64 + ((c.lane & 7) ^ ((krow_ >> 1) & 7)) * 8;
    const bf16_t* vs = Vt + (16 * (c.wid & 3) + (c.lane >> 2)) * 64 + (c.wid >> 2) * 32 + (c.lane & 3) * 8;
    glds16(ks, lds_addr(c, koff(s) + c.wid * 1024));
    glds16(vs, lds_addr(c, voff(s) + c.wid * 1024));
}
__device__ __forceinline__ void dma_v(const Ctx& c, const bf16_t* Vt, int s) {
    const bf16_t* vs = Vt + (16 * (c.wid & 3) + (c.lane >> 2)) * 64 + (c.wid >> 2) * 32 + (c.lane & 3) * 8;
    glds16(vs, lds_addr(c, voff(s) + c.wid * 1024));
}
__device__ __forceinline__ void dma_k(const Ctx& c, const bf16_t* Kt, int s) {
    const int krow_ = c.wid * 8 + (c.lane >> 3);
    const bf16_t* ks = Kt + krow_ * 64 + ((c.lane & 7) ^ ((krow_ >> 1) & 7)) * 8;
    glds16(ks, lds_addr(c, koff(s) + c.wid * 1024));
}
__device__ __forceinline__ void prefetch_tile(const Ctx& c, const bf16_t* t) { glds16(t + c.wid * 512 + c.lane * 8, lds_addr(c, L_DUMP)); }
#define NSA_WAITBAR2() asm volatile("s_waitcnt vmcnt(2) lgkmcnt(0)\n\ts_barrier" ::: "memory")
#define NSA_WAITBAR() asm volatile("s_waitcnt vmcnt(0) lgkmcnt(0)\n\ts_barrier" ::: "memory")

__device__ __forceinline__ int kfrag_off(const Ctx& c, int d0) { return c.r32 * 128 + (((2 * d0 + c.hi) ^ ((c.r32 >> 1) & 7)) << 4); }
__device__ __forceinline__ void qkt(f32x16& p0, f32x16& p1, const Ctx& c, int s, const bf16x8 (&qr)[4]) {
    const lds_cptr kb = (lds_cptr)(c.lds + koff(s));
    p0 = f32x16{}; p1 = f32x16{};
#pragma unroll
    for (int d0 = 0; d0 < 4; ++d0) {
        const int ko = kfrag_off(c, d0);
        const bf16x8 b0 = *(const LAS bf16x8*)(kb + ko), b1 = *(const LAS bf16x8*)(kb + ko + 4096);
        p0 = NSA_MFMA(b0, qr[d0], p0); p1 = NSA_MFMA(b1, qr[d0], p1);
    }
}
__device__ __forceinline__ s16x4 vtr(lds_cptr p) { typedef short v4i16_t __attribute__((ext_vector_type(4))); return __builtin_bit_cast(s16x4, __builtin_amdgcn_ds_read_tr16_b64_v4i16((LAS v4i16_t*)p)); }
__device__ __forceinline__ void pv(f32x16 (&o)[2], const Ctx& c, int s, const bf16x8 (&pa)[4]) {
    const lds_cptr vp = (lds_cptr)(c.lds + voff(s)) + ((c.lane >> 4) & 1) * 32 + (c.lane & 3) * 8 + (4 * c.hi + ((c.lane & 15) >> 2)) * 64;
#pragma unroll
    for (int d0 = 0; d0 < 2; ++d0) {
        s16x4 lo[4], hh[4];
#pragma unroll
        for (int ks = 0; ks < 4; ++ks) { lo[ks] = vtr(vp + d0 * 4096 + ks * 1024); hh[ks] = vtr(vp + d0 * 4096 + ks * 1024 + 512); }
        __builtin_amdgcn_sched_barrier(0);
#pragma unroll
        for (int ks = 0; ks < 4; ++ks) { const bf16x8 vf = {lo[ks][0], lo[ks][1], lo[ks][2], lo[ks][3], hh[ks][0], hh[ks][1], hh[ks][2], hh[ks][3]}; o[d0] = NSA_MFMA(pa[ks], vf, o[d0]); }
        __builtin_amdgcn_sched_barrier(0);
    }
}
__device__ __forceinline__ float rowmax32(const f32x16& p0, const f32x16& p1) {
    float a = fmaxf(p0[0], p1[0]);
#pragma unroll
    for (int r = 1; r < 16; ++r) a = fmaxf(a, fmaxf(p0[r], p1[r]));
    return fmaxf(a, __shfl_xor(a, 32));
}
__device__ __forceinline__ unsigned cvtpk(float lo, float hi) { return pg8::cvt_pk_bf16(lo, hi); }
__device__ __forceinline__ void pack_p(bf16x8 (&pa)[4], const f32x16& p0, const f32x16& p1) {
    pa[0] = __builtin_bit_cast(bf16x8, (u32x4){cvtpk(p0[0], p0[1]), cvtpk(p0[2], p0[3]), cvtpk(p0[4], p0[5]), cvtpk(p0[6], p0[7])});
    pa[1] = __builtin_bit_cast(bf16x8, (u32x4){cvtpk(p0[8], p0[9]), cvtpk(p0[10], p0[11]), cvtpk(p0[12], p0[13]), cvtpk(p0[14], p0[15])});
    pa[2] = __builtin_bit_cast(bf16x8, (u32x4){cvtpk(p1[0], p1[1]), cvtpk(p1[2], p1[3]), cvtpk(p1[4], p1[5]), cvtpk(p1[6], p1[7])});
    pa[3] = __builtin_bit_cast(bf16x8, (u32x4){cvtpk(p1[8], p1[9]), cvtpk(p1[10], p1[11]), cvtpk(p1[12], p1[13]), cvtpk(p1[14], p1[15])});
}
template <int MODE>
__device__ __forceinline__ void apply_mask(f32x16& p0, f32x16& p1, int hi, int ql, int lim, bool rowsel) {
    if (MODE == M_NONE) return;
    const float NEG = -INFINITY;
    const int qh = ql - 4 * hi, lh = lim - 4 * hi;
#pragma unroll
    for (int r = 0; r < 16; ++r) {
        const int kc = (r & 3) + 8 * (r >> 2);
        bool v0 = true, v1 = true;
        if (MODE == M_CAUSAL || MODE == M_SELCAUSAL) { v0 = kc <= qh; v1 = kc + 32 <= qh; }
        if (MODE == M_WINLO) { v0 = kc > qh; v1 = kc + 32 > qh; }
        if (MODE == M_CMP) { v0 = kc <= lh; v1 = kc + 32 <= lh; }
        if (MODE == M_SEL || MODE == M_SELCAUSAL) { v0 = v0 && rowsel; v1 = v1 && rowsel; }
        if (!v0) p0[r] = NEG; if (!v1) p1[r] = NEG;
    }
}
struct Sm { float m, l; };
__device__ __forceinline__ float rowmax32_3(const f32x16& p0, const f32x16& p1) {
    float a = __builtin_fmaxf(__builtin_fmaxf(p0[0], p0[1]), p1[0]), b = __builtin_fmaxf(__builtin_fmaxf(p0[2], p0[3]), p1[1]);
    a = __builtin_fmaxf(__builtin_fmaxf(a, p1[2]), p1[3]);
#pragma unroll
    for (int r = 4; r < 16; r += 4) { a = __builtin_fmaxf(__builtin_fmaxf(a, p0[r]), p0[r + 1]); b = __builtin_fmaxf(__builtin_fmaxf(b, p0[r + 2]), p0[r + 3]);
        a = __builtin_fmaxf(__builtin_fmaxf(a, p1[r]), p1[r + 1]); b = __builtin_fmaxf(__builtin_fmaxf(b, p1[r + 2]), p1[r + 3]); }
    a = __builtin_fmaxf(a, b);
    return __builtin_fmaxf(a, __shfl_xor(a, 32));
}
constexpr float RESCALE_THR = 8.0f;
#define SGB(mask, n) __builtin_amdgcn_sched_group_barrier(mask, n, 0)
__device__ __forceinline__ void rescale_rows(Sm& st, f32x16 (&o)[2], f32x16& p0, f32x16& p1, const Ctx& c, float rm, bool first) {
    const float dl = first ? (rm > -INFINITY ? rm : 0.f) : __builtin_fmaxf(rm, 0.f), f = __builtin_amdgcn_exp2f(-dl);
    st.m += dl; st.l *= f;
#pragma unroll
    for (int r = 0; r < 16; ++r) { p0[r] -= dl; p1[r] -= dl; }
    LAS float* wsf = (LAS float*)(c.lds + L_WSF) + c.wid * 64;
    if (c.hi == 0) wsf[c.r32] = f;
    const LAS float* wsh = wsf + 4 * c.hi;
#pragma unroll
    for (int r = 0; r < 16; ++r) { const float fr_ = wsh[(r & 3) + 8 * (r >> 2)]; o[0][r] *= fr_; o[1][r] *= fr_; }
}
template <int DBG = 0>
__device__ __forceinline__ void exp_sum_pack(Sm& st, f32x16& p0, f32x16& p1, bf16x8 (&pa)[4]) {
    float sum = 0.f;
#pragma unroll
    for (int r = 0; r < 16; ++r) { if (!(DBG & 1)) { p0[r] = __builtin_amdgcn_exp2f(p0[r]); p1[r] = __builtin_amdgcn_exp2f(p1[r]); } sum += p0[r] + p1[r]; }
    st.l += sum;
    pack_p(pa, p0, p1);
}
__device__ __forceinline__ void read_kf(bf16x8 (&kf)[8], const Ctx& c, int ks) {
    const lds_cptr kb = (lds_cptr)(c.lds + koff(ks));
#pragma unroll
    for (int d0 = 0; d0 < 4; ++d0) { const int ko = kfrag_off(c, d0); kf[2 * d0] = *(const LAS bf16x8*)(kb + ko); kf[2 * d0 + 1] = *(const LAS bf16x8*)(kb + ko + 4096); }
}
__device__ __forceinline__ void read_vf(s16x4 (&vf)[16], const Ctx& c, int vs) {
    const lds_cptr vp = (lds_cptr)(c.lds + voff(vs)) + ((c.lane >> 4) & 1) * 32 + (c.lane & 3) * 8 + (4 * c.hi + ((c.lane & 15) >> 2)) * 64;
#pragma unroll
    for (int i = 0; i < 8; ++i) { vf[2 * i] = vtr(vp + (i >> 2) * 4096 + (i & 3) * 1024); vf[2 * i + 1] = vtr(vp + (i >> 2) * 4096 + (i & 3) * 1024 + 512); }
}
template <int DBG = 0>
__device__ __forceinline__ void block_b(f32x16& n0, f32x16& n1, const Ctx& c, const bf16x8 (&kf)[8], const bf16x8 (&qr)[4], s16x4 (&vf)[16], int vs, float cinit, Sm& st, f32x16& p0, f32x16& p1, bf16x8 (&pa)[4]) {
    read_vf(vf, c, vs);
    f32x16 cv;
#pragma unroll
    for (int r = 0; r < 16; ++r) cv[r] = cinit;
#pragma unroll
    for (int d0 = 0; d0 < 4; ++d0) { n0 = NSA_MFMA(kf[2 * d0], qr[d0], d0 == 0 ? cv : n0); n1 = NSA_MFMA(kf[2 * d0 + 1], qr[d0], d0 == 0 ? cv : n1); }
    exp_sum_pack<DBG>(st, p0, p1, pa);
}
template <bool HASN, int DBG = 0, bool NORESC = false>
__device__ __forceinline__ float block_c(f32x16 (&o)[2], const Ctx& c, const s16x4 (&vf)[16], const bf16x8 (&pa)[4], const f32x16& n0, const f32x16& n1, bf16x8 (&kf)[8], int ks2) {
    if (HASN) { if (ks2 >= 0) read_kf(kf, c, ks2); }
    float rm = -INFINITY;
#pragma unroll
    for (int i = 0; i < 8; ++i) { const bf16x8 v8 = {vf[2 * i][0], vf[2 * i][1], vf[2 * i][2], vf[2 * i][3], vf[2 * i + 1][0], vf[2 * i + 1][1], vf[2 * i + 1][2], vf[2 * i + 1][3]}; o[i >> 2] = NSA_MFMA(pa[i & 3], v8, o[i >> 2]); }
    if (HASN && !NORESC) rm = rowmax32_3(n0, n1);
    return rm;
}
#undef SGB
__device__ __forceinline__ void qk_first(f32x16& p0, f32x16& p1, const Ctx& c, int s, float cinit, int mode, int ql) {
    const lds_cptr kb = (lds_cptr)(c.lds + koff(s));
    const lds_cptr qb_ = (lds_cptr)(c.lds + L_QF + c.wid * 4096) + c.hi * 512 + c.r32 * 16;
    bf16x8 qr[4];
#pragma unroll
    for (int d0 = 0; d0 < 4; ++d0) qr[d0] = *(const LAS bf16x8*)(qb_ + d0 * 1024);
#pragma unroll
    for (int r = 0; r < 16; ++r) { p0[r] = cinit; p1[r] = cinit; }
#pragma unroll
    for (int d0 = 0; d0 < 4; ++d0) { const int ko = kfrag_off(c, d0); const bf16x8 b0 = *(const LAS bf16x8*)(kb + ko), b1 = *(const LAS bf16x8*)(kb + ko + 4096); p0 = NSA_MFMA(b0, qr[d0], p0); p1 = NSA_MFMA(b1, qr[d0], p1); }
    if (mode == M_CAUSAL) apply_mask<M_CAUSAL>(p0, p1, c.hi, ql, 0, true); else if (mode == M_WINLO) apply_mask<M_WINLO>(p0, p1, c.hi, ql, 0, true);
}
__device__ __forceinline__ void sm_stats(Sm& st, const Ctx& c, int s, const bf16x8 (&qr)[4], int lim) {
    f32x16 p0, p1; qkt(p0, p1, c, s, qr);
    apply_mask<M_CMP>(p0, p1, c.hi, 0, lim, true);
    const float rm = rowmax32(p0, p1), mn = fmaxf(st.m, rm), f = __builtin_amdgcn_exp2f(st.m - mn);
    st.m = mn;
    float sum = 0.f;
#pragma unroll
    for (int r = 0; r < 16; ++r) sum += __builtin_amdgcn_exp2f(p0[r] - mn) + __builtin_amdgcn_exp2f(p1[r] - mn);
    st.l = st.l * f + sum;
}
__device__ __forceinline__ void acc_scaled(const f32x16 (&o)[2], const Ctx& c, float fac_row) {
    LAS float* wsf = (LAS float*)(c.lds + L_WSF) + c.wid * 64;
    LAS float* oacc = (LAS float*)(c.lds + L_OACC) + c.wid * 2048;
    if (c.hi == 0) wsf[c.r32] = fac_row;
    const LAS float* wsh = wsf + 4 * c.hi; LAS float* oah = oacc + 4 * c.hi * 64 + c.r32;
#pragma unroll
    for (int r = 0; r < 16; ++r) { const int kc = (r & 3) + 8 * (r >> 2); const float fr_ = wsh[kc]; oah[kc * 64] += o[0][r] * fr_; oah[kc * 64 + 32] += o[1][r] * fr_; }
}

struct Tensors { const bf16_t *q, *kcmp, *vcmp, *ks, *vs, *kw, *vw; const float* g3; bf16_t* onsa; bf16_t* owin; bool bounded_slc, bounded_win; };
template <int DBG>
__device__ __forceinline__ void unit(const Tensors& T_, LAS unsigned char* lds, int b, int g, int qb, int flags) {
    int tid_ = threadIdx.x; asm volatile("" : "+v"(tid_));
    Ctx c; c.lds = lds; c.wid = __builtin_amdgcn_readfirstlane(tid_ >> 6); c.lane = tid_ & 63; c.r32 = c.lane & 31; c.hi = c.lane >> 5; c.th = c.wid & 1; c.hh = c.wid >> 1;
    const int tid = tid_, h = 4 * g + c.hh, t0 = qb * 64, ql = 32 * c.th + c.r32, tq = t0 + ql;
    const size_t tok = (size_t)b * SEQ + tq;
    const bf16_t* Qw = T_.q + (((size_t)b * NH + h) * SEQ + t0 + 32 * c.th) * 64;
    bf16x8 qr[4];
#pragma unroll
    for (int d0 = 0; d0 < 4; ++d0) qr[d0] = *(const bf16x8*)(Qw + (size_t)c.r32 * 64 + d0 * 16 + c.hi * 8);
    const size_t bg = (size_t)b * NG + g;
    const float gv0 = T_.g3[tok * 24 + h], gv1 = T_.g3[tok * 24 + 8 + h], gv2 = T_.g3[tok * 24 + 16 + h];
    {
        if (flags & 1) { prefetch_tile(c, T_.kcmp + bg * 256 * 64); prefetch_tile(c, T_.vcmp + bg * 256 * 64);
            prefetch_tile(c, T_.ks + (bg * SEQ + (size_t)qb * 64) * 64); prefetch_tile(c, T_.vs + (bg * SEQ + (size_t)qb * 64) * 64); }
        if (flags & 2) { prefetch_tile(c, T_.kw + (bg * SEQ + (size_t)qb * 64) * 64); prefetch_tile(c, T_.vw + (bg * SEQ + (size_t)qb * 64) * 64);
            if (qb >= 8) { prefetch_tile(c, T_.kw + (bg * SEQ + (size_t)(qb - 8) * 64) * 64); prefetch_tile(c, T_.vw + (bg * SEQ + (size_t)(qb - 8) * 64) * 64); } }
    }
    { LAS bf16x8* qf = (LAS bf16x8*)(lds + L_QF + c.wid * 4096 + c.hi * 512 + c.r32 * 16);
#pragma unroll
      for (int d0 = 0; d0 < 4; ++d0) qf[d0 * 64] = qr[d0]; }
    { LAS float* gt = (LAS float*)(lds + L_GT) + c.wid * 192 + c.lane; gt[0] = gv0; gt[64] = gv1; gt[128] = gv2; }
    asm volatile("" :: "v"(qr[0]), "v"(qr[1]), "v"(qr[2]), "v"(qr[3]), "v"(gv0), "v"(gv1), "v"(gv2));
    { LAS f32x4* z = (LAS f32x4*)(lds + L_OACC) + c.wid * 512 + c.lane;
#pragma unroll
      for (int i = 0; i < 8; ++i) z[64 * i] = (f32x4){0.f, 0.f, 0.f, 0.f}; }

    if (flags & 1) {
        const bf16_t* KC = T_.kcmp + bg * 256 * 64; const bf16_t* VC = T_.vcmp + bg * 256 * 64;
        const int nct = ((t0 + 63 - 31) >> 4) / 64 + 1;
        const int cmax = (tq >= 31) ? ((tq - 31) >> 4) : -1;
        LAS unsigned* imp = (LAS unsigned*)(lds + L_IMP);
        for (int e = tid; e < 64 * 65; e += 512) imp[e] = 0u;
        Sm st{-1e30f, 0.f};
        dma_k(c, KC, 0);
        for (int n = 0; n < nct; ++n) {
            NSA_WAITBAR();
            if (n + 1 < nct) dma_k(c, KC + (size_t)(n + 1) * 4096, (n + 1) & 1);
            sm_stats(st, c, n & 1, qr, cmax - 64 * n);
        }
        const float lt = st.l + __shfl_xor(st.l, 32), inv = lt > 0.f ? 1.f / lt : 0.f;
        __syncthreads();
        f32x16 o[2]; o[0] = f32x16{}; o[1] = f32x16{};
        dma_kv(c, KC, VC, 0);
        for (int n = 0; n < nct; ++n) {
            NSA_WAITBAR();
            if (n + 1 < nct) dma_kv(c, KC + (size_t)(n + 1) * 4096, VC + (size_t)(n + 1) * 4096, (n + 1) & 1);
            f32x16 p0, p1; qkt(p0, p1, c, n & 1, qr);
            apply_mask<M_CMP>(p0, p1, c.hi, 0, cmax - 64 * n, true);
#pragma unroll
            for (int r = 0; r < 16; ++r) { p0[r] = __builtin_amdgcn_exp2f(p0[r] - st.m) * inv; p1[r] = __builtin_amdgcn_exp2f(p1[r] - st.m) * inv; }
#pragma unroll
            for (int rq = 0; rq < 4; ++rq) {
                const float s0 = (p0[4 * rq] + p0[4 * rq + 1]) + (p0[4 * rq + 2] + p0[4 * rq + 3]), s1 = (p1[4 * rq] + p1[4 * rq + 1]) + (p1[4 * rq + 2] + p1[4 * rq + 3]);
                const int j0 = 16 * n + 2 * rq + c.hi, j1 = j0 + 8;
                LAS unsigned* impr = imp + ql * 65 + 16 * n + c.hi;
                __hip_atomic_fetch_add(&impr[2 * rq], (unsigned)(s0 * 16777216.f + 0.5f), __ATOMIC_RELAXED, __HIP_MEMORY_SCOPE_WORKGROUP);
                __hip_atomic_fetch_add(&impr[2 * rq + 8], (unsigned)(s1 * 16777216.f + 0.5f), __ATOMIC_RELAXED, __HIP_MEMORY_SCOPE_WORKGROUP);
                if (j0 + 1 < 64) __hip_atomic_fetch_add(&impr[2 * rq + 1], (unsigned)(p0[4 * rq + 3] * 16777216.f + 0.5f), __ATOMIC_RELAXED, __HIP_MEMORY_SCOPE_WORKGROUP);
                if (j1 + 1 < 64) __hip_atomic_fetch_add(&impr[2 * rq + 9], (unsigned)(p1[4 * rq + 3] * 16777216.f + 0.5f), __ATOMIC_RELAXED, __HIP_MEMORY_SCOPE_WORKGROUP);
            }
            bf16x8 pa[4]; pack_p(pa, p0, p1);
            pv(o, c, n & 1, pa);
        }
        acc_scaled(o, c, ((LAS float*)(lds + L_GT))[c.wid * 192 + c.lane]);
        __syncthreads();
        {
            const bf16_t* KS0 = T_.ks + bg * SEQ * 64; const bf16_t* VS0 = T_.vs + bg * SEQ * 64;
            dma_k(c, KS0 + (size_t)qb * 4096, 0);
            if (qb >= 1) dma_k(c, KS0 + (size_t)(qb - 1) * 4096, 1);
            dma_v(c, VS0 + (size_t)qb * 4096, 0);
        }
        {
            int t2_ = tid; asm volatile("" : "+v"(t2_));
            const int tk = t2_ >> 3, jb = (t2_ & 7) * 8;
            unsigned sown[8]; int rank[8];
#pragma unroll
            for (int k = 0; k < 8; ++k) { const int j = jb + k; sown[k] = imp[tk * 65 + j] + ((j == 0 || j == qb || j == qb - 1) ? 0x40000000u : 0u); rank[k] = 0; }
            if (qb >= 16)
            for (int jp = 0; jp <= qb; ++jp) { const unsigned sp = imp[tk * 65 + jp] + ((jp == 0 || jp == qb || jp == qb - 1) ? 0x40000000u : 0u);
#pragma unroll
                for (int k = 0; k < 8; ++k) rank[k] += (sp > sown[k] || (sp == sown[k] && jp < jb + k)) ? 1 : 0; }
            unsigned bits = 0u;
#pragma unroll
            for (int k = 0; k < 8; ++k) if (jb + k <= qb && rank[k] < 16) bits |= 1u << k;
            ((LAS unsigned char*)(lds + L_SEL))[tk * 8 + (t2_ & 7)] = (unsigned char)bits;
        }
        __syncthreads();
        if (tid < 64) {
            const unsigned long long mine = ((LAS unsigned long long*)(lds + L_SEL))[tid];
            unsigned lo = (unsigned)mine, hi2 = (unsigned)(mine >> 32);
#pragma unroll
            for (int o_ = 1; o_ < 64; o_ <<= 1) { lo |= __shfl_xor(lo, o_); hi2 |= __shfl_xor(hi2, o_); }
            if (tid == 0) { ((LAS unsigned*)(lds + L_UNI))[0] = lo; ((LAS unsigned*)(lds + L_UNI))[1] = hi2; }
        }
        __syncthreads();
    }
    for (int sidx = (flags & 1) ? 0 : 1; sidx < ((flags & 2) ? 2 : 1); ++sidx) {
        unsigned long long tm;
        if (sidx == 0) { const unsigned ul = (unsigned)__builtin_amdgcn_readfirstlane((int)((LAS unsigned*)(lds + L_UNI))[0]), uh = (unsigned)__builtin_amdgcn_readfirstlane((int)((LAS unsigned*)(lds + L_UNI))[1]);
            tm = ((((unsigned long long)uh << 32) | ul) & ((2ull << qb) - 1ull)) | (1ull << qb); }
        else { const int jlo = qb - 7 < 0 ? 0 : qb - 7; tm = ((2ull << qb) - 1ull) & ~((1ull << jlo) - 1ull); }
        if (DBG & 32) tm = 1ull << qb;
        const int NT = __builtin_popcountll(tm);
        unsigned long long selm = ~0ull;
        if (sidx == 0) selm = ((LAS unsigned long long*)(lds + L_SEL))[ql];
        const bool bounded = sidx ? T_.bounded_win : T_.bounded_slc;
        const bf16_t* KB = (sidx ? T_.kw : T_.ks) + bg * SEQ * 64; const bf16_t* VB = (sidx ? T_.vw : T_.vs) + bg * SEQ * 64;
#define TM_TOP(m) (63 - __builtin_clzll(m))
#define TL_RS(j) ((bool)((selm >> (j)) & 1ull))
        Sm st{0.f, 0.f}; f32x16 o[2]; o[0] = f32x16{}; o[1] = f32x16{};
        f32x16 sA0, sA1, sB0, sB1;
        bool first = true;
        if (sidx == 1 && qb >= 8 && !(DBG & 64)) {
            dma_kv(c, KB + (size_t)(qb - 8) * 4096, VB + (size_t)(qb - 8) * 4096, 0);
            NSA_WAITBAR();
            qk_first(sA0, sA1, c, 0, 0.f, M_WINLO, ql);
            const float rm = rowmax32_3(sA0, sA1);
            if (!bounded && __builtin_expect(__any(rm > RESCALE_THR || (rm < -RESCALE_THR && rm > -INFINITY)), 0)) rescale_rows(st, o, sA0, sA1, c, rm, true);
            bf16x8 pa_[4]; exp_sum_pack(st, sA0, sA1, pa_);
            { s16x4 vf0[16]; bf16x8 kfd[8]; read_vf(vf0, c, 0); (void)block_c<false>(o, c, vf0, pa_, sA0, sA1, kfd, -1); }
            first = false;
            asm volatile("s_waitcnt lgkmcnt(0)\n\ts_barrier" ::: "memory");
        }
        unsigned long long tw = tm;
        int jc0 = TM_TOP(tw); tw &= ~(1ull << jc0);
        int jc1 = tw ? TM_TOP(tw) : -1; if (jc1 >= 0) tw &= ~(1ull << jc1);
        int jc2 = tw ? TM_TOP(tw) : -1; if (jc2 >= 0) tw &= ~(1ull << jc2);
        int jc3 = tw ? TM_TOP(tw) : -1; if (jc3 >= 0) tw &= ~(1ull << jc3);
        int jc4 = tw ? TM_TOP(tw) : -1; if (jc4 >= 0) tw &= ~(1ull << jc4);
        if (!(sidx == 0 && (flags & 1) && jc0 == qb && jc1 == qb - 1)) {
            dma_k(c, KB + (size_t)jc0 * 4096, 0);
            if (jc1 >= 0) dma_k(c, KB + (size_t)jc1 * 4096, 1);
            dma_v(c, VB + (size_t)jc0 * 4096, 0);
        }
        if (jc2 >= 0) dma_k(c, KB + (size_t)jc2 * 4096, 2);
        NSA_WAITBAR();
        qk_first(sA0, sA1, c, 0, TL_RS(jc0) ? -st.m : -INFINITY, M_CAUSAL, ql);
        float rmc = rowmax32_3(sA0, sA1);
        bf16x8 kf[8];
        if (jc1 >= 0) read_kf(kf, c, 1);
        asm volatile("s_waitcnt lgkmcnt(0)\n\ts_barrier" ::: "memory");
        if (jc3 >= 0) dma_k(c, KB + (size_t)jc3 * 4096, 0);
        if (jc1 >= 0) dma_v(c, VB + (size_t)jc1 * 4096, 1);
        bf16x8 qs[4];
        { const lds_cptr qb_ = (lds_cptr)(lds + L_QF + c.wid * 4096) + c.hi * 512 + c.r32 * 16;
#pragma unroll
          for (int d0 = 0; d0 < 4; ++d0) qs[d0] = *(const LAS bf16x8*)(qb_ + d0 * 1024); }
        int r0 = 0, r1 = 1, r2 = 2;
        s16x4 vf[16];
#define NSA_STEP(n, C0, C1, N0, N1, NR) do { \
            if (jc3 >= 0 && (n) > 0) NSA_WAITBAR2(); else NSA_WAITBAR(); \
            if (jc4 >= 0) dma_k(c, KB + (size_t)jc4 * 4096, r1); \
            if (jc2 >= 0) dma_v(c, VB + (size_t)jc2 * 4096, r2); \
            if (!(NR)) { if (__builtin_expect(__any(rmc > RESCALE_THR || (first && rmc < -RESCALE_THR && rmc > -INFINITY)), 0)) rescale_rows(st, o, C0, C1, c, rmc, first); } \
            first = false; \
            bf16x8 pa_[4]; \
            block_b<DBG>(N0, N1, c, kf, qs, vf, r0, TL_RS(jc1) ? -st.m : -INFINITY, st, C0, C1, pa_); \
            rmc = block_c<true, DBG, NR>(o, c, vf, pa_, N0, N1, kf, jc2 >= 0 ? r2 : -1); \
            { const int t_ = r0; r0 = r1; r1 = r2; r2 = t_; } \
            jc0 = jc1; jc1 = jc2; jc2 = jc3; jc3 = jc4; jc4 = tw ? TM_TOP(tw) : -1; if (jc4 >= 0) tw &= ~(1ull << jc4); \
        } while (0)
        int n = 0;
        bool inA = true;
        if (bounded) {
            rmc = 0.f;
            while (jc1 >= 0) {
                NSA_STEP(n, sA0, sA1, sB0, sB1, true); ++n; inA = false;
                if (jc1 >= 0) { NSA_STEP(n, sB0, sB1, sA0, sA1, true); ++n; inA = true; }
            }
        } else {
            while (jc1 >= 0) {
                NSA_STEP(n, sA0, sA1, sB0, sB1, false); ++n; inA = false;
                if (jc1 >= 0) { NSA_STEP(n, sB0, sB1, sA0, sA1, false); ++n; inA = true; }
            }
        }
        if (!inA) { sA0 = sB0; sA1 = sB1; }
        {
            NSA_WAITBAR();
            if (__builtin_expect(__any(rmc > RESCALE_THR || (first && rmc < -RESCALE_THR && rmc > -INFINITY)), 0)) rescale_rows(st, o, sA0, sA1, c, rmc, first);
            bf16x8 pa_[4]; exp_sum_pack(st, sA0, sA1, pa_);
            read_vf(vf, c, r0);
            (void)block_c<false>(o, c, vf, pa_, sA0, sA1, kf, -1);
            const float lt = st.l + __shfl_xor(st.l, 32);
            acc_scaled(o, c, lt > 0.f ? ((LAS float*)(lds + L_GT))[c.wid * 192 + (sidx ? 128 : 64) + c.lane] / lt : 0.f);
        }
#undef NSA_STEP
#undef TM_TOP
#undef TL_RS
        asm volatile("s_waitcnt lgkmcnt(0)\n\ts_barrier" ::: "memory");
    }
    {
        const LAS float* oacc = (const LAS float*)(lds + L_OACC) + c.wid * 2048;
        const bool to_owin = !(flags & 1);
        const int ldo = to_owin ? 512 : K5_LD;
        bf16_t* dstb = (to_owin ? T_.owin : T_.onsa) + ((size_t)b * SEQ + t0 + 32 * c.th) * ldo + h * 64;
        asm volatile("s_waitcnt lgkmcnt(0)" ::: "memory");
#pragma unroll
        for (int i = 0; i < 4; ++i) { const int row = i * 8 + (c.lane >> 3), ch = c.lane & 7;
            f32x4 a = *(const LAS f32x4*)(oacc + row * 64 + ch * 8), b2 = *(const LAS f32x4*)(oacc + row * 64 + ch * 8 + 4);
            if (!(flags & 2)) { f32x4 wa, wb; epi::unpack8(*(const u32x4*)(T_.owin + ((size_t)b * SEQ + t0 + 32 * c.th + row) * 512 + h * 64 + ch * 8), wa, wb); a += wa; b2 += wb; }
            *(u32x4*)(dstb + (size_t)row * ldo + ch * 8) = epi::pack8(a, b2); }
    }
    __syncthreads();
}
#undef NSA_MFMA
#undef NSA_WAITBAR
}

enum { MAP_ID = 0, MAP_GU = 1, MAP_WIN = 2, MAP_GLU = 3 };
__device__ __forceinline__ int map_col(int mapid, int n) {
    if (mapid == MAP_ID) return n;
    if (mapid == MAP_GU) return ((n >> 8) << 7) + (n & 127);
    if (mapid == MAP_GLU) return (((n >> 7) & 1) << 10) + ((n >> 8) << 7) + (n & 127);
    const int pn = n >> 8, r = n & 255;
    if (pn < 5) { const int bj = r >> 7, wc = (r >> 5) & 3, i = r & 31; return 64 * (4 * pn + wc) + 32 * bj + i; }
    if (pn < 7) return 1304 + 256 * (pn - 5) + r;
    if (pn < 11) return 1816 + 256 * (pn - 7) + r;
    if (pn < 15) return 2840 + 256 * (pn - 11) + r;
    return r < 24 ? 1280 + r : -1;
}
struct TDesc { const float* W; const float* W2; int K, ldw, Nt, mapid; size_t off; const float* gain; };
__device__ __forceinline__ TDesc tdesc(const Args& a, int id) {
    switch (id) {
    case 0: return TDesc{a.in[2], a.in[3], DM, FF, 2 * FF, MAP_GU, WS_W1GU, a.in[1]};
    case 1: return TDesc{a.in[29], a.in[30], DM, FF, 2 * FF, MAP_GU, WS_W2GU, a.in[28]};
    case 2: return TDesc{a.in[4], nullptr, FF, DM, DM, MAP_ID, WS_W1D, nullptr};
    case 3: return TDesc{a.in[31], nullptr, FF, DM, DM, MAP_ID, WS_W2D, nullptr};
    case 4: return TDesc{a.in[6], nullptr, DM, INW, 4096, MAP_WIN, WS_WIN, a.in[5]};
    case 5: return TDesc{a.in[17], nullptr, 512, DM, DM, MAP_ID, WS_WNSA, nullptr};
    case 6: return TDesc{a.in[26], nullptr, 512, 2048, 2048, MAP_GLU, WS_WGLU, nullptr};
    case 7: return TDesc{a.in[27], nullptr, DM, DM, DM, MAP_ID, WS_WOUT, nullptr};
    case 8: return TDesc{a.in[13], nullptr, 2048, 256, 256, MAP_ID, WS_WC1K, nullptr};
    default: return TDesc{a.in[15], nullptr, 2048, 256, 256, MAP_ID, WS_WC1V, nullptr};
    }
}
constexpr int N_TMAT = 10;
__device__ __forceinline__ bool tmat_early(int id) { return id == 0 || id == 2 || id == 4 || id == 8 || id == 9; }
__device__ __forceinline__ int tmat_items(const TDesc& d) { return (d.K / 64) * (d.Nt / 32); }
__device__ __forceinline__ int tmat_ldt(const TDesc& d) { return d.K == 512 ? K5_LD : d.K; }
__device__ __forceinline__ void tmat_item(const Args& a, const TDesc& d, int r, LAS float* scr, int lane) {
    const int nblk = d.Nt / 32, kb = r / nblk, nb = r % nblk, n0 = 32 * nb;
    const float* W = (d.mapid == MAP_GU && ((n0 >> 7) & 1)) ? d.W2 : d.W;
    const int mapid = d.mapid;
    transpose_item(W, d.ldw, (bf16_t*)(a.ws + d.off), tmat_ldt(d), 64 * kb, n0, [mapid](int n) { return map_col(mapid, n); }, scr, lane, d.gain);
}
constexpr int LATE_ITEMS = (DM / 64) * (2 * FF / 32) + (FF / 64) * (DM / 32) + (512 / 64) * (DM / 32) + (512 / 64) * (2048 / 32) + (DM / 64) * (DM / 32);
__device__ __forceinline__ void late_find(const Args& a, int v, TDesc& d, int& r) {
    const int ids[5] = {1, 3, 5, 6, 7};
    int base = 0; d = tdesc(a, ids[0]); r = 0;
#pragma unroll
    for (int q = 0; q < 5; ++q) { const TDesc t = tdesc(a, ids[q]); const int n = tmat_items(t); if (v >= base && v < base + n) { d = t; r = v - base; } base += n; }
}
__device__ __forceinline__ void late_load(const TDesc& d, int r, int lane, f32x4 (&v)[8]) {
    const int nblk = d.Nt / 32, kb = r / nblk, nb = r % nblk, n0 = 32 * nb;
    const float* W = (d.mapid == MAP_GU && ((n0 >> 7) & 1)) ? d.W2 : d.W;
    const int mapid = d.mapid;
    transpose_load(W, d.ldw, 64 * kb, n0, [mapid](int n) { return map_col(mapid, n); }, lane, d.gain, v);
}
__device__ __forceinline__ void late_store(const Args& a, const TDesc& d, int r, LAS float* scr, int lane, const f32x4 (&v)[8]) {
    const int nblk = d.Nt / 32, kb = r / nblk, nb = r % nblk;
    transpose_store(v, (bf16_t*)(a.ws + d.off), tmat_ldt(d), 64 * kb, 32 * nb, scr, lane);
}
__device__ __forceinline__ void late_item2(const Args& a, int v0, int v1, LAS float* scr, int lane) {
    TDesc d0, d1; int r0, r1; late_find(a, v0, d0, r0); late_find(a, v1, d1, r1);
    f32x4 x0[8], x1[8];
    late_load(d0, r0, lane, x0); late_load(d1, r1, lane, x1);
    late_store(a, d0, r0, scr, lane, x0); late_store(a, d1, r1, scr, lane, x1);
}
__device__ __forceinline__ void p0_prologue(Frame& F, const Args& a) {
    LAS float* scr = (LAS float*)(F.lds + RING_OFF + F.wave * 16384);
    const int gw = F.vcu * NWAVES + F.wave, NGW = F.G * NWAVES;
    unsigned char* ws = a.ws;
    { bf16_t* xn = (bf16_t*)(ws + WS_XN); float* ssq = (float*)(ws + WS_SSQ);
      const int per_x = F.G / 8, xcd = F.vcu / per_x, wl = (F.vcu % per_x) * NWAVES + F.wave, nwl = per_x * NWAVES, rows_x = T / 8;
      for (int r = wl; r < rows_x / 2; r += nwl) { const int m = xcd * rows_x + r, m1 = m + rows_x / 2;
          prep_row2(a.in[0] + (size_t)m * DM, a.in[0] + (size_t)m1 * DM, a.in[1], xn + (size_t)m * DM, xn + (size_t)m1 * DM, ssq + (size_t)m * 16, ssq + (size_t)m1 * 16, F.lane); } }
    int base = 0;
    for (int id = 0; id < N_TMAT; ++id) {
        if (!tmat_early(id)) continue;
        const TDesc d = tdesc(a, id);
        const int nitems = tmat_items(d);
        int first = gw - (base % NGW); if (first < 0) first += NGW;
        for (int r = first; r < nitems; r += NGW) tmat_item(a, d, r, scr, F.lane);
        base += nitems;
    }
    for (int wt = gw; wt < SSM_G * 64; wt += NGW) ssm_weights_task(a, wt >> 6, wt & 63, F.lane, scr);
    for (int wt = gw; wt < 64; wt += NGW) { const int kv = wt >> 5, kc = (wt >> 2) & 7, n = (wt & 3) * 64 + F.lane;
        const float* pos = a.in[kv ? 12 : 11]; const float* w1 = a.in[kv ? 15 : 13]; float acc = 0.f;
        for (int k0 = kc * 256; k0 < kc * 256 + 256; k0 += 16) {
            float wv[16], pv[16];
#pragma unroll
            for (int j = 0; j < 16; ++j) { wv[j] = w1[(size_t)(k0 + j) * 256 + n]; pv[j] = pos[k0 + j]; }
#pragma unroll
            for (int j = 0; j < 16; ++j) acc += pv[j] * wv[j]; }
        ((float*)(ws + WS_MISC))[(kv * 8 + kc) * 256 + n] = acc; }
}

typedef short bf16x8_t __attribute__((ext_vector_type(8)));
typedef float f32x16_t __attribute__((ext_vector_type(16)));
__device__ __forceinline__ void cmp_l2_wave(const bf16_t* hidrows, const float* w2, const float* knorm, bf16_t* outrows, int mrow0, int lane) {
    const int r32 = lane & 31, hi = lane >> 5;
    f32x16_t acc0 = {}, acc1 = {};
    for (int k4 = 0; k4 < 16; k4 += 4) {
        bf16x8_t af[4]; float wv[4][16];
#pragma unroll
        for (int q = 0; q < 4; ++q) { const int ks = k4 + q; af[q] = *(const bf16x8_t*)(hidrows + (size_t)r32 * 256 + 16 * ks + 8 * hi);
#pragma unroll
            for (int j = 0; j < 4; ++j) { const float* wp = w2 + (size_t)(16 * ks + 8 * hi + 2 * j) * 64 + r32; wv[q][4 * j] = wp[0]; wv[q][4 * j + 1] = wp[64]; wv[q][4 * j + 2] = wp[32]; wv[q][4 * j + 3] = wp[64 + 32]; } }
#pragma unroll
        for (int q = 0; q < 4; ++q) {
            const bf16x8_t bf0 = __builtin_bit_cast(bf16x8_t, (v4u){pk2(wv[q][0], wv[q][1]), pk2(wv[q][4], wv[q][5]), pk2(wv[q][8], wv[q][9]), pk2(wv[q][12], wv[q][13])});
            const bf16x8_t bf1 = __builtin_bit_cast(bf16x8_t, (v4u){pk2(wv[q][2], wv[q][3]), pk2(wv[q][6], wv[q][7]), pk2(wv[q][10], wv[q][11]), pk2(wv[q][14], wv[q][15])});
            acc0 = __builtin_amdgcn_mfma_f32_32x32x16_bf16(af[q], bf0, acc0, 0, 0, 0);
            acc1 = __builtin_amdgcn_mfma_f32_32x32x16_bf16(af[q], bf1, acc1, 0, 0, 0);
        }
    }
    const float g0 = knorm ? knorm[r32] : 1.f, g1 = knorm ? knorm[32 + r32] : 1.f;
#pragma unroll
    for (int r = 0; r < 16; ++r) {
        const int row = (r & 3) + 8 * (r >> 2) + 4 * hi;
        float v0 = acc0[r], v1 = acc1[r];
        if (knorm) { float ss = v0 * v0 + v1 * v1;
            ss += __shfl_xor(ss, 1); ss += __shfl_xor(ss, 2); ss += __shfl_xor(ss, 4); ss += __shfl_xor(ss, 8); ss += __shfl_xor(ss, 16);
            const float rn = rsqrtf(ss * (1.f / 64.f) + RMS_EPS); v0 *= rn * g0; v1 *= rn * g1; }
        if (((mrow0 + row) & 255) == 255) { v0 = 0.f; v1 = 0.f; }
        outrows[(size_t)row * 64 + r32] = f2bf(v0); outrows[(size_t)row * 64 + 32 + r32] = f2bf(v1);
    }
}

__global__ void __launch_bounds__(NWAVES * 64, 2) mega(Args args) {
    extern __shared__ __attribute__((aligned(16))) unsigned char lds[];
    Frame F;
    F.lds = (LAS unsigned char*)lds;
    F.MISC = (volatile LAS unsigned*)(F.lds + MISC_OFF);
    F.tid = threadIdx.x; F.lane = F.tid & 63; F.wave = __builtin_amdgcn_readfirstlane(F.tid >> 6);
    F.G = gridDim.x; { const int bx = blockIdx.x; F.vcu = (F.G % 8 == 0) ? (bx % 8) * (F.G / 8) + bx / 8 : bx; }
    unsigned char* ws = args.ws;
    F.ctl = (gu32*)(ws + WS_CTL);
    for (int u = F.tid; u < (LDS_BYTES - LDSCTL_OFF) / 4; u += NWAVES * 64) ((LAS unsigned*)(F.lds + LDSCTL_OFF))[u] = 0u;
    __syncthreads();
    XcdBarrier bar; bar.bar = (unsigned*)(F.ctl + CW_BAR); bar.x = 0; bar.st = nullptr;
    if (args.fused) bar = xcd_barrier_post((unsigned*)(F.ctl + CW_BAR), F.MISC + 8);
    const int lo = args.ph_lo, hi = args.ph_hi;
#define SELF_HANDOFF() do { asm volatile("s_waitcnt vmcnt(0)" ::: "memory"); __syncthreads(); } while (0)
#define IN(k) (lo <= (k) && (k) < hi)
#define SEAM(k) do { if (IN(k) && IN((k) + 1)) xcd_barrier(bar); } while (0)
    float* out = args.out;
    bf16_t* xn = (bf16_t*)(ws + WS_XN); float* ssq = (float*)(ws + WS_SSQ); bf16_t* act = (bf16_t*)(ws + WS_ACT);

    if (IN(PH_PRO)) { p0_prologue(F, args); } SEAM(PH_PRO);

    if (IN(PH_F1GU)) {
        pg8::Gemm g{xn, (const bf16_t*)(ws + WS_W1GU), DM, DM, DM, 0, 0}; pg8::StaticOrder S; S.init(T, 2 * FF, F.G, (int)blockIdx.x);
        epi::EpiSwiGLU E{act, ssq, (LAS float*)(F.lds + RING_BYTES), -1};
        pg8::gemm_phase<epi::EpiSwiGLU, pg8::StaticOrder, PG8_ALIGN, PG8_SP2>(F.lds + RING_OFF, g, S, E);
    } SEAM(PH_F1GU);

    if (IN(PH_F1D)) {
        pg8::Gemm g{act, (const bf16_t*)(ws + WS_W1D), ACT_LD, FF, FF, 0, 0}; pg8::StaticOrder S; S.init(T, DM, F.G, (int)blockIdx.x);
        epi::EpiResid<true, false> E{nullptr, xn, nullptr, 0.5f, xn, ssq};
        pg8::gemm_phase<epi::EpiResid<true, false>, pg8::StaticOrder, PG8_ALIGN, PG8_SP2>(F.lds + RING_OFF, g, S, E);
    } SEAM(PH_F1D);

    if (IN(PH_WIN)) {
        pg8::Gemm g{xn, (const bf16_t*)(ws + WS_WIN), DM, DM, DM, 0, 0}; pg8::StaticOrder S; S.init(T, 4096, F.G, (int)blockIdx.x);
        epi::EpiWin E; E.ssq = ssq; E.q = (bf16_t*)(ws + WS_Q); E.ks = (bf16_t*)(ws + WS_KS); E.vs = (bf16_t*)(ws + WS_VS); E.kw = (bf16_t*)(ws + WS_KW); E.vw = (bf16_t*)(ws + WS_VW);
        E.kcr = (bf16_t*)(ws + WS_KCR); E.vcr = (bf16_t*)(ws + WS_VCR); E.acat = (bf16_t*)(ws + WS_ACAT); E.sgn = (bf16_t*)(ws + WS_SGN); E.sgs = (bf16_t*)(ws + WS_SGS); E.g3 = (float*)(ws + WS_G3);
        E.gains = (LAS float*)(F.lds + RING_BYTES + 16384); E.rs_tab = (LAS float*)(F.lds + RING_BYTES); E.cached_pm = -1;
        if (F.tid < 192) E.gains[F.tid] = (F.tid < 64 ? args.in[7] : F.tid < 128 ? args.in[9] : args.in[10])[F.tid & 63];
        __syncthreads();
        pg8::gemm_phase<epi::EpiWin, pg8::StaticOrder, PG8_ALIGN, PG8_SP2>(F.lds + RING_OFF, g, S, E);
    } SEAM(PH_WIN);

    if (IN(PH_MIDA)) {
        const int vcu = F.vcu;
        {
#if defined(REP_MIDA)
            const int cu = ((vcu & 1) == 0 && !(args.pad & 32)) ? (vcu >> 3) : -1, ks = (vcu & 7) >> 1;
#else
            const int cu = (vcu & 1) == 0 ? (vcu >> 3) : -1, ks = (vcu & 7) >> 1;
#endif
            unsigned* cnt = (unsigned*)(F.ctl + CW_CMP);
            pg8::Gemm g{(const bf16_t*)(ws + WS_KCR) + ks * 512, (const bf16_t*)(ws + WS_WC1K) + ks * 512, 1024, 2048, 512, WS_VCR - WS_KCR, WS_WC1V - WS_WC1K};
            pg8::GroupOrder S; S.init(16, 1, 2, F.G, cu);
            epi::EpiCmp1S E{(bf16_t*)(ws + WS_HID), (const float*)(ws + WS_MISC), (float*)(ws + WS_CPART), cnt, ks};
            pg8::gemm_phase<epi::EpiCmp1S, pg8::GroupOrder, false, PG8_SP2>(F.lds + RING_OFF, g, S, E);
            if (cu >= 0 && ks != 0) { if (F.tid == 0) __hip_atomic_fetch_add(cnt + 16 * cu, 1u, RLX_AGENT); }
            if (cu >= 0 && ks == 0) {
                SELF_HANDOFF();
                const int pg = cu >> 4, pm = cu & 15, r0 = pm * 256 + F.wave * 32;
                cmp_l2_wave((const bf16_t*)(ws + WS_HID) + ((size_t)pg * 4096 + r0) * 256, args.in[pg ? 16 : 14], pg ? nullptr : args.in[8],
                            (bf16_t*)(ws + (pg ? WS_VCMP : WS_KCMP)) + (size_t)r0 * 64, r0, F.lane);
            }
        }
        {
#if defined(REP_MIDA)
            const int cu = ((vcu & 3) == 1 && !(args.pad & 64)) ? (vcu >> 2) : -1;
#else
            const int cu = (vcu & 3) == 1 ? (vcu >> 2) : -1;
#endif
            pg8::Gemm g{(const bf16_t*)(ws + WS_ACAT), (const bf16_t*)(ws + WS_W1S), ACAT_LD, 1024, 1024, (size_t)512 * ACAT_LD * 2, (size_t)128 * 1024 * 2};
            pg8::GroupOrder S; S.init(2, 1, SSM_G, F.G, cu);
            epi::EpiSst E{(float*)(ws + WS_SST)};
            pg8::gemm_phase<epi::EpiSst, pg8::GroupOrder, false, PG8_SP2>(F.lds + RING_OFF, g, S, E);
            if (cu >= 0) {
                SELF_HANDOFF();
                ssm_carry_scan(args, cu >> 1, cu & 1, F.tid);
            }
        }
        {
            unsigned* ctr = (unsigned*)(F.ctl + CW_TOEP);
            LAS float* scr = (LAS float*)(F.lds + RING_OFF + F.wave * 16384);
            volatile LAS int* qs = (volatile LAS int*)(F.lds + RING_BYTES);
            constexpr int LATE_CH = LATE_ITEMS / 16, TOEP_CH = SSM_G * 1024 / 32;
            static_assert(LATE_ITEMS % 16 == 0, "late items come in chunks of 16");
            if (F.tid == 0) qs[0] = (int)__hip_atomic_fetch_add(ctr, 1u, RLX_AGENT);
            __syncthreads();
            int cur = qs[0];
            for (int it = 0; cur < LATE_CH + TOEP_CH; ++it) {
                int nxt = 0;
                if (F.tid == 0) nxt = (int)__hip_atomic_fetch_add(ctr, 1u, RLX_AGENT);
                if (cur < LATE_CH) late_item2(args, cur * 16 + F.wave, cur * 16 + 8 + F.wave, scr, F.lane);
                else toep_rows4(ws, ((cur - LATE_CH) * 8 + F.wave) * 4, F.lane);
                if (F.tid == 0) qs[(it + 1) & 1] = nxt;
                __syncthreads();
                cur = qs[(it + 1) & 1];
            }
        }
    } SEAM(PH_MIDA);

    if (IN(PH_MIDB)) {
        if (args.pad & 4) {
            pg8::GroupOrder S; S.init(2, 4, SSM_G, F.G, F.vcu);
            pg8::Unit u0;
            (void)u0;
            pg8::Gemm g{(const bf16_t*)(ws + WS_ACAT), (const bf16_t*)(ws + WS_WTOEP), ACAT_LD, ACAT_LD, ACAT_LD, (size_t)512 * ACAT_LD * 2, (size_t)1024 * ACAT_LD * 2};
            epi::EpiSsmOut E{(const bf16_t*)(ws + WS_ACAT), args.in[25], ((bf16_t*)out + (size_t)T * K5_LD)};
            pg8::gemm_phase<epi::EpiSsmOut, pg8::GroupOrder, false, PG8_SP2>(F.lds + RING_OFF, g, S, E);
        }
        if (args.pad & 3) {
            nsa::Tensors AT{(const bf16_t*)(ws + WS_Q), (const bf16_t*)(ws + WS_KCMP), (const bf16_t*)(ws + WS_VCMP), (const bf16_t*)(ws + WS_KS), (const bf16_t*)(ws + WS_VS),
                            (const bf16_t*)(ws + WS_KW), (const bf16_t*)(ws + WS_VW), (const float*)(ws + WS_G3), ((bf16_t*)out), (bf16_t*)(ws + WS_OWIN), false, false};
            {
                const float gq = wave_max(fabsf(args.in[7][F.lane])), gks = wave_max(fabsf(args.in[9][F.lane])), gkw = wave_max(fabsf(args.in[10][F.lane]));
                AT.bounded_slc = C2 * 64.f * gq * gks < 24.f; AT.bounded_win = C2 * 64.f * gq * gkw < 24.f;
            }
            const int bgi = F.vcu >> 4, sidx = F.vcu & 15;
            if (F.wave >= 4) __builtin_amdgcn_s_setprio(1);
            for (int i = 0; i < 4; ++i) { const int qb = (i == 0) ? sidx : (i == 1) ? 31 - sidx : (i == 2) ? 32 + sidx : 63 - sidx;

#if defined(PROBE_ATT)
                if (args.pad & 16) nsa::unit<PROBE_ATT>(AT, F.lds + RING_OFF, bgi >> 1, bgi & 1, qb, args.pad & 3); else
#endif
                nsa::unit<0>(AT, F.lds + RING_OFF, bgi >> 1, bgi & 1, qb, args.pad & 3); }
            __builtin_amdgcn_s_setprio(0);
        }
    } SEAM(PH_MIDB);

    if (IN(PH_NSA)) {
        pg8::StaticOrder S; S.init(T, DM, F.G, (int)blockIdx.x);
        { pg8::Gemm g{((const bf16_t*)out), (const bf16_t*)(ws + WS_WNSA), K5_LD, K5_LD, 512, 0, 0};
          epi::EpiNsa E{(const bf16_t*)(ws + WS_SGN), (bf16_t*)(ws + WS_M1)};
          pg8::gemm_phase<epi::EpiNsa, pg8::StaticOrder, PG8_ALIGN, PG8_SP2>(F.lds + RING_OFF, g, S, E); }
        SELF_HANDOFF();
        { pg8::Gemm g{((const bf16_t*)out + (size_t)T * K5_LD), (const bf16_t*)(ws + WS_WGLU), K5_LD, K5_LD, 512, 0, 0}; pg8::SplitOrder L{S};
          epi::EpiGlu E{(const bf16_t*)(ws + WS_SGS), (const bf16_t*)(ws + WS_M1), (bf16_t*)(ws + WS_MERGED)};
          pg8::gemm_phase<epi::EpiGlu, pg8::SplitOrder, PG8_ALIGN, PG8_SP2>(F.lds + RING_OFF, g, L, E); }
    } SEAM(PH_NSA);

    if (IN(PH_WOUT)) {
        pg8::Gemm g{(const bf16_t*)(ws + WS_MERGED), (const bf16_t*)(ws + WS_WOUT), DM, DM, DM, 0, 0}; pg8::StaticOrder S; S.init(T, DM, F.G, (int)blockIdx.x);
        epi::EpiResid<true, false> E{nullptr, xn, nullptr, 1.0f, xn, ssq};
        pg8::gemm_phase<epi::EpiResid<true, false>, pg8::StaticOrder, PG8_ALIGN, PG8_SP2>(F.lds + RING_OFF, g, S, E);
    } SEAM(PH_WOUT);

    if (IN(PH_F2GU)) {
        pg8::Gemm g{xn, (const bf16_t*)(ws + WS_W2GU), DM, DM, DM, 0, 0}; pg8::StaticOrder S; S.init(T, 2 * FF, F.G, (int)blockIdx.x);
        epi::EpiSwiGLU E{act, ssq, (LAS float*)(F.lds + RING_BYTES), -1};
        pg8::gemm_phase<epi::EpiSwiGLU, pg8::StaticOrder, PG8_ALIGN, PG8_SP2>(F.lds + RING_OFF, g, S, E);
    } SEAM(PH_F2GU);

    if (IN(PH_F2D)) {
        pg8::Gemm g{act, (const bf16_t*)(ws + WS_W2D), ACT_LD, FF, FF, 0, 0}; pg8::StaticOrder S; S.init(T, DM, F.G, (int)blockIdx.x);
        epi::EpiResid<true, true> E{nullptr, xn, out, 0.5f, nullptr, nullptr};
        pg8::gemm_phase<epi::EpiResid<true, true>, pg8::StaticOrder, PG8_ALIGN, PG8_SP2>(F.lds + RING_OFF, g, S, E);
    }
#undef IN
#undef SEAM
}

template <int NB, class AL, class BL, class EPI>
__device__ __forceinline__ void tgemm(int m0, int n0, int K, const AL& al, const BL& bl, const EPI& epi) {
    __shared__ float As[16][64 + 4];
    __shared__ float Bs[NB][16][64 + 4];
    __shared__ float Cs[NB][64][65];
    const int tid = threadIdx.x, ty = tid >> 4, tx = tid & 15;
    float acc[NB][4][4];
#pragma unroll
    for (int b = 0; b < NB; ++b)
#pragma unroll
        for (int i = 0; i < 4; ++i)
#pragma unroll
            for (int j = 0; j < 4; ++j) acc[b][i][j] = 0.f;
    for (int k0 = 0; k0 < K; k0 += 16) {
        {
            const int m = tid >> 2, kk = (tid & 3) * 4;
#pragma unroll
            for (int i = 0; i < 4; ++i) As[kk + i][m] = al(m0 + m, k0 + kk + i);
        }
        {
            const int kk = tid >> 4, nn = (tid & 15) * 4;
#pragma unroll
            for (int b = 0; b < NB; ++b)
#pragma unroll
                for (int j = 0; j < 4; ++j) Bs[b][kk][nn + j] = bl(b, k0 + kk, n0 + nn + j);
        }
        __syncthreads();
#pragma unroll
        for (int kk = 0; kk < 16; ++kk) {
            float a[4];
#pragma unroll
            for (int i = 0; i < 4; ++i) a[i] = As[kk][ty * 4 + i];
#pragma unroll
            for (int b = 0; b < NB; ++b) {
                float bv[4];
#pragma unroll
                for (int j = 0; j < 4; ++j) bv[j] = Bs[b][kk][tx * 4 + j];
#pragma unroll
                for (int i = 0; i < 4; ++i)
#pragma unroll
                    for (int j = 0; j < 4; ++j) acc[b][i][j] += a[i] * bv[j];
            }
        }
        __syncthreads();
    }
#pragma unroll
    for (int b = 0; b < NB; ++b)
#pragma unroll
        for (int i = 0; i < 4; ++i)
#pragma unroll
            for (int j = 0; j < 4; ++j) Cs[b][ty * 4 + i][tx * 4 + j] = acc[b][i][j];
    __syncthreads();
    epi(Cs, m0, n0);
}

__device__ __forceinline__ float row_rstd(const float* ssq, int t) {
    float s = 0.f;
#pragma unroll
    for (int i = 0; i < 16; ++i) s += ssq[(size_t)t * 16 + i];
    return rsqrtf(s * (1.f / DM) + RMS_EPS);
}

__global__ void __launch_bounds__(256) k_prep_rows(const float* x, const float* g, bf16_t* xn, float* ssq) {
    const int row = blockIdx.x * 4 + (threadIdx.x >> 6), lane = threadIdx.x & 63;
    const float* xr = x + (size_t)row * DM;
    float s = 0.f;
    for (int c = lane; c < DM; c += 64) { const float v = xr[c]; s += v * v; xn[(size_t)row * DM + c] = f2bf(v * g[c]); }
    s = wave_sum(s);
    if (lane < 16) ssq[(size_t)row * 16 + lane] = (lane == 0) ? s : 0.f;
}
__global__ void __launch_bounds__(256) k_row_ssq(const float* x, float* ssq) {
    const int row = blockIdx.x * 4 + (threadIdx.x >> 6), lane = threadIdx.x & 63;
    const float* xr = x + (size_t)row * DM;
    float s = 0.f;
    for (int c = lane; c < DM; c += 64) { const float v = xr[c]; s += v * v; }
    s = wave_sum(s);
    if (lane < 16) ssq[(size_t)row * 16 + lane] = (lane == 0) ? s : 0.f;
}

__global__ void __launch_bounds__(256) k_ffn_gu(const bf16_t* xn, const float* ssq, const float* wg, const float* wu, bf16_t* act) {
    const int m0 = blockIdx.y * 64, n0 = blockIdx.x * 64;
    auto al = [&](int m, int k) { return bf2f(xn[(size_t)m * DM + k]); };
    auto bl = [&](int b, int k, int n) { return (b == 0 ? wg : wu)[(size_t)k * FF + n]; };
    auto epi = [&](float (*Cs)[64][65], int m0_, int n0_) {
        const int tid = threadIdx.x;
        for (int e = tid; e < 64 * 64; e += 256) {
            const int r = e >> 6, c = e & 63, t = m0_ + r;
            const float rs = row_rstd(ssq, t);
            const float gv = Cs[0][r][c] * rs, uv = Cs[1][r][c] * rs;
            act[(size_t)t * FF + n0_ + c] = f2bf(gv * sigmoidf_(gv) * uv);
        }
    };
    tgemm<2>(m0, n0, DM, al, bl, epi);
}
__global__ void __launch_bounds__(256) k_ffn_down(const bf16_t* act, const float* wd, const float* xin, float* out, const float* gnext, bf16_t* xn) {
    const int m0 = blockIdx.y * 64, n0 = blockIdx.x * 64;
    auto al = [&](int m, int k) { return bf2f(act[(size_t)m * FF + k]); };
    auto bl = [&](int b, int k, int n) { return wd[(size_t)k * DM + n]; };
    auto epi = [&](float (*Cs)[64][65], int m0_, int n0_) {
        for (int e = threadIdx.x; e < 64 * 64; e += 256) {
            const int r = e >> 6, c = e & 63, t = m0_ + r, n = n0_ + c;
            const float o = xin[(size_t)t * DM + n] + 0.5f * Cs[0][r][c];
            out[(size_t)t * DM + n] = o;
            if (xn) xn[(size_t)t * DM + n] = f2bf(o * gnext[n]);
        }
    };
    tgemm<1>(m0, n0, FF, al, bl, epi);
}

__device__ __forceinline__ int win_origcol(int v) {
    if (v < 1280) return v;
    if (v < 1792) return 1304 + (v - 1280);
    if (v < 2816) return 1816 + (v - 1792);
    if (v < 3840) return 2840 + (v - 2816);
    if (v < 3864) return 1280 + (v - 3840);
    return -1;
}
struct WinOut {
    bf16_t *q, *ks, *vs, *kw, *vw, *kcr, *vcr, *acat, *sgn, *sgs; float* g3;
    const float *q_norm, *k_norm_slc, *k_norm_win;
};
__global__ void __launch_bounds__(256) k_win_proj(const bf16_t* xn, const float* ssq, const float* win, WinOut o, int skip_lo, int skip_hi) {
    const int m0 = blockIdx.y * 64, nt = blockIdx.x, n0 = nt * 64;
    if (nt > 60) return;
    if (nt >= skip_lo && nt < skip_hi) return;
    auto al = [&](int m, int k) { return bf2f(xn[(size_t)m * DM + k]); };
    auto bl = [&](int b, int k, int n) { const int oc = win_origcol(n); return oc >= 0 ? win[(size_t)k * INW + oc] : 0.f; };
    auto epi = [&](float (*Cs)[64][65], int m0_, int n0_) {
        const int tid = threadIdx.x;
        if (tid >= 64) return;
        const int r = tid, t = m0_ + r, b = t / SEQ, s = t % SEQ;
        const float rs = row_rstd(ssq, t);
        float v[64];
#pragma unroll
        for (int c = 0; c < 64; ++c) v[c] = Cs[0][r][c] * rs;
        if (nt < 8 || nt == 12 || nt == 13 || nt == 16 || nt == 17) {
            float ss = 0.f;
#pragma unroll
            for (int c = 0; c < 64; ++c) ss += v[c] * v[c];
            const float rn = rsqrtf(ss * (1.f / 64.f) + RMS_EPS);
            if (nt < 8) { bf16_t* dst = o.q + (((size_t)b * NH + nt) * SEQ + s) * 64;
#pragma unroll
                for (int c = 0; c < 64; ++c) dst[c] = f2bf(v[c] * rn * o.q_norm[c] * C2); }
            else { const bool isS = nt < 16; const int g = isS ? nt - 12 : nt - 16; bf16_t* dst = (isS ? o.ks : o.kw) + (((size_t)b * NG + g) * SEQ + s) * 64; const float* gn = isS ? o.k_norm_slc : o.k_norm_win;
#pragma unroll
                for (int c = 0; c < 64; ++c) dst[c] = f2bf(v[c] * rn * gn[c]); }
        } else if (nt < 20) {
            bf16_t* base; int g;
            if (nt < 10) { base = o.kcr; g = nt - 8; } else if (nt < 12) { base = o.vcr; g = nt - 10; } else if (nt < 16) { base = o.vs; g = nt - 14; } else { base = o.vw; g = nt - 18; }
            bf16_t* dst = base + (((size_t)b * NG + g) * SEQ + s) * 64;
#pragma unroll
            for (int c = 0; c < 64; ++c) dst[c] = f2bf(v[c]);
        } else if (nt < 28) {
#pragma unroll
            for (int c = 0; c < 64; ++c) { const int ch = 64 * (nt - 20) + c, g = ch >> 4, ci = ch & 15;
                o.acat[((size_t)g * 512 + b * 64 + (s >> 6)) * ACAT_LD + (s & 63) * 16 + ci] = f2bf(v[c]); }
        } else if (nt < 60) {
            const bool isN = nt < 44; bf16_t* dst = (isN ? o.sgn : o.sgs) + (size_t)t * DM + (isN ? nt - 28 : nt - 44) * 64;
#pragma unroll
            for (int c = 0; c < 64; ++c) dst[c] = f2bf(sigmoidf_(v[c]));
        } else {
#pragma unroll
            for (int c = 0; c < 24; ++c) o.g3[(size_t)t * 24 + c] = sigmoidf_(v[c]);
        }
    };
    tgemm<1>(m0, n0, DM, al, bl, epi);
}

__global__ void __launch_bounds__(256) k_cmp_l1(const bf16_t* kcr, const bf16_t* vcr, const float* posk, const float* posv, const float* w1k, const float* w1v, bf16_t* hid) {
    const int kv = blockIdx.z, m0 = blockIdx.y * 64, n0 = blockIdx.x * 64;
    const bf16_t* src = kv ? vcr : kcr; const float* pos = kv ? posv : posk; const float* w1 = kv ? w1v : w1k;
    auto al = [&](int m, int k) { const int bg = m >> 8, c = m & 255, s = k >> 6, d = k & 63, tok = 16 * c + s;
        if (tok >= SEQ) return 0.f; return bf2f(src[((size_t)bg * SEQ + tok) * 64 + d]) + pos[k]; };
    auto bl = [&](int b, int k, int n) { return w1[(size_t)k * 256 + n]; };
    auto epi = [&](float (*Cs)[64][65], int m0_, int n0_) {
        for (int e = threadIdx.x; e < 64 * 64; e += 256) { const int r = e >> 6, c = e & 63;
            hid[((size_t)kv * 4096 + m0_ + r) * 256 + n0_ + c] = f2bf(gelu_tanh(Cs[0][r][c])); }
    };
    tgemm<1>(m0, n0, 2048, al, bl, epi);
}
__global__ void __launch_bounds__(256) k_cmp_l2(const bf16_t* hid, const float* w2k, const float* w2v, const float* knorm, bf16_t* kcmp, bf16_t* vcmp) {
    const int gw = blockIdx.x * 4 + (threadIdx.x >> 6), lane = threadIdx.x & 63;
    const int kv = gw >> 12, m = gw & 4095;
    const float* w2 = kv ? w2v : w2k; const bf16_t* h = hid + ((size_t)kv * 4096 + m) * 256;
    float acc = 0.f;
    for (int k = 0; k < 256; ++k) acc += bf2f(h[k]) * w2[k * 64 + lane];
    if (!kv) { const float ss = wave_sum(acc * acc); acc = acc * rsqrtf(ss * (1.f / 64.f) + RMS_EPS) * knorm[lane]; }
    if ((m & 255) == 255) acc = 0.f;
    (kv ? vcmp : kcmp)[(size_t)m * 64 + lane] = f2bf(acc);
}

constexpr int SSMP_AB = 0, SSMP_BB = SSM_G * SSM_P * 2;
__global__ void k_ssm_params(const float* lre, const float* lim, const float* lstep, const float* bre, const float* bim, float* sp) {
    const int g = blockIdx.x, p = threadIdx.x;
    const double lr = lre[g * 64 + p], li = lim[g * 64 + p], step = exp((double)lstep[g]);
    const double mag = exp(lr * step), ar = mag * cos(li * step), ai = mag * sin(li * step);
    const double den = lr * lr + li * li, cr = ((ar - 1.0) * lr + ai * li) / den, ci = (ai * lr - (ar - 1.0) * li) / den;
    sp[SSMP_AB + (g * 64 + p) * 2 + 0] = (float)ar; sp[SSMP_AB + (g * 64 + p) * 2 + 1] = (float)ai;
    for (int c = 0; c < 16; ++c) { const double br = bre[(g * 64 + p) * 16 + c], bi = bim[(g * 64 + p) * 16 + c];
        sp[SSMP_BB + ((g * 64 + p) * 16 + c) * 2 + 0] = (float)(cr * br - ci * bi); sp[SSMP_BB + ((g * 64 + p) * 16 + c) * 2 + 1] = (float)(cr * bi + ci * br); }
}
__global__ void __launch_bounds__(64) k_ssm_scan(const bf16_t* acat, const float* sp, const float* cre, const float* cim, const float* dsk, bf16_t* geluy) {
    __shared__ float Cre[16][65], Cim[16][65], U[64][16], XR[64], XI[64];
    const int b = blockIdx.x / SSM_G, g = blockIdx.x % SSM_G, p = threadIdx.x;
    for (int e = p; e < 16 * 64; e += 64) { Cre[e >> 6][e & 63] = cre[(g * 16 + (e >> 6)) * 64 + (e & 63)]; Cim[e >> 6][e & 63] = cim[(g * 16 + (e >> 6)) * 64 + (e & 63)]; }
    const float ar = sp[SSMP_AB + (g * 64 + p) * 2], ai = sp[SSMP_AB + (g * 64 + p) * 2 + 1];
    float br[16], bi[16];
#pragma unroll
    for (int c = 0; c < 16; ++c) { br[c] = sp[SSMP_BB + ((g * 64 + p) * 16 + c) * 2]; bi[c] = sp[SSMP_BB + ((g * 64 + p) * 16 + c) * 2 + 1]; }
    const int co = p & 15, qd = p >> 4; const float dv = dsk[g * 16 + co];
    float xr = 0.f, xi = 0.f;
    for (int ch = 0; ch < 64; ++ch) {
        __syncthreads();
        const bf16_t* urow = acat + ((size_t)g * 512 + b * 64 + ch) * ACAT_LD;
        for (int e = p; e < 1024; e += 64) U[e >> 4][e & 15] = bf2f(urow[e]);
        __syncthreads();
        for (int i = 0; i < 64; ++i) {
            float ur = 0.f, ui = 0.f;
#pragma unroll
            for (int c = 0; c < 16; ++c) { ur += br[c] * U[i][c]; ui += bi[c] * U[i][c]; }
            const float nr = ar * xr - ai * xi + ur, ni = ar * xi + ai * xr + ui; xr = nr; xi = ni;
            XR[p] = xr; XI[p] = xi;
            __syncthreads();
            float y = 0.f;
#pragma unroll
            for (int pp = 0; pp < 16; ++pp) { const int P_ = qd * 16 + pp; y += Cre[co][P_] * XR[P_] - Cim[co][P_] * XI[P_]; }
            y += __shfl_xor(y, 16); y += __shfl_xor(y, 32);
            if (qd == 0) { y += dv * U[i][co]; geluy[((size_t)b * SEQ + ch * 64 + i) * 512 + g * 16 + co] = f2bf(gelu_tanh(y)); }
            __syncthreads();
        }
    }
}

__global__ void __launch_bounds__(256) k_win_attn(const bf16_t* q, const bf16_t* kw, const bf16_t* vw, const float* g3, bf16_t* owin) {
    const int gw = blockIdx.x * 4 + (threadIdx.x >> 6), lane = threadIdx.x & 63;
    const int t = gw >> 3, h = gw & 7, b = t / SEQ, s = t % SEQ, g = h >> 2;
    const float qv = bf2f(q[(((size_t)b * NH + h) * SEQ + s) * 64 + lane]);
    const bf16_t* K = kw + ((size_t)b * NG + g) * SEQ * 64; const bf16_t* V = vw + ((size_t)b * NG + g) * SEQ * 64;
    float m = -1e30f, l = 0.f, acc = 0.f;
    const int k0 = s - 511 < 0 ? 0 : s - 511;
    for (int k = k0; k <= s; ++k) {
        const float sc = wave_sum(qv * bf2f(K[(size_t)k * 64 + lane]));
        const float mn = fmaxf(m, sc), f = exp2f(m - mn), p = exp2f(sc - mn);
        l = l * f + p; acc = acc * f + p * bf2f(V[(size_t)k * 64 + lane]); m = mn;
    }
    owin[(size_t)t * 512 + h * 64 + lane] = f2bf(g3[(size_t)t * 24 + 16 + h] * acc / l);
}

__global__ void __launch_bounds__(256) k_cmp_slc_attn(const bf16_t* q, const bf16_t* kcmp, const bf16_t* vcmp, const bf16_t* ks, const bf16_t* vs, const float* g3, const bf16_t* owin, bf16_t* onsa) {
    __shared__ float Ps[4][4][256];
    __shared__ float Sc[4][1024];
    const int w = threadIdx.x >> 6, lane = threadIdx.x & 63;
    const int gw = blockIdx.x * 4 + w, t = gw >> 1, g = gw & 1, b = t / SEQ, s = t % SEQ, qblk = s >> 6;
    const bf16_t* KC = kcmp + ((size_t)b * NG + g) * 256 * 64; const bf16_t* VC = vcmp + ((size_t)b * NG + g) * 256 * 64;
    const bf16_t* KS = ks + ((size_t)b * NG + g) * SEQ * 64; const bf16_t* VS = vs + ((size_t)b * NG + g) * SEQ * 64;
    const int ncv = (s >= 31) ? ((s - 31) >> 4) + 1 : 0;
    __shared__ float Ocmp[4][4][64];
    for (int r = 0; r < 4; ++r) {
        const bf16_t* qp = q + (((size_t)b * NH + g * 4 + r) * SEQ + s) * 64;
        float sc[4]; float mx = -1e30f;
#pragma unroll
        for (int j = 0; j < 4; ++j) { const int c = lane + 64 * j; float a = -1e30f;
            if (c < ncv) { a = 0.f; for (int d = 0; d < 64; ++d) a += bf2f(qp[d]) * bf2f(KC[(size_t)c * 64 + d]); }
            sc[j] = a; mx = fmaxf(mx, a); }
        mx = wave_max(mx); float den = 0.f;
#pragma unroll
        for (int j = 0; j < 4; ++j) { const int c = lane + 64 * j; sc[j] = (c < ncv) ? exp2f(sc[j] - mx) : 0.f; den += sc[j]; }
        den = wave_sum(den); const float inv = den > 0.f ? 1.f / den : 1.f;
#pragma unroll
        for (int j = 0; j < 4; ++j) Ps[w][r][lane + 64 * j] = sc[j] * inv;
        __syncthreads();
        float a = 0.f;
        for (int c = 0; c < ncv; ++c) a += Ps[w][r][c] * bf2f(VC[(size_t)c * 64 + lane]);
        Ocmp[w][r][lane] = a;
    }
    __syncthreads();
    float imp = 0.f;
    for (int r = 0; r < 4; ++r) for (int c = 4 * lane - 1; c <= 4 * lane + 3; ++c) if (c >= 0 && c < NCMP) imp += Ps[w][r][c];
    const bool force = (lane == 0) || (lane == qblk) || (lane == qblk - 1);
    const float score = (lane <= qblk) ? imp + (force ? 1000.f : 0.f) : -1e30f;
    int rank = 0;
    for (int j = 0; j < 64; ++j) { const float o = __shfl(score, j); rank += (o > score || (o == score && j < lane)) ? 1 : 0; }
    const unsigned long long selmask = __ballot(rank < 16 && lane <= qblk);
    for (int r = 0; r < 4; ++r) {
        const bf16_t* qp = q + (((size_t)b * NH + g * 4 + r) * SEQ + s) * 64;
        int nb = 0; float mx = -1e30f;
        for (int j = 0; j < 64; ++j) if ((selmask >> j) & 1ull) {
            const int key = 64 * j + lane; float a = -1e30f;
            if (key <= s) { a = 0.f; for (int d = 0; d < 64; ++d) a += bf2f(qp[d]) * bf2f(KS[(size_t)key * 64 + d]); }
            Sc[w][nb * 64 + lane] = a; mx = fmaxf(mx, a); ++nb;
        }
        mx = wave_max(mx); float den = 0.f;
        for (int i = 0; i < nb; ++i) { const float a = Sc[w][i * 64 + lane]; const float p = (a > -1e29f) ? exp2f(a - mx) : 0.f; Sc[w][i * 64 + lane] = p; den += p; }
        den = wave_sum(den); const float inv = den > 0.f ? 1.f / den : 1.f;
        __syncthreads();
        float a = 0.f; nb = 0;
        for (int j = 0; j < 64; ++j) if ((selmask >> j) & 1ull) {
            for (int kk = 0; kk < 64; ++kk) { const float p = Sc[w][nb * 64 + kk]; if (p != 0.f) a += p * bf2f(VS[(size_t)(64 * j + kk) * 64 + lane]); }
            ++nb;
        }
        const int h = g * 4 + r;
        const float o = g3[(size_t)t * 24 + h] * Ocmp[w][r][lane] + g3[(size_t)t * 24 + 8 + h] * (a * inv) + bf2f(owin[(size_t)t * 512 + h * 64 + lane]);
        onsa[(size_t)t * 512 + h * 64 + lane] = f2bf(o);
        __syncthreads();
    }
}

__global__ void __launch_bounds__(256) k_nsa_proj(const bf16_t* onsa, const float* w, const bf16_t* sgn, bf16_t* m1) {
    const int m0 = blockIdx.y * 64, n0 = blockIdx.x * 64;
    auto al = [&](int m, int k) { return bf2f(onsa[(size_t)m * 512 + k]); };
    auto bl = [&](int b, int k, int n) { return w[(size_t)k * DM + n]; };
    auto epi = [&](float (*Cs)[64][65], int m0_, int n0_) {
        for (int e = threadIdx.x; e < 64 * 64; e += 256) { const int r = e >> 6, c = e & 63; const size_t ix = (size_t)(m0_ + r) * DM + n0_ + c;
            m1[ix] = f2bf(bf2f(sgn[ix]) * Cs[0][r][c]); }
    };
    tgemm<1>(m0, n0, 512, al, bl, epi);
}
__global__ void __launch_bounds__(256) k_glu(const bf16_t* geluy, const float* w, const bf16_t* sgs, const bf16_t* m1, bf16_t* merged) {
    const int m0 = blockIdx.y * 64, n0 = blockIdx.x * 64;
    auto al = [&](int m, int k) { return bf2f(geluy[(size_t)m * 512 + k]); };
    auto bl = [&](int b, int k, int n) { return w[(size_t)k * 2048 + b * 1024 + n]; };
    auto epi = [&](float (*Cs)[64][65], int m0_, int n0_) {
        for (int e = threadIdx.x; e < 64 * 64; e += 256) { const int r = e >> 6, c = e & 63; const size_t ix = (size_t)(m0_ + r) * DM + n0_ + c;
            merged[ix] = f2bf(bf2f(m1[ix]) + bf2f(sgs[ix]) * Cs[0][r][c] * sigmoidf_(Cs[1][r][c])); }
    };
    tgemm<2>(m0, n0, 512, al, bl, epi);
}
__global__ void __launch_bounds__(256) k_wout(const bf16_t* merged, const float* w, float* out, const float* gnext, bf16_t* xn) {
    const int m0 = blockIdx.y * 64, n0 = blockIdx.x * 64;
    auto al = [&](int m, int k) { return bf2f(merged[(size_t)m * DM + k]); };
    auto bl = [&](int b, int k, int n) { return w[(size_t)k * DM + n]; };
    auto epi = [&](float (*Cs)[64][65], int m0_, int n0_) {
        for (int e = threadIdx.x; e < 64 * 64; e += 256) { const int r = e >> 6, c = e & 63; const size_t ix = (size_t)(m0_ + r) * DM + n0_ + c;
            const float o = out[ix] + Cs[0][r][c]; out[ix] = o; xn[ix] = f2bf(o * gnext[n0_ + c]); }
    };
    tgemm<1>(m0, n0, DM, al, bl, epi);
}

static void launch_mega(const Args& a0, int lo, int hi, int fused, int grid, hipStream_t stream, int aflags = 7) {
    Args a = a0; a.ph_lo = lo; a.ph_hi = hi; a.fused = fused; a.pad = aflags;
    hipLaunchKernelGGL(mega, dim3(grid), dim3(NWAVES * 64), LDS_BYTES, stream, a);
}
extern "C" void kernel_launch(void* const* d_in, const int* in_sizes, int n_in, void* d_out, int out_size, void* d_ws, size_t ws_size, hipStream_t stream) {
    static int grid = 0;
    if (grid == 0) {
        if (n_in != 32 || out_size != T * DM || ws_size < WS_END) { fprintf(stderr, "kernel_launch: unexpected shapes n_in %d out %d ws %zu\n", n_in, out_size, ws_size); grid = -1; return; }
        int dev = 0, cus = 0;
        if (hipGetDevice(&dev) != hipSuccess || hipDeviceGetAttribute(&cus, hipDeviceAttributeMultiprocessorCount, dev) != hipSuccess) { grid = -1; return; }
        if (hipFuncSetAttribute((const void*)mega, hipFuncAttributeMaxDynamicSharedMemorySize, LDS_BYTES) != hipSuccess) { fprintf(stderr, "kernel_launch: hipFuncSetAttribute failed\n"); grid = -1; return; }
        if (cus < 256) { fprintf(stderr, "kernel_launch: this kernel's unit maps need 256 co-resident workgroups (one per CU); the device has %d CUs\n", cus); grid = -1; return; }
        grid = 256;
    }
    if (grid < 0) return;
    const float* in[32]; for (int i = 0; i < 32; ++i) in[i] = (const float*)d_in[i];
    unsigned char* ws = (unsigned char*)d_ws; float* out = (float*)d_out;
    (void)hipMemsetAsync(ws + WS_CTL, 0, CTL_ZERO_BYTES, stream);
    Args a{}; for (int i = 0; i < 32; ++i) a.in[i] = in[i]; a.out = out; a.ws = ws;
    float* ssq = (float*)(ws + WS_SSQ); float* g3 = (float*)(ws + WS_G3); bf16_t* hid = (bf16_t*)(ws + WS_HID);
    bf16_t* kcmp = (bf16_t*)(ws + WS_KCMP); bf16_t* vcmp = (bf16_t*)(ws + WS_VCMP); float* ssmp = (float*)(ws + WS_SSMP);
    bf16_t* xn = (bf16_t*)(ws + WS_XN);
    WinOut wo; wo.q = (bf16_t*)(ws + WS_Q); wo.ks = (bf16_t*)(ws + WS_KS); wo.vs = (bf16_t*)(ws + WS_VS); wo.kw = (bf16_t*)(ws + WS_KW); wo.vw = (bf16_t*)(ws + WS_VW);
    wo.kcr = (bf16_t*)(ws + WS_KCR); wo.vcr = (bf16_t*)(ws + WS_VCR); wo.acat = (bf16_t*)(ws + WS_ACAT); wo.sgn = (bf16_t*)(ws + WS_SGN); wo.sgs = (bf16_t*)(ws + WS_SGS); wo.g3 = g3;
    wo.q_norm = in[7]; wo.k_norm_slc = in[9]; wo.k_norm_win = in[10];
    bf16_t* owin = (bf16_t*)(ws + WS_OWIN); bf16_t* onsa = (bf16_t*)(ws + WS_ONSA); bf16_t* geluy = (bf16_t*)(ws + WS_GELUY);
    bf16_t* m1 = (bf16_t*)(ws + WS_M1); bf16_t* merged = (bf16_t*)(ws + WS_MERGED);

#if defined(PROBE_ATT)
    for (int ph = 0; ph < NPH; ++ph) { launch_mega(a, ph, ph + 1, 0, grid, stream); if (ph == PH_MIDB) for (int r_ = 0; r_ < 4; ++r_) launch_mega(a, ph, ph + 1, 0, grid, stream, 2 | 16); }
#elif defined(PROBE_MIDB)
    for (int ph = 0; ph < NPH; ++ph) {
        if (ph == PH_MIDB && PROBE_MIDB == 4) launch_mega(a, ph, ph + 1, 0, grid, stream, 2);
        launch_mega(a, ph, ph + 1, 0, grid, stream);
        if (ph == PH_MIDB) launch_mega(a, ph, ph + 1, 0, grid, stream, PROBE_MIDB == 1 ? 4 : PROBE_MIDB == 2 ? 3 : PROBE_MIDB == 3 ? 2 : PROBE_MIDB == 5 ? 7 : 1);
    }
#elif defined(REP_MIDA)
    for (int ph = 0; ph < NPH; ++ph) { launch_mega(a, ph, ph + 1, 0, grid, stream); if (ph == PH_MIDA) { if (REP_MIDA >= 3) (void)hipMemsetAsync(ws + WS_CTL, 0, CTL_ZERO_BYTES, stream); launch_mega(a, ph, ph + 1, 0, grid, stream, 7 | (REP_MIDA == 1 ? 32 : REP_MIDA == 2 ? 64 : REP_MIDA == 4 ? 96 : 0)); } }
#elif defined(PROBE_F1D)
    for (int ph = 0; ph < NPH; ++ph) { launch_mega(a, ph, ph + 1, 0, grid, stream); if (ph == PH_F1D) launch_mega(a, ph, ph + 1, 0, grid, stream, 7 | 8); }
#elif defined(REP_PHASE)
    for (int ph = 0; ph < NPH; ++ph) for (int r = 0; r < (ph == REP_PHASE ? 2 : 1); ++r) launch_mega(a, ph, ph + 1, 0, grid, stream);
#elif defined(MK_PER_PHASE)
    for (int ph = 0; ph < NPH; ++ph) launch_mega(a, ph, ph + 1, 0, grid, stream);
#else
    launch_mega(a, 0, NPH, 1, grid, stream);
#endif
}
```
